# Optimizing an MI355X kernel written in HIP

```python
import jax, jax.numpy as jnp
from jax import lax
import numpy as np

D_MODEL = 1024
BATCH = 16
SEQ = 256
DEPTH = 2
DEC_BATCH = 2
DEC_SEQ = 4096
PAST_LEN = 256

GRID_W = 64
N_EVEN = (DEPTH + 1) // 2
N_ODD = DEPTH // 2
EPS = 1e-6
H_A = 4
DH_A = D_MODEL // 8
W_A = H_A * DH_A
CHUNK_A = 128
FORGET_BIAS = 3.0
HQ_B = 8
HKV_B = 2
G_B = HQ_B // HKV_B
DH_B = D_MODEL // 16
W_B = HQ_B * DH_B
QBLOCK = 128
ROPE_THETA = 10000.0
H_C = 16
DH_C = D_MODEL // 16
W_C = H_C * DH_C
WIN_R_MAX = 8
WIN_C = 16
EVEN_SIZES = (W_A, W_A, W_A, W_A, 4 * H_A, W_B, HKV_B * DH_B, HKV_B * DH_B, W_A + W_B)
IN_EVEN = 4 * W_A + 4 * H_A + W_B + 2 * HKV_B * DH_B + W_A + W_B
IN_ODD = 4 * W_C

kernel_name = 'hybrid_mlstm_gqa_natten_diffusion_step'


def offsets(sizes):
    out, acc = [], 0
    for s in sizes[:-1]:
        acc += s
        out.append(acc)
    return out


def rmsnorm(x, g):
    xf = x.astype(jnp.float32)
    y = xf * lax.rsqrt(jnp.mean(xf * xf, axis=-1, keepdims=True) + EPS)
    return (y * g.astype(jnp.float32)).astype(x.dtype)


def modulation(cvec, w, b):
    m = jnp.dot(jax.nn.silu(cvec), w) + b
    return jnp.split(m, 3, axis=-1)


def to_heads(a, n):
    B, T, _ = a.shape
    return a.reshape(B, T, n, -1).transpose(0, 2, 1, 3)


def from_heads(a):
    B, H, T, D = a.shape
    return a.transpose(0, 2, 1, 3).reshape(B, T, H * D)


def axial_rope_tables(n_tok):
    t = jnp.arange(n_tok)
    row = (t // GRID_W).astype(jnp.float32)
    col = (t % GRID_W).astype(jnp.float32)
    quarter = DH_B // 4
    freqs = ROPE_THETA ** (-jnp.arange(quarter, dtype=jnp.float32) / quarter)
    ang_r = row[:, None] * freqs
    ang_c = col[:, None] * freqs
    return (jnp.cos(ang_r), jnp.sin(ang_r), jnp.cos(ang_c), jnp.sin(ang_c))


def rope_half(x, cos, sin):
    x1, x2 = jnp.split(x, 2, axis=-1)
    return jnp.concatenate([x1 * cos - x2 * sin, x1 * sin + x2 * cos], axis=-1)


def axial_rope(x, tables):
    cos_r, sin_r, cos_c, sin_c = (t.astype(x.dtype) for t in tables)
    xr, xc = jnp.split(x, 2, axis=-1)
    return jnp.concatenate([rope_half(xr, cos_r, sin_r), rope_half(xc, cos_c, sin_c)], axis=-1)


def mlstm_scan(q, k, v, ig, fg, C0, n0, m0):
    f32 = jnp.float32
    B, H, T, Dh = q.shape
    L = CHUNK_A
    nc = T // L

    def chunks(a):
        a = a.reshape(B, H, nc, L, *a.shape[3:])
        return jnp.moveaxis(a, 2, 0)

    qc = chunks(q.astype(f32))
    kc = chunks(k.astype(f32) * Dh ** -0.5)
    vc = chunks(v.astype(f32))
    logf = chunks(jax.nn.log_sigmoid(fg.astype(f32)))
    logi = chunks(ig.astype(f32))
    causal = jnp.tril(jnp.ones((L, L), dtype=bool))

    def step(carry, xs):
        C, n, m = carry
        qj, kj, vj, lf, li = xs
        b = jnp.cumsum(lf, axis=-1)
        Dm = jnp.where(causal, b[..., :, None] - b[..., None, :] + li[..., None, :], -jnp.inf)
        m_inter = b + m[..., None]
        m_t = jnp.maximum(m_inter, jnp.max(Dm, axis=-1))
        w_inter = jnp.exp(m_inter - m_t)
        P = jnp.exp(Dm - m_t[..., None]) * jnp.einsum('bhld,bhsd->bhls', qj, kj)
        num = w_inter[..., None] * jnp.einsum('bhvk,bhlk->bhlv', C, qj) + jnp.einsum('bhls,bhsv->bhlv', P, vj)
        den = w_inter * jnp.einsum('bhk,bhlk->bhl', n, qj) + jnp.sum(P, axis=-1)
        h = num / jnp.maximum(jnp.abs(den), jnp.exp(-m_t))[..., None]
        bL = b[..., -1]
        g = bL[..., None] - b + li
        m_new = jnp.maximum(bL + m, jnp.max(g, axis=-1))
        a_st = jnp.exp(bL + m - m_new)
        wk = jnp.exp(g - m_new[..., None])
        C_new = a_st[..., None, None] * C + jnp.einsum('bhs,bhsv,bhsk->bhvk', wk, vj, kj)
        n_new = a_st[..., None] * n + jnp.einsum('bhs,bhsk->bhk', wk, kj)
        return (C_new, n_new, m_new), h

    (C, n, m), hs = lax.scan(step, (C0.astype(f32), n0.astype(f32), m0.astype(f32)), (qc, kc, vc, logf, logi))
    h = jnp.moveaxis(hs, 0, 2).reshape(B, H, T, Dh)
    return h, C, n, m


def block_attend(q, k, v):
    B, KV, G, T, D = q.shape
    nb = T // QBLOCK
    scale = D ** -0.5
    qb = jnp.moveaxis(q.reshape(B, KV, G, nb, QBLOCK, D), 3, 0)

    def blk(qi):
        s = jnp.einsum('bkgqd,bksd->bkgqs', qi, k).astype(jnp.float32) * scale
        p = jax.nn.softmax(s, axis=-1).astype(v.dtype)
        return jnp.einsum('bkgqs,bksd->bkgqd', p, v)

    o = lax.map(blk, qb)
    return jnp.moveaxis(o, 0, 3).reshape(B, KV, G, T, D)


def na_attend(q, k, v, kc, vc, rpb):
    B, H, T, D = q.shape
    rows = T // GRID_W
    wr = min(WIN_R_MAX, rows)
    scale = D ** -0.5
    qg = q.reshape(B, H, rows, GRID_W, D)
    kg = k.reshape(B, H, rows, GRID_W, D)
    vg = v.reshape(B, H, rows, GRID_W, D)
    col = jnp.arange(GRID_W)
    cs = jnp.clip(col - WIN_C // 2, 0, GRID_W - WIN_C)
    col_idx = cs[:, None] + jnp.arange(WIN_C)[None, :]
    rpb_cols = rpb[:, :, col_idx - col[:, None] + WIN_C - 1]

    def row_fn(args):
        r, q_r = args
        rs = jnp.clip(r - wr // 2, 0, rows - wr)
        k_win = lax.dynamic_slice_in_dim(kg, rs, wr, axis=2)[:, :, :, col_idx, :]
        v_win = lax.dynamic_slice_in_dim(vg, rs, wr, axis=2)[:, :, :, col_idx, :]
        bias = rpb_cols[:, rs + jnp.arange(wr) - r + WIN_R_MAX - 1]
        s_loc = (jnp.einsum('bhcd,bhrcwd->bhcrw', q_r, k_win).astype(jnp.float32) * scale
                 + jnp.transpose(bias, (0, 2, 1, 3))[None].astype(jnp.float32))
        s_ctx = jnp.einsum('bhcd,bhpd->bhcp', q_r, kc).astype(jnp.float32) * scale
        p = jax.nn.softmax(jnp.concatenate([s_loc.reshape(B, H, GRID_W, wr * WIN_C), s_ctx], axis=-1), axis=-1)
        p_loc = p[..., :wr * WIN_C].reshape(B, H, GRID_W, wr, WIN_C).astype(v.dtype)
        p_ctx = p[..., wr * WIN_C:].astype(v.dtype)
        return jnp.einsum('bhcrw,bhrcwd->bhcd', p_loc, v_win) + jnp.einsum('bhcp,bhpd->bhcd', p_ctx, vc)

    o = lax.map(row_fn, (jnp.arange(rows), jnp.moveaxis(qg, 2, 0)))
    return jnp.moveaxis(o, 0, 2).reshape(B, H, T, D)


def even_mixer(h, w_in, b_gates, g_hn, g_q, g_k, w_out, st_fwd, st_bwd, kv_ctx, rope):
    B, T, _ = h.shape
    p = jnp.einsum('btd,dn->btn', h, w_in)
    qa, ka, va, oa, gates, qb, kb, vb, z = jnp.split(p, offsets(EVEN_SIZES), axis=-1)
    qa, ka, va, oa = (to_heads(a, H_A) for a in (qa, ka, va, oa))
    g4 = (gates + b_gates).reshape(B, T, 4, H_A).transpose(2, 0, 3, 1)
    ig_f, fg_f, ig_b, fg_b = g4[0], g4[1], g4[2], g4[3]
    rev = lambda a: jnp.flip(a, axis=2)
    h_f, C_f, n_f, m_f = mlstm_scan(qa, ka, va, ig_f, fg_f, *st_fwd)
    h_b, C_b, n_b, m_b = mlstm_scan(rev(qa), rev(ka), rev(va), rev(ig_b), rev(fg_b), *st_bwd)
    ha = rmsnorm(h_f + rev(h_b), g_hn.reshape(H_A, 1, DH_A)) * jax.nn.sigmoid(oa.astype(jnp.float32))
    ha = from_heads(ha.astype(h.dtype))
    qb = rmsnorm(to_heads(qb, HQ_B), g_q)
    kb = rmsnorm(to_heads(kb, HKV_B), g_k)
    vb = to_heads(vb, HKV_B)
    if rope is not None:
        qb = axial_rope(qb, rope)
        kb_pos = axial_rope(kb, rope)
    else:
        kb_pos = kb
    if kv_ctx is None:
        k_all, v_all = kb_pos, vb
    else:
        k_all = jnp.concatenate([kb_pos, kv_ctx[0].astype(kb.dtype)], axis=2)
        v_all = jnp.concatenate([vb, kv_ctx[1].astype(vb.dtype)], axis=2)
    hb = block_attend(qb.reshape(B, HKV_B, G_B, T, DH_B), k_all, v_all).reshape(B, HQ_B, T, DH_B)
    y = jnp.concatenate([ha, from_heads(hb)], axis=-1) * jax.nn.silu(z)
    y = jnp.einsum('btn,nd->btd', y, w_out)
    ctx_tensors = (jnp.stack([C_f, C_b], axis=1), jnp.stack([n_f, n_b], axis=1), jnp.stack([m_f, m_b], axis=1), kb, vb)
    return y, ctx_tensors


def odd_mixer(h, w_in, rpb, w_out, kv_ctx):
    p = jnp.einsum('btd,dn->btn', h, w_in)
    q, k, v, z = jnp.split(p, 4, axis=-1)
    q, k, v = (to_heads(a, H_C) for a in (q, k, v))
    if kv_ctx is None:
        o = block_attend(q[:, :, None], k, v)[:, :, 0]
    else:
        o = na_attend(q, k, v, kv_ctx[0].astype(k.dtype), kv_ctx[1].astype(v.dtype), rpb)
    y = jnp.einsum('btn,nd->btd', from_heads(o) * jax.nn.silu(z), w_out)
    return y, (k, v)


def setup_inputs(seed: int = 0) -> dict:
    key = jax.random.key(seed)
    ks = jax.random.split(key, 32)
    nrm = lambda k, shape, s=1.0: s * jax.random.normal(k, shape, jnp.float32)
    gate_offset = jnp.tile(jnp.repeat(jnp.array([0.0, FORGET_BIAS], jnp.float32), H_A), 2)
    return {
        'x_prompt': nrm(ks[0], (BATCH, SEQ, D_MODEL)),
        'x_sample': nrm(ks[1], (DEC_BATCH, DEC_SEQ, D_MODEL)),
        'state_mlstm_C': nrm(ks[2], (DEC_BATCH, N_EVEN, 2, H_A, DH_A, DH_A), 0.1),
        'state_mlstm_n': nrm(ks[3], (DEC_BATCH, N_EVEN, 2, H_A, DH_A), 0.1),
        'state_mlstm_m': nrm(ks[4], (DEC_BATCH, N_EVEN, 2, H_A)),
        'cache_gqa_k': nrm(ks[5], (DEC_BATCH, N_EVEN, HKV_B, PAST_LEN, DH_B)),
        'cache_gqa_v': nrm(ks[6], (DEC_BATCH, N_EVEN, HKV_B, PAST_LEN, DH_B)),
        'cache_na_k': nrm(ks[7], (DEC_BATCH, N_ODD, H_C, PAST_LEN, DH_C)),
        'cache_na_v': nrm(ks[8], (DEC_BATCH, N_ODD, H_C, PAST_LEN, DH_C)),
        'c': nrm(ks[9], (DEC_BATCH, D_MODEL)),
        'c_ctx': nrm(ks[10], (D_MODEL,)),
        'w_mod': nrm(ks[11], (DEPTH, D_MODEL, 3 * D_MODEL), 0.5 * D_MODEL ** -0.5),
        'b_mod': nrm(ks[12], (DEPTH, 3 * D_MODEL), 0.01),
        'g_pre': 1.0 + nrm(ks[13], (DEPTH, D_MODEL), 0.05),
        'g_post': 1.0 + nrm(ks[14], (DEPTH, D_MODEL), 0.05),
        'w_in_ab': nrm(ks[15], (N_EVEN, D_MODEL, IN_EVEN), D_MODEL ** -0.5),
        'b_gates_ab': gate_offset + nrm(ks[16], (N_EVEN, 4 * H_A), 0.1),
        'g_hnorm_a': 1.0 + nrm(ks[17], (N_EVEN, W_A), 0.05),
        'g_qnorm_b': 1.0 + nrm(ks[18], (N_EVEN, DH_B), 0.05),
        'g_knorm_b': 1.0 + nrm(ks[19], (N_EVEN, DH_B), 0.05),
        'w_out_ab': nrm(ks[20], (N_EVEN, W_A + W_B, D_MODEL), (W_A + W_B) ** -0.5),
        'w_in_c': nrm(ks[21], (N_ODD, D_MODEL, IN_ODD), D_MODEL ** -0.5),
        'rpb_c': nrm(ks[22], (N_ODD, H_C, 2 * WIN_R_MAX - 1, 2 * WIN_C - 1), 0.1),
        'w_out_c': nrm(ks[23], (N_ODD, W_C, D_MODEL), W_C ** -0.5),
    }


def reference(x_prompt, x_sample, state_mlstm_C, state_mlstm_n, state_mlstm_m, cache_gqa_k, cache_gqa_v,
              cache_na_k, cache_na_v, c, c_ctx, w_mod, b_mod, g_pre, g_post, w_in_ab, b_gates_ab, g_hnorm_a,
              g_qnorm_b, g_knorm_b, w_out_ab, w_in_c, rpb_c, w_out_c):
    f32 = jnp.float32
    rope = axial_rope_tables(x_sample.shape[1])
    bp = x_prompt.shape[0]
    xp, xs = x_prompt, x_sample
    new_C, new_n, new_m, new_gk, new_gv, new_nk, new_nv = [], [], [], [], [], [], []
    for layer in range(DEPTH):
        sh_p, sc_p, gt_p = modulation(c_ctx, w_mod[layer], b_mod[layer])
        sh_s, sc_s, gt_s = (a[:, None, :] for a in modulation(c, w_mod[layer], b_mod[layer]))
        hp = rmsnorm(xp, g_pre[layer]) * (1.0 + sc_p) + sh_p
        hs = rmsnorm(xs, g_pre[layer]) * (1.0 + sc_s) + sh_s
        j = layer // 2
        if layer % 2 == 0:
            w = (w_in_ab[j], b_gates_ab[j], g_hnorm_a[j], g_qnorm_b[j], g_knorm_b[j], w_out_ab[j])
            zero = (jnp.zeros((bp, H_A, DH_A, DH_A), f32), jnp.zeros((bp, H_A, DH_A), f32), jnp.zeros((bp, H_A), f32))
            yp, (sC, sn, sm, kb, vb) = even_mixer(hp, *w, zero, zero, None, None)
            st_f = (state_mlstm_C[:, j, 0], state_mlstm_n[:, j, 0], state_mlstm_m[:, j, 0])
            st_b = (state_mlstm_C[:, j, 1], state_mlstm_n[:, j, 1], state_mlstm_m[:, j, 1])
            ys, _ = even_mixer(hs, *w, st_f, st_b, (cache_gqa_k[:, j], cache_gqa_v[:, j]), rope)
            new_C.append(sC)
            new_n.append(sn)
            new_m.append(sm)
            new_gk.append(kb)
            new_gv.append(vb)
        else:
            yp, (kc, vc) = odd_mixer(hp, w_in_c[j], rpb_c[j], w_out_c[j], None)
            ys, _ = odd_mixer(hs, w_in_c[j], rpb_c[j], w_out_c[j], (cache_na_k[:, j], cache_na_v[:, j]))
            new_nk.append(kc)
            new_nv.append(vc)
        xp = xp + gt_p * rmsnorm(yp, g_post[layer])
        xs = xs + gt_s * rmsnorm(ys, g_post[layer])
    dt = x_prompt.dtype
    out_C = jnp.stack(new_C, axis=1).astype(dt)
    out_n = jnp.stack(new_n, axis=1).astype(dt)
    out_m = jnp.stack(new_m, axis=1).astype(dt)
    out_gk = jnp.stack(new_gk, axis=1).astype(dt)
    out_gv = jnp.stack(new_gv, axis=1).astype(dt)
    out_nk = jnp.stack(new_nk, axis=1).astype(dt)
    out_nv = jnp.stack(new_nv, axis=1).astype(dt)
    return (xp, xs, out_C, out_n, out_m, out_gk, out_gv, out_nk, out_nv)
```

```cpp
#include <hip/hip_runtime.h>
#include <hip/hip_cooperative_groups.h>
#include <cstdio>
#include <cstdint>
namespace cg = cooperative_groups;

#define LAS __attribute__((address_space(3)))
#define DI __device__ __forceinline__
typedef unsigned short bf16_t;
typedef short bf16x8 __attribute__((ext_vector_type(8)));
typedef short s16x4 __attribute__((ext_vector_type(4)));
typedef float f32x4 __attribute__((ext_vector_type(4)));
typedef float f32x2 __attribute__((ext_vector_type(2)));
typedef float f32x16 __attribute__((ext_vector_type(16)));
typedef unsigned u32x4 __attribute__((ext_vector_type(4)));
typedef unsigned u32x2 __attribute__((ext_vector_type(2)));
typedef __bf16 bf16x2_t __attribute__((ext_vector_type(2)));

constexpr int DM = 1024, MP = 4096, MS = 8192, MROWS = 12288, NP = 4096;
constexpr float EPS = 1e-6f;
constexpr float LOG2E = 1.4426950408889634f;
constexpr float QSCALE = 0.125f * LOG2E;
constexpr int C_QA = 0, C_KA = 512, C_VA = 1024, C_OA = 1536, C_G = 2048, C_QB = 2064, C_KB = 2576, C_VB = 2704, C_Z = 2832, C_END = 3856;
constexpr size_t O_YP = 0, O_YS = 4194304, O_C = 12582912, O_N = 14680064, O_M = 14696448, O_GK = 14696576, O_GV = 15220864, O_NK = 15745152, O_NV = 19939456;
constexpr size_t MiB = 1u << 20;
constexpr size_t WS_BAR = 0;
constexpr size_t WS_MOD = 1 * MiB;
constexpr size_t WS_G = 2 * MiB;
constexpr size_t WS_SC = 3 * MiB;
constexpr size_t WS_CH = 5 * MiB;
constexpr size_t WS_UN = 5 * MiB + 65536;
constexpr size_t WS_NST = 5 * MiB + 65536 + 393216;
constexpr size_t WS_MJ = 5 * MiB + 65536 + 786432;
constexpr size_t WS_CK = 6 * MiB;
constexpr size_t WS_CVT = 6 * MiB + 131072;
constexpr size_t WS_NK = 7 * MiB;
constexpr size_t WS_NVT = 8 * MiB;
constexpr size_t WS_WINE = 10 * MiB;
constexpr size_t WS_WOUTE = 18 * MiB;
constexpr size_t WS_WINO = 20 * MiB;
constexpr size_t WS_WOUTO = 28 * MiB;
constexpr size_t WS_H = 30 * MiB;
constexpr size_t WS_KT = 54 * MiB;
constexpr size_t WS_VT = 66 * MiB;
constexpr size_t WS_Y2 = 54 * MiB;
constexpr size_t WS_P = 78 * MiB;
constexpr size_t WS_CST = 174 * MiB;
constexpr size_t WS_QB = 198 * MiB;
constexpr size_t WS_KB = 210 * MiB;
constexpr size_t WS_VBT = 213 * MiB;
constexpr size_t WS_U = 216 * MiB;
constexpr size_t WS_VCT = 216 * MiB;
constexpr size_t WS_X1P = 10 * MiB;
constexpr size_t WS_X1S = 240 * MiB;
constexpr size_t WS_END = 256 * MiB;

constexpr int REP_MASK = 0, SYNC_REP = 1;
constexpr int LDS_BYTES = 147456;

DI float bf2f(unsigned short b) { return __uint_as_float(((unsigned)b) << 16); }
DI unsigned cvtpk(float lo, float hi) { f32x2 v = {lo, hi}; bf16x2_t b = __builtin_convertvector(v, bf16x2_t); return __builtin_bit_cast(unsigned, b); }
DI unsigned short f2bf(float x) { return (unsigned short)(cvtpk(x, 0.f) & 0xffffu); }
DI float siluf(float x) { return x / (1.f + __expf(-x)); }
DI float sigmf(float x) { return 1.f / (1.f + __expf(-x)); }
DI float wave_sum(float v) {
#pragma unroll
    for (int o = 1; o < 64; o <<= 1) v += __shfl_xor(v, o);
    return v;
}
DI int crow(int i, int h) { return (i & 3) + 8 * (i >> 2) + 4 * h; }
DI bf16x8 pack8(float a0, float a1, float a2, float a3, float a4, float a5, float a6, float a7) {
    u32x4 p; p.x = cvtpk(a0, a1); p.y = cvtpk(a2, a3); p.z = cvtpk(a4, a5); p.w = cvtpk(a6, a7);
    return __builtin_bit_cast(bf16x8, p);
}
#define MFMA32(a, b, c) __builtin_amdgcn_mfma_f32_32x32x16_bf16((a), (b), (c), 0, 0, 0)

namespace pg8 {
constexpr int BM = 256, BK = 64, HALF = 128, HTB = HALF * BK * 2, NXCD = 8, WGM = 8;
DI int lds_byte(int r, int c) { const int st = (r >> 4) * 2 + (c >> 5), rr = r & 15, cc = c & 31, ob = rr * 64 + cc * 2; return st * 1024 + (ob ^ (((ob >> 9) & 1) << 5)); }
DI void stage_rc(int b, int& R, int& C) { const int st = b / 1024, sb = b % 1024, swz = sb ^ (((sb >> 9) & 1) << 5); R = (st >> 1) * 16 + swz / 64; C = (st & 1) * 32 + (swz % 64) / 2; }
DI int perm32(int rho) { const int n = rho >> 4, i = rho & 15; return 8 * (i >> 2) + 4 * n + (i & 3); }
struct Unit { int pm, pn; };
struct Gemm { const bf16_t* A; const bf16_t* Bt; int M, N, K; };
struct StaticOrder {
    int nM, nN, nwg, G, c;
    DI void init(int M, int N, int G_, int c_) { nM = M / BM; nN = N / BM; nwg = nM * nN; G = G_; c = c_; }
    DI bool next(int i, Unit& u) const {
        const long L = (long)i * G + c; if (L >= nwg) return false;
        int wgid = (int)L; { const int q = nwg / NXCD, r = nwg % NXCD, xcd = wgid % NXCD, off = wgid / NXCD; wgid = (xcd < r ? xcd * (q + 1) : r * (q + 1) + (xcd - r) * q) + off; }
        const int nig = WGM * nN, gid = wgid / nig, fm = gid * WGM, gsz = (nM - fm) < WGM ? (nM - fm) : WGM;
        u.pm = fm + ((wgid % nig) % gsz); u.pn = (wgid % nig) / gsz; return true;
    }
};
template <class Epi>
DI void gemm_phase(LAS unsigned char* lds, const Gemm g, const StaticOrder& S, const Epi& E) {
    const int tid = threadIdx.x, wid = __builtin_amdgcn_readfirstlane(tid >> 6), lane = tid & 63, wr = wid >> 2, wc = wid & 3, fr = lane & 15, fq = lane >> 4;
    const int K = g.K, nt = K / BK;
    unsigned voffA[2], voffB[2];
#pragma unroll
    for (int i = 0; i < 2; ++i) { int R, C; stage_rc(tid * 16 + i * 8192, R, C); const int Rb = (R & ~31) + perm32(R & 31);
        voffA[i] = (unsigned)(R * K + C) * 2u; voffB[i] = (unsigned)(Rb * K + C) * 2u; }
    const size_t kstep = (size_t)(BK * 2);
    const size_t hstep = (size_t)HALF * K * 2;
    const size_t tstep = 2 * hstep;
    const unsigned ldsw = (unsigned)wid * 1024u;
    const int aoff = lds_byte(wr * 64 + fr, fq * 8), boff = lds_byte(wc * 32 + fr, fq * 8);
#define PG8_SA(b, h) (((b) * 2 + (h)) * HTB)
#define PG8_SB(b, h) ((4 + (b) * 2 + (h)) * HTB)
#define PG8_STAGE(bufoff, gbase, voff) do { _Pragma("unroll") for (int _i = 0; _i < 2; ++_i) \
        __builtin_amdgcn_global_load_lds((const unsigned*)((const char*)(gbase) + (voff)[_i]), (LAS unsigned*)(lds + (bufoff) + ldsw + _i * 8192), 16, 0, 0); } while (0)
#define PG8_LDA(dst, b, h) do { _Pragma("unroll") for (int m = 0; m < 4; ++m) _Pragma("unroll") for (int k = 0; k < 2; ++k) dst[m][k] = *(const LAS bf16x8*)(lds + PG8_SA(b, h) + aoff + m * 2048 + k * 1024); } while (0)
#define PG8_LDB(dst, b, h) do { _Pragma("unroll") for (int n = 0; n < 2; ++n) _Pragma("unroll") for (int k = 0; k < 2; ++k) dst[n][k] = *(const LAS bf16x8*)(lds + PG8_SB(b, h) + boff + n * 2048 + k * 1024); } while (0)
#define PG8_MMA(ai, bj, At, Bt) do { __builtin_amdgcn_s_setprio(1); _Pragma("unroll") for (int m = 0; m < 4; ++m) _Pragma("unroll") for (int n = 0; n < 2; ++n) _Pragma("unroll") for (int k = 0; k < 2; ++k) \
        acc[ai][bj][m][n] = __builtin_amdgcn_mfma_f32_16x16x32_bf16(Bt[n][k], At[m][k], acc[ai][bj][m][n], 0, 0, 0); __builtin_amdgcn_s_setprio(0); } while (0)
#define PG8_WAIT_V(n) asm volatile("s_waitcnt vmcnt(" #n ")" ::: "memory")
#define PG8_WAIT_L(n) asm volatile("s_waitcnt lgkmcnt(" #n ")" ::: "memory")
#define PG8_BAR __builtin_amdgcn_s_barrier()
#define PG8_SCHED __builtin_amdgcn_sched_barrier(0)
    Unit cur, nxt; int ui = 0;
    if (!S.next(0, cur)) return;
    f32x4 acc[2][2][4][2];
#pragma unroll
    for (int a = 0; a < 2; ++a)
#pragma unroll
        for (int b = 0; b < 2; ++b)
#pragma unroll
            for (int m = 0; m < 4; ++m)
#pragma unroll
                for (int n = 0; n < 2; ++n) acc[a][b][m][n] = (f32x4){0.f, 0.f, 0.f, 0.f};
    bf16x8 At[4][2], B0[2][2], B1[2][2];
    const char* cA = (const char*)g.A + (size_t)cur.pm * tstep; const char* cB = (const char*)g.Bt + (size_t)cur.pn * tstep;
    PG8_STAGE(PG8_SB(0, 0), cB, voffB); PG8_STAGE(PG8_SB(0, 1), cB + hstep, voffB); PG8_STAGE(PG8_SA(0, 0), cA, voffA); PG8_STAGE(PG8_SA(0, 1), cA + hstep, voffA);
    if (wr == 1) PG8_BAR;
    PG8_WAIT_V(2); PG8_BAR;
    PG8_STAGE(PG8_SB(1, 0), cB + kstep, voffB); PG8_STAGE(PG8_SA(1, 0), cA + kstep, voffA); PG8_STAGE(PG8_SB(1, 1), cB + hstep + kstep, voffB);
    PG8_WAIT_V(6); PG8_BAR;
    for (;;) {
        const bool has_next = S.next(ui + 1, nxt);
        const char* nA = has_next ? (const char*)g.A + (size_t)nxt.pm * tstep : cA; const char* nB = has_next ? (const char*)g.Bt + (size_t)nxt.pn * tstep : cB;
        for (int t = 0; t < nt; t += 2) {
            const bool last = (t == nt - 2);
            const char* a1 = cA + (size_t)(t + 1) * kstep;
            const char* a2 = last ? nA : cA + (size_t)(t + 2) * kstep; const char* b2 = last ? nB : cB + (size_t)(t + 2) * kstep;
            const char* a3 = a2 + kstep; const char* b3 = b2 + kstep;
            PG8_LDB(B0, 0, 0); PG8_LDB(B1, 0, 1); PG8_SCHED; PG8_LDA(At, 0, 0); PG8_STAGE(PG8_SA(1, 1), a1 + hstep, voffA);
            PG8_WAIT_V(8); PG8_WAIT_L(0); PG8_BAR; PG8_MMA(0, 0, At, B0); PG8_MMA(0, 1, At, B1); PG8_BAR; PG8_SCHED;
            PG8_LDA(At, 0, 1); PG8_STAGE(PG8_SB(0, 0), b2, voffB); PG8_STAGE(PG8_SB(0, 1), b2 + hstep, voffB); PG8_STAGE(PG8_SA(0, 0), a2, voffA);
            PG8_WAIT_V(8); PG8_WAIT_L(0); PG8_BAR; PG8_MMA(1, 0, At, B0); PG8_MMA(1, 1, At, B1); PG8_BAR; PG8_SCHED;
            PG8_LDB(B0, 1, 0); PG8_LDB(B1, 1, 1); PG8_SCHED; PG8_LDA(At, 1, 0); PG8_STAGE(PG8_SA(0, 1), a2 + hstep, voffA);
            PG8_WAIT_V(8); PG8_WAIT_L(0); PG8_BAR; PG8_MMA(0, 0, At, B0); PG8_MMA(0, 1, At, B1); PG8_BAR; PG8_SCHED;
            PG8_LDA(At, 1, 1); PG8_STAGE(PG8_SB(1, 0), b3, voffB); PG8_STAGE(PG8_SB(1, 1), b3 + hstep, voffB); PG8_STAGE(PG8_SA(1, 0), a3, voffA);
            PG8_WAIT_V(8); PG8_WAIT_L(0); PG8_BAR; PG8_MMA(1, 0, At, B0); PG8_MMA(1, 1, At, B1); PG8_BAR; PG8_SCHED;
        }
        if (wr == 0) PG8_BAR;
        if constexpr (!Epi::AFTER_DRAIN) E(acc, cur, wr, wc, fr, fq);
        if (!has_next) break;
#pragma unroll
        for (int a = 0; a < 2; ++a)
#pragma unroll
            for (int b = 0; b < 2; ++b)
#pragma unroll
                for (int m = 0; m < 4; ++m)
#pragma unroll
                    for (int n = 0; n < 2; ++n) acc[a][b][m][n] = (f32x4){0.f, 0.f, 0.f, 0.f};
        cur = nxt; cA = nA; cB = nB; ++ui;
        if (wr == 1) PG8_BAR;
    }
    PG8_WAIT_V(0);
    PG8_BAR;
    if constexpr (Epi::AFTER_DRAIN) E.fused(acc, cur, wr, wc, fr, fq, lds, wid, lane);
#undef PG8_SA
#undef PG8_SB
#undef PG8_STAGE
#undef PG8_LDA
#undef PG8_LDB
#undef PG8_MMA
#undef PG8_WAIT_V
#undef PG8_WAIT_L
#undef PG8_BAR
#undef PG8_SCHED
}
}

struct Params {
    const float* in[24];
    float* out;
    unsigned char* ws;
    int ph_lo, ph_hi, coop, pad;
};

struct WT { __amdgpu_buffer_rsrc_t rs; const unsigned char* base; };
DI WT mk_wt(const void* base, unsigned bytes) { WT w; w.rs = __builtin_amdgcn_make_buffer_rsrc((void*)base, (short)0, (int)bytes, 0x00020000); w.base = (const unsigned char*)base; return w; }
DI void wt16(const WT& w, const void* p, u32x4 v) { __builtin_amdgcn_raw_buffer_store_b128(v, w.rs, (unsigned)((const unsigned char*)p - w.base), 0, 16); }
DI void st_bf16x8(bf16_t* p, f32x4 a, f32x4 b) {
    u32x4 w; w.x = cvtpk(a[0], a[1]); w.y = cvtpk(a[2], a[3]); w.z = cvtpk(b[0], b[1]); w.w = cvtpk(b[2], b[3]);
    *(u32x4*)p = w;
}

struct EpiEvenIn {
    static constexpr bool AFTER_DRAIN = false;
    bf16_t* P; bf16_t* KT; bf16_t* VT; bf16_t* VbT; float* G; float* out;
    DI void operator()(const f32x4 (&acc)[2][2][4][2], const pg8::Unit& u, int wr, int wc, int fr, int fq) const {
#pragma unroll
        for (int bj = 0; bj < 2; ++bj) {
            const int c8 = u.pn * 256 + bj * 128 + wc * 32 + 8 * fq;
            if (c8 >= C_END) continue;
#pragma unroll
            for (int ai = 0; ai < 2; ++ai)
#pragma unroll
                for (int m = 0; m < 4; ++m) {
                    const int row = u.pm * 256 + ai * 128 + wr * 64 + m * 16 + fr;
                    f32x4 v0 = acc[ai][bj][m][0], v1 = acc[ai][bj][m][1];
                    if (c8 >= C_KA && c8 < C_VA) { v0 = v0 * 0.08838834764831845f; v1 = v1 * 0.08838834764831845f; }
                    if (c8 >= C_Z) {
#pragma unroll
                        for (int j = 0; j < 4; ++j) { v0[j] = siluf(v0[j]); v1[j] = siluf(v1[j]); }
                    }
                    if (c8 >= C_G && c8 < C_QB) {
                        *(f32x4*)(G + (size_t)row * 16 + (c8 - C_G)) = v0; *(f32x4*)(G + (size_t)row * 16 + (c8 - C_G) + 4) = v1;
                    } else {
                        st_bf16x8(P + (size_t)row * NP + c8, v0, v1);
                    }
                    bf16_t* T = nullptr; int tc = 0;
                    if (c8 >= C_KA && c8 < C_VA) { T = KT; tc = c8 - C_KA; }
                    else if (c8 >= C_VA && c8 < C_OA) { T = VT; tc = c8 - C_VA; }
                    else if (c8 >= C_VB && c8 < C_Z) { T = VbT; tc = c8 - C_VB; }
                    if (T) {
#pragma unroll
                        for (int j = 0; j < 4; ++j) { T[(size_t)(tc + j) * MROWS + row] = f2bf(v0[j]); T[(size_t)(tc + 4 + j) * MROWS + row] = f2bf(v1[j]); }
                    }
                    if (c8 >= C_VB && c8 < C_Z && row < MP) {
                        const int c = c8 - C_VB, hk = c >> 6, d = c & 63, b = row >> 8, t = row & 255;
                        float* o = out + O_GV + ((size_t)((b * 2 + hk) * 256 + t)) * 64 + d;
                        *(f32x4*)o = v0; *(f32x4*)(o + 4) = v1;
                    }
                }
        }
    }
};
struct EpiPlain {
    static constexpr bool AFTER_DRAIN = false;
    bf16_t* O; int ldc;
    DI void operator()(const f32x4 (&acc)[2][2][4][2], const pg8::Unit& u, int wr, int wc, int fr, int fq) const {
#pragma unroll
        for (int bj = 0; bj < 2; ++bj) {
            const int c8 = u.pn * 256 + bj * 128 + wc * 32 + 8 * fq;
#pragma unroll
            for (int ai = 0; ai < 2; ++ai)
#pragma unroll
                for (int m = 0; m < 4; ++m) {
                    const int row = u.pm * 256 + ai * 128 + wr * 64 + m * 16 + fr;
                    st_bf16x8(O + (size_t)row * ldc + c8, acc[ai][bj][m][0], acc[ai][bj][m][1]);
                }
        }
    }
};
struct EpiOddIn {
    static constexpr bool AFTER_DRAIN = false;
    bf16_t* P; bf16_t* VcT; float* out;
    DI void operator()(const f32x4 (&acc)[2][2][4][2], const pg8::Unit& u, int wr, int wc, int fr, int fq) const {
#pragma unroll
        for (int bj = 0; bj < 2; ++bj) {
            const int c8 = u.pn * 256 + bj * 128 + wc * 32 + 8 * fq;
            const int seg = c8 >> 10, c = c8 & 1023;
#pragma unroll
            for (int ai = 0; ai < 2; ++ai)
#pragma unroll
                for (int m = 0; m < 4; ++m) {
                    const int row = u.pm * 256 + ai * 128 + wr * 64 + m * 16 + fr;
                    f32x4 v0 = acc[ai][bj][m][0], v1 = acc[ai][bj][m][1];
                    if ((seg == 1 || seg == 2) && row < MP) {
                        const int h = c >> 6, d = c & 63, b = row >> 8, t = row & 255;
                        float* o = out + (seg == 1 ? O_NK : O_NV) + ((size_t)((b * 16 + h) * 256 + t)) * 64 + d;
                        *(f32x4*)o = v0; *(f32x4*)(o + 4) = v1;
                    }
                    if (seg == 2) {
#pragma unroll
                        for (int j = 0; j < 4; ++j) { VcT[(size_t)(c + j) * MROWS + row] = f2bf(v0[j]); VcT[(size_t)(c + 4 + j) * MROWS + row] = f2bf(v1[j]); }
                    } else {
                        if (seg == 0) { v0 = v0 * QSCALE; v1 = v1 * QSCALE; }
                        if (seg == 3) {
#pragma unroll
                            for (int j = 0; j < 4; ++j) { v0[j] = siluf(v0[j]); v1[j] = siluf(v1[j]); }
                        }
                        st_bf16x8(P + (size_t)row * NP + c8, v0, v1);
                    }
                }
        }
    }
};

DI void panel_row_rinv(const f32x4 (&v)[2][2][4][2], const pg8::Unit& u, int wr, int wc, int fr, int fq, LAS float* Pl, LAS float* Sl, int tid, float* slot, unsigned* c) {
#pragma unroll
    for (int ai = 0; ai < 2; ++ai)
#pragma unroll
        for (int m = 0; m < 4; ++m) {
            float sq = 0.f;
#pragma unroll
            for (int bj = 0; bj < 2; ++bj)
#pragma unroll
                for (int n = 0; n < 2; ++n) { const f32x4 x = v[ai][bj][m][n]; sq += (x[0] * x[0] + x[1] * x[1]) + (x[2] * x[2] + x[3] * x[3]); }
            sq += __shfl_xor(sq, 16); sq += __shfl_xor(sq, 32);
            if (fq == 0) Pl[(ai * 128 + wr * 64 + m * 16 + fr) * 4 + wc] = sq;
        }
    __syncthreads();
    if (tid < 256) {
        const float tot = (Pl[tid * 4 + 0] + Pl[tid * 4 + 1]) + (Pl[tid * 4 + 2] + Pl[tid * 4 + 3]);
        __hip_atomic_store(slot + tid * 4 + u.pn, tot, __ATOMIC_RELAXED, __HIP_MEMORY_SCOPE_AGENT);
    }
    asm volatile("s_waitcnt vmcnt(0)" ::: "memory");
    __syncthreads();
    if (tid == 0) {
        __hip_atomic_fetch_add(c, 1u, __ATOMIC_RELAXED, __HIP_MEMORY_SCOPE_AGENT);
        unsigned spins = 0;
        while (__hip_atomic_load(c, __ATOMIC_RELAXED, __HIP_MEMORY_SCOPE_AGENT) < 4u) { __builtin_amdgcn_s_sleep(1); if (++spins > (1u << 22)) break; }
        asm volatile("" ::: "memory");
    }
    __syncthreads();
    if (tid < 256) {
        float t = 0.f;
#pragma unroll
        for (int k = 0; k < 4; ++k) t += __hip_atomic_load(slot + tid * 4 + k, __ATOMIC_RELAXED, __HIP_MEMORY_SCOPE_AGENT);
        Sl[tid] = rsqrtf(t * (1.f / DM) + EPS);
    }
    __syncthreads();
}
struct EpiFinal {
    static constexpr bool AFTER_DRAIN = true;
    const bf16_t* X1P; const bf16_t* X1S; const float* MODl; const float* gpost; float* out; float* xbuf; unsigned* cnt;
    DI void fused(f32x4 (&acc)[2][2][4][2], const pg8::Unit& u, int wr, int wc, int fr, int fq, LAS unsigned char* lds, int wid, int lane) const {
        LAS float* Pl = (LAS float*)lds;
        LAS float* Sl = Pl + 1024;
        const int tid = wid * 64 + lane;
        panel_row_rinv(acc, u, wr, wc, fr, fq, Pl, Sl, tid, xbuf + (size_t)(u.pm * 256) * 4, cnt + 16 * u.pm);
        const int v = u.pm < 16 ? 0 : 1 + ((u.pm - 16) >> 4);
        const float* gate = MODl + (1 * 3 + v) * 3072 + 2048;
#pragma unroll
        for (int bj = 0; bj < 2; ++bj) {
            const int c8 = u.pn * 256 + bj * 128 + wc * 32 + 8 * fq;
            const f32x4 g0 = *(const f32x4*)(gpost + c8), g1 = *(const f32x4*)(gpost + c8 + 4);
            const f32x4 t0 = *(const f32x4*)(gate + c8), t1 = *(const f32x4*)(gate + c8 + 4);
#pragma unroll
            for (int ai = 0; ai < 2; ++ai)
#pragma unroll
                for (int m = 0; m < 4; ++m) {
                    const int rl = ai * 128 + wr * 64 + m * 16 + fr, row = u.pm * 256 + rl;
                    const float rinv = Sl[rl];
                    const u32x4 xr = *(const u32x4*)((row < MP ? X1P + (size_t)row * DM : X1S + (size_t)(row - MP) * DM) + c8);
                    const f32x4 y0 = acc[ai][bj][m][0], y1 = acc[ai][bj][m][1];
                    f32x4 o0, o1;
                    o0[0] = __uint_as_float(xr.x << 16) + t0[0] * (y0[0] * rinv * g0[0]); o0[1] = __uint_as_float(xr.x & 0xffff0000u) + t0[1] * (y0[1] * rinv * g0[1]);
                    o0[2] = __uint_as_float(xr.y << 16) + t0[2] * (y0[2] * rinv * g0[2]); o0[3] = __uint_as_float(xr.y & 0xffff0000u) + t0[3] * (y0[3] * rinv * g0[3]);
                    o1[0] = __uint_as_float(xr.z << 16) + t1[0] * (y1[0] * rinv * g1[0]); o1[1] = __uint_as_float(xr.z & 0xffff0000u) + t1[1] * (y1[1] * rinv * g1[1]);
                    o1[2] = __uint_as_float(xr.w << 16) + t1[2] * (y1[2] * rinv * g1[2]); o1[3] = __uint_as_float(xr.w & 0xffff0000u) + t1[3] * (y1[3] * rinv * g1[3]);
                    float* op = out + (size_t)row * DM + c8;
                    *(f32x4*)op = o0; *(f32x4*)(op + 4) = o1;
                }
        }
    }
};

struct EpiMid {
    static constexpr bool AFTER_DRAIN = true;
    const float* x_prompt; const float* x_sample; const float* MODl; const float* gpost; const float* gpre1; bf16_t* X1P; bf16_t* X1S; bf16_t* Hn; float* xbuf; unsigned* cnt;
    DI void fused(f32x4 (&acc)[2][2][4][2], const pg8::Unit& u, int wr, int wc, int fr, int fq, LAS unsigned char* lds, int wid, int lane) const {
        LAS float* Pl = (LAS float*)lds; LAS float* Sl = Pl + 1024;
        const int tid = wid * 64 + lane;
        panel_row_rinv(acc, u, wr, wc, fr, fq, Pl, Sl, tid, xbuf + (size_t)(12288 + u.pm * 256) * 4, cnt + 16 * (48 + u.pm));
        const int v = u.pm < 16 ? 0 : 1 + ((u.pm - 16) >> 4);
        const float* md0 = MODl + (0 * 3 + v) * 3072; const float* md1 = MODl + (1 * 3 + v) * 3072;
        const float* xbase = u.pm < 16 ? x_prompt + (size_t)(u.pm * 256) * DM : x_sample + (size_t)(u.pm * 256 - MP) * DM;
#pragma unroll
        for (int bj = 0; bj < 2; ++bj) {
            const int c8 = u.pn * 256 + bj * 128 + wc * 32 + 8 * fq;
            const f32x4 g0 = *(const f32x4*)(gpost + c8), g1 = *(const f32x4*)(gpost + c8 + 4);
            const f32x4 t0 = *(const f32x4*)(md0 + 2048 + c8), t1 = *(const f32x4*)(md0 + 2048 + c8 + 4);
#pragma unroll
            for (int ai = 0; ai < 2; ++ai)
#pragma unroll
                for (int m = 0; m < 4; ++m) {
                    const int rl = ai * 128 + wr * 64 + m * 16 + fr, row = u.pm * 256 + rl;
                    const float rinv = Sl[rl];
                    const f32x4 x0 = *(const f32x4*)(xbase + (size_t)rl * DM + c8), x1 = *(const f32x4*)(xbase + (size_t)rl * DM + c8 + 4);
                    f32x4 y0 = acc[ai][bj][m][0], y1 = acc[ai][bj][m][1];
#pragma unroll
                    for (int e = 0; e < 4; ++e) { y0[e] = x0[e] + t0[e] * (y0[e] * rinv * g0[e]); y1[e] = x1[e] + t1[e] * (y1[e] * rinv * g1[e]); }
                    acc[ai][bj][m][0] = y0; acc[ai][bj][m][1] = y1;
                    u32x4 w; w.x = cvtpk(y0[0], y0[1]); w.y = cvtpk(y0[2], y0[3]); w.z = cvtpk(y1[0], y1[1]); w.w = cvtpk(y1[2], y1[3]);
                    *(u32x4*)((row < MP ? X1P + (size_t)row * DM : X1S + (size_t)(row - MP) * DM) + c8) = w;
                }
        }
        panel_row_rinv(acc, u, wr, wc, fr, fq, Pl, Sl, tid, xbuf + (size_t)(2 * 12288 + u.pm * 256) * 4, cnt + 16 * (96 + u.pm));
#pragma unroll
        for (int bj = 0; bj < 2; ++bj) {
            const int c8 = u.pn * 256 + bj * 128 + wc * 32 + 8 * fq;
            const f32x4 g0 = *(const f32x4*)(gpre1 + c8), g1 = *(const f32x4*)(gpre1 + c8 + 4);
            const f32x4 a0 = *(const f32x4*)(md1 + 1024 + c8), a1 = *(const f32x4*)(md1 + 1024 + c8 + 4);
            const f32x4 b0 = *(const f32x4*)(md1 + c8), b1 = *(const f32x4*)(md1 + c8 + 4);
#pragma unroll
            for (int ai = 0; ai < 2; ++ai)
#pragma unroll
                for (int m = 0; m < 4; ++m) {
                    const int rl = ai * 128 + wr * 64 + m * 16 + fr, row = u.pm * 256 + rl;
                    const float r1 = Sl[rl];
                    const f32x4 y0 = acc[ai][bj][m][0], y1 = acc[ai][bj][m][1];
                    float o[8];
#pragma unroll
                    for (int e = 0; e < 4; ++e) { o[e] = y0[e] * r1 * g0[e] * (1.f + a0[e]) + b0[e]; o[4 + e] = y1[e] * r1 * g1[e] * (1.f + a1[e]) + b1[e]; }
                    u32x4 w; w.x = cvtpk(o[0], o[1]); w.y = cvtpk(o[2], o[3]); w.z = cvtpk(o[4], o[5]); w.w = cvtpk(o[6], o[7]);
                    *(u32x4*)(Hn + (size_t)row * DM + c8) = w;
                }
        }
    }
};

constexpr int AT_PITCH = 144, AT_TILE = 64 * AT_PITCH;
DI void attn_tile_load(int it, int nt0, const bf16_t* K0, int k0s, const bf16_t* V0, int v0s, const bf16_t* K1, int k1s, const bf16_t* V1, int v1s, int tid, u32x4& kr, u32x4& vr) {
    const int row = tid >> 3, pc = tid & 7;
    const bf16_t* K; const bf16_t* V; int ks, vs, tt;
    if (it < nt0) { K = K0; V = V0; ks = k0s; vs = v0s; tt = it; } else { K = K1; V = V1; ks = k1s; vs = v1s; tt = it - nt0; }
    kr = *(const u32x4*)(K + (size_t)(tt * 64 + row) * ks + pc * 8);
    vr = *(const u32x4*)(V + (size_t)row * vs + tt * 64 + pc * 8);
}
DI void attn_tile_store(LAS unsigned char* kb, LAS unsigned char* vb, int tid, const u32x4& kr, const u32x4& vr, bool nat) {
    const int row = tid >> 3, pc = tid & 7;
    *(LAS u32x4*)(kb + row * AT_PITCH + pc * 16) = kr;
    if (nat) { *(LAS u32x4*)(vb + row * AT_PITCH + pc * 16) = vr; return; }
    const int grp = pc >> 1, b3 = pc & 1;
    u32x2 lo = {vr.x, vr.y}, hi = {vr.z, vr.w};
    *(LAS u32x2*)(vb + row * AT_PITCH + (16 * grp + 4 * b3) * 2) = lo;
    *(LAS u32x2*)(vb + row * AT_PITCH + (16 * grp + 8 + 4 * b3) * 2) = hi;
}

DI void attn_qk(const LAS unsigned char* kb, const bf16x8 (&qf)[4], int l32, int half, float nm, f32x16& s0, f32x16& s1) {
    bf16x8 a[8];
#pragma unroll
    for (int s = 0; s < 4; ++s) {
        a[2 * s] = *(const LAS bf16x8*)(kb + l32 * AT_PITCH + s * 32 + half * 16);
        a[2 * s + 1] = *(const LAS bf16x8*)(kb + (32 + l32) * AT_PITCH + s * 32 + half * 16);
    }
    f32x16 nmC;
#pragma unroll
    for (int i = 0; i < 16; ++i) nmC[i] = nm;
    s0 = MFMA32(a[0], qf[0], nmC); s1 = MFMA32(a[1], qf[0], nmC);
#pragma unroll
    for (int s = 1; s < 4; ++s) { s0 = MFMA32(a[2 * s], qf[s], s0); s1 = MFMA32(a[2 * s + 1], qf[s], s1); }
}
DI void attn_bias(f32x16& s0, f32x16& s1, const LAS float* bp, int half, int cs) {
#pragma unroll
    for (int i = 0; i < 16; ++i) {
        const int kc0 = 8 * (i >> 2) + (i & 3);
        const int kca = kc0 + 4 * half, kcb = kca + 32;
        const float b0 = bp[kc0], b1 = bp[kc0 + 32];
        s0[i] = ((unsigned)(kca - cs) < 16u) ? s0[i] + b0 : -1e30f;
        s1[i] = ((unsigned)(kcb - cs) < 16u) ? s1[i] + b1 : -1e30f;
    }
}
DI float attn_max(const f32x16& s0, const f32x16& s1) {
    float mx = fmaxf(s0[0], s1[0]);
#pragma unroll
    for (int i = 1; i < 16; ++i) mx = fmaxf(mx, fmaxf(s0[i], s1[i]));
    return mx;
}
DI void attn_pv(const LAS unsigned char* vb, f32x16& s0, f32x16& s1, int l32, int half, const bf16x8& ones, f32x16& o0, f32x16& o1, f32x16& lacc) {
    bf16x8 v[8];
#pragma unroll
    for (int s = 0; s < 4; ++s) {
        v[2 * s] = *(const LAS bf16x8*)(vb + l32 * AT_PITCH + (16 * s + 8 * half) * 2);
        v[2 * s + 1] = *(const LAS bf16x8*)(vb + (32 + l32) * AT_PITCH + (16 * s + 8 * half) * 2);
    }
#pragma unroll
    for (int i = 0; i < 16; ++i) { s0[i] = __builtin_amdgcn_exp2f(s0[i]); s1[i] = __builtin_amdgcn_exp2f(s1[i]); }
    bf16x8 pf[4];
    pf[0] = pack8(s0[0], s0[1], s0[2], s0[3], s0[4], s0[5], s0[6], s0[7]);
    pf[1] = pack8(s0[8], s0[9], s0[10], s0[11], s0[12], s0[13], s0[14], s0[15]);
    pf[2] = pack8(s1[0], s1[1], s1[2], s1[3], s1[4], s1[5], s1[6], s1[7]);
    pf[3] = pack8(s1[8], s1[9], s1[10], s1[11], s1[12], s1[13], s1[14], s1[15]);
#pragma unroll
    for (int s = 0; s < 4; ++s) {
        o0 = MFMA32(v[2 * s], pf[s], o0); o1 = MFMA32(v[2 * s + 1], pf[s], o1);
        lacc = MFMA32(ones, pf[s], lacc);
    }
}

DI void attn_qk32(const LAS unsigned char* kb, const bf16x8 (&qf)[4], int krow, int half, float nm, f32x16& sv) {
    f32x16 nmC;
#pragma unroll
    for (int i = 0; i < 16; ++i) nmC[i] = nm;
    const LAS unsigned char* p = kb + krow * AT_PITCH + half * 16;
    sv = MFMA32(*(const LAS bf16x8*)p, qf[0], nmC);
#pragma unroll
    for (int s = 1; s < 4; ++s) sv = MFMA32(*(const LAS bf16x8*)(p + s * 32), qf[s], sv);
}
DI void attn_bias32(f32x16& sv, const LAS float* bp, int kcb, bool rowvalid) {
#pragma unroll
    for (int i = 0; i < 16; ++i) {
        const int kc0 = 8 * (i >> 2) + (i & 3);
        const float b0 = bp[kc0];
        sv[i] = (rowvalid && (unsigned)(kcb + kc0) < 16u) ? sv[i] + b0 : -1e30f;
    }
}
DI float attn_max16(const f32x16& sv) {
    float mx = sv[0];
#pragma unroll
    for (int i = 1; i < 16; ++i) mx = fmaxf(mx, sv[i]);
    return mx;
}
DI void attn_pv32(const LAS unsigned char* vb, f32x16& sv, int l32, int half, int k0, const bf16x8& ones, f32x16& o0, f32x16& o1, f32x16& lacc) {
#pragma unroll
    for (int i = 0; i < 16; ++i) sv[i] = __builtin_amdgcn_exp2f(sv[i]);
    const bf16x8 pf0 = pack8(sv[0], sv[1], sv[2], sv[3], sv[4], sv[5], sv[6], sv[7]);
    const bf16x8 pf1 = pack8(sv[8], sv[9], sv[10], sv[11], sv[12], sv[13], sv[14], sv[15]);
#pragma unroll
    for (int s2 = 0; s2 < 2; ++s2) {
        const LAS unsigned char* p0 = vb + l32 * AT_PITCH + (k0 + 16 * s2 + 4 * half) * 2;
        const LAS unsigned char* p1 = p0 + 32 * AT_PITCH;
        const s16x4 lo0 = *(const LAS s16x4*)p0, hi0 = *(const LAS s16x4*)(p0 + 16);
        const s16x4 lo1 = *(const LAS s16x4*)p1, hi1 = *(const LAS s16x4*)(p1 + 16);
        const bf16x8 A0 = __builtin_shufflevector(lo0, hi0, 0, 1, 2, 3, 4, 5, 6, 7);
        const bf16x8 A1 = __builtin_shufflevector(lo1, hi1, 0, 1, 2, 3, 4, 5, 6, 7);
        o0 = MFMA32(A0, s2 == 0 ? pf0 : pf1, o0); o1 = MFMA32(A1, s2 == 0 ? pf0 : pf1, o1);
        lacc = MFMA32(ones, s2 == 0 ? pf0 : pf1, lacc);
    }
}

template <int MODE>
DI void attn_item(LAS unsigned char* lds, int tid,
                  const bf16_t* Q, int qstride,
                  const bf16_t* K0, int k0s, const bf16_t* V0, int v0s, int nt0,
                  const bf16_t* K1, int k1s, const bf16_t* V1, int v1s, int nt1,
                  int r0, int rs_lo, const LAS float* rpbL,
                  const bf16_t* Z, int zstride, bf16_t* O, int ostride, const WT& wt, bool usewt, unsigned* pcnt) {
    const int lane = tid & 63, w = tid >> 6, l32 = lane & 31, half = lane >> 5;
    const int np = (nt0 + nt1 + 1) >> 1;
    const int ng = w & 3, nrp = w >> 2;
    const int qc = (MODE == 1) ? 16 * ng + (l32 & 15) : 0;
    const int qrw = (MODE == 1) ? 2 * nrp + (l32 >> 4) : 0;
    const int qr = r0 + qrw;
    const int qrow = (MODE == 1) ? qrw * 64 + qc : w * 32 + l32;
    const int k0 = (ng == 0) ? 0 : (ng == 1) ? 8 : (ng == 2) ? 24 : 32;
    bf16x8 qf[4];
#pragma unroll
    for (int s = 0; s < 4; ++s) qf[s] = *(const bf16x8*)(Q + (size_t)qrow * qstride + 16 * s + 8 * half);
    f32x16 o0, o1, lacc;
#pragma unroll
    for (int i = 0; i < 16; ++i) { o0[i] = 0.f; o1[i] = 0.f; lacc[i] = 0.f; }
    float m_run = 0.f;
    const bf16x8 ones = {0x3F80, 0x3F80, 0x3F80, 0x3F80, 0x3F80, 0x3F80, 0x3F80, 0x3F80};
    const int cs = min(max(qc - 8, 0), 48);
    const int rsq = min(max(qr - 4, 0), 56);
    const int rsw_lo = min(max(r0 + 2 * nrp - 4, 0), 56), rsw_hi = min(max(r0 + 2 * nrp + 1 - 4, 0), 56) + 8;

    u32x4 eka, eva, ekb, evb;
#define AT_LOAD(pair, ka, va, kb_, vb_) do { attn_tile_load(2 * (pair), nt0, K0, k0s, V0, v0s, K1, k1s, V1, v1s, tid, ka, va); \
        attn_tile_load(2 * (pair) + 1, nt0, K0, k0s, V0, v0s, K1, k1s, V1, v1s, tid, kb_, vb_); } while (0)
#define AT_STORE(stage, pair, ka, va, kb_, vb_) do { LAS unsigned char* nb_ = lds + (stage) * 4 * AT_TILE; const bool nat_ = (MODE == 1) && (2 * (pair) >= nt0); \
        attn_tile_store(nb_, nb_ + AT_TILE, tid, ka, va, nat_); attn_tile_store(nb_ + 2 * AT_TILE, nb_ + 3 * AT_TILE, tid, kb_, vb_, nat_); } while (0)
#define AT_SLOWPATH(ip_, EXTRA) \
            mx = fmaxf(mx, __shfl_xor(mx, 32)); \
            const bool need = ((ip_) == 0) || (mx > 8.f); \
            if (__builtin_amdgcn_ballot_w64(need) != 0ull) { \
                const float delta = need ? mx : 0.f; \
                const float alpha = __builtin_amdgcn_exp2f(-delta); \
                m_run += delta; \
                _Pragma("unroll") for (int i = 0; i < 16; ++i) { EXTRA; o0[i] *= alpha; o1[i] *= alpha; lacc[i] *= alpha; } \
            }
#define AT_COMPUTE(ip_) do { \
        LAS unsigned char* base = lds + ((ip_) & 1) * 4 * AT_TILE; \
        const int ita = 2 * (ip_), itb = 2 * (ip_) + 1; \
        if (MODE == 1 && ita >= nt0) { \
            const int kra_ = rs_lo + (ita - nt0), krb_ = kra_ + 1; \
            const bool acta = (kra_ >= rsw_lo) && (kra_ < rsw_hi), actb = (krb_ >= rsw_lo) && (krb_ < rsw_hi); \
            if (acta || actb) { \
                f32x16 sa, sb; \
                _Pragma("unroll") for (int i = 0; i < 16; ++i) { sa[i] = -1e30f; sb[i] = -1e30f; } \
                float mx = -3.0e38f; \
                if (acta) { attn_qk32(base, qf, k0 + l32, half, -m_run, sa); \
                    attn_bias32(sa, rpbL + 64 + (kra_ - qr + 7) * 31 + (k0 - qc + 15) + 4 * half, k0 + 4 * half - cs, (kra_ >= rsq) && (kra_ < rsq + 8)); mx = attn_max16(sa); } \
                if (actb) { attn_qk32(base + 2 * AT_TILE, qf, k0 + l32, half, -m_run, sb); \
                    attn_bias32(sb, rpbL + 64 + (krb_ - qr + 7) * 31 + (k0 - qc + 15) + 4 * half, k0 + 4 * half - cs, (krb_ >= rsq) && (krb_ < rsq + 8)); mx = fmaxf(mx, attn_max16(sb)); } \
                AT_SLOWPATH(ip_, sa[i] -= delta; sb[i] -= delta) \
                if (acta) attn_pv32(base + AT_TILE, sa, l32, half, k0, ones, o0, o1, lacc); \
                if (actb) attn_pv32(base + 3 * AT_TILE, sb, l32, half, k0, ones, o0, o1, lacc); \
            } \
        } else { \
            f32x16 sa0, sa1, sb0, sb1; \
            attn_qk(base, qf, l32, half, -m_run, sa0, sa1); \
            attn_qk(base + 2 * AT_TILE, qf, l32, half, -m_run, sb0, sb1); \
            float mx = fmaxf(attn_max(sa0, sa1), attn_max(sb0, sb1)); \
            AT_SLOWPATH(ip_, sa0[i] -= delta; sa1[i] -= delta; sb0[i] -= delta; sb1[i] -= delta) \
            attn_pv(base + AT_TILE, sa0, sa1, l32, half, ones, o0, o1, lacc); \
            attn_pv(base + 3 * AT_TILE, sb0, sb1, l32, half, ones, o0, o1, lacc); \
        } } while (0)
    AT_LOAD(0, eka, eva, ekb, evb);
    AT_STORE(0, 0, eka, eva, ekb, evb);
    __syncthreads();
    for (int ip = 0; ip < np; ++ip) {
        if (ip + 1 < np) AT_LOAD(ip + 1, eka, eva, ekb, evb);
        AT_COMPUTE(ip);
        if (ip + 1 < np) AT_STORE((ip + 1) & 1, ip + 1, eka, eva, ekb, evb);
        __syncthreads();
    }
#undef AT_LOAD
#undef AT_STORE
#undef AT_COMPUTE
#undef AT_SLOWPATH
    const float inv = 1.f / lacc[0];
    {
        LAS float* ot = (LAS float*)lds;
#pragma unroll
        for (int dt = 0; dt < 2; ++dt)
#pragma unroll
            for (int i = 0; i < 16; ++i) ot[qrow * 65 + dt * 32 + crow(i, half)] = (dt == 0 ? o0[i] : o1[i]) * inv;
        __syncthreads();
#pragma unroll
        for (int j = 0; j < 4; ++j) {
            const int idx = tid + 512 * j, row = idx >> 3, pc = idx & 7;
            const u32x4 zz = *(const u32x4*)(Z + (size_t)row * zstride + pc * 8);
            const LAS float* sp = ot + row * 65 + pc * 8;
            u32x4 ov;
            ov.x = cvtpk(sp[0] * __uint_as_float(zz.x << 16), sp[1] * __uint_as_float(zz.x & 0xffff0000u));
            ov.y = cvtpk(sp[2] * __uint_as_float(zz.y << 16), sp[3] * __uint_as_float(zz.y & 0xffff0000u));
            ov.z = cvtpk(sp[4] * __uint_as_float(zz.z << 16), sp[5] * __uint_as_float(zz.z & 0xffff0000u));
            ov.w = cvtpk(sp[6] * __uint_as_float(zz.w << 16), sp[7] * __uint_as_float(zz.w & 0xffff0000u));
            if (usewt) wt16(wt, O + (size_t)row * ostride + pc * 8, ov); else *(u32x4*)(O + (size_t)row * ostride + pc * 8) = ov;
        }
        if (pcnt) asm volatile("s_waitcnt vmcnt(0)" ::: "memory");
        __syncthreads();
        if (pcnt && tid == 0) __hip_atomic_fetch_add(pcnt, 1u, __ATOMIC_RELAXED, __HIP_MEMORY_SCOPE_AGENT);
    }
}

DI int chain_base(int sid, int h, int dir) { return sid < 16 ? ((sid * 4 + h) * 2 + dir) * 2 : 256 + (((sid - 16) * 4 + h) * 2 + dir) * 32; }
DI int seq_rowbase(int sid) { return sid < 16 ? sid * 256 : MP + (sid - 16) * 4096; }
DI float chain_m0(const float* state_m, int sid, int h, int dir) { return sid < 16 ? 0.f : state_m[((sid - 16) * 2 + dir) * 4 + h]; }
DI float chain_m_at(const float* CH, int base, int js, float m0) {
    float m = m0;
    for (int i = 0; i < js; ++i) { const float bL = CH[(base + i) * 2], rmL = CH[(base + i) * 2 + 1]; m = bL + fmaxf(m, rmL); }
    return m;
}

DI void gate_scan_item(int sid, int h, int dir, int js, int lane, const float* G, const float* bg, float* SC, float* CH) {
    const int nc = sid < 16 ? 2 : 32, T = nc * 128, rb = seq_rowbase(sid);
    const float bi = bg[(dir * 2) * 4 + h], bff = bg[(dir * 2 + 1) * 4 + h];
    float ig[2], lf[2]; int row[2];
#pragma unroll
    for (int e = 0; e < 2; ++e) {
        const int Ppos = js * 128 + 2 * lane + e; const int t = dir ? (T - 1 - Ppos) : Ppos; row[e] = rb + t;
        ig[e] = G[(size_t)row[e] * 16 + (dir * 2) * 4 + h] + bi;
        const float fg = G[(size_t)row[e] * 16 + (dir * 2 + 1) * 4 + h] + bff;
        lf[e] = fminf(fg, 0.f) - log1pf(expf(-fabsf(fg)));
    }
    const float tot = lf[0] + lf[1];
    float x = tot;
#pragma unroll
    for (int o = 1; o < 64; o <<= 1) { const float y = __shfl_up(x, o); if (lane >= o) x += y; }
    const float excl = x - tot;
    const float b0 = excl + lf[0], b1 = excl + tot;
    const float a0 = ig[0] - b0, a1 = ig[1] - b1;
    const float lm = fmaxf(a0, a1);
    float xm = lm;
#pragma unroll
    for (int o = 1; o < 64; o <<= 1) { const float y = __shfl_up(xm, o); if (lane >= o) xm = fmaxf(xm, y); }
    float em = __shfl_up(xm, 1); if (lane == 0) em = -3.0e38f;
    const float rm0 = fmaxf(em, a0), rm1 = fmaxf(em, lm);
    *(f32x4*)(SC + ((size_t)row[0] * 8 + h * 2 + dir) * 4) = (f32x4){a0, b0, rm0, 0.f};
    *(f32x4*)(SC + ((size_t)row[1] * 8 + h * 2 + dir) * 4) = (f32x4){a1, b1, rm1, 0.f};
    if (lane == 63) { const int slot = chain_base(sid, h, dir) + js; CH[slot * 2] = b1; CH[slot * 2 + 1] = rm1; }
}

DI void qknorm_item(int row, int lane, const u32x4 (&rawqk)[2], const float* gq, const float* gk, bf16_t* Qb, bf16_t* Kb, float* out) {
    const bool sample = row >= MP;
    const int t = sample ? ((row - MP) & 4095) : 0;
    const int grow = t >> 6, gcol = t & 63;
    const int sub = lane & 7, d0 = sub * 8;
    const float pos = (float)((sub < 4) ? grow : gcol);
#pragma unroll
    for (int pass = 0; pass < 2; ++pass) {
        const u32x4 raw = rawqk[pass];
        float x[8];
        x[0] = __uint_as_float(raw.x << 16); x[1] = __uint_as_float(raw.x & 0xffff0000u);
        x[2] = __uint_as_float(raw.y << 16); x[3] = __uint_as_float(raw.y & 0xffff0000u);
        x[4] = __uint_as_float(raw.z << 16); x[5] = __uint_as_float(raw.z & 0xffff0000u);
        x[6] = __uint_as_float(raw.w << 16); x[7] = __uint_as_float(raw.w & 0xffff0000u);
        float ss = 0.f;
#pragma unroll
        for (int e = 0; e < 8; ++e) ss += x[e] * x[e];
        ss += __shfl_xor(ss, 1); ss += __shfl_xor(ss, 2); ss += __shfl_xor(ss, 4);
        const float r = rsqrtf(ss * (1.f / 64.f) + EPS);
        const float* gw = pass == 0 ? gq : gk;
        float y[8];
#pragma unroll
        for (int e = 0; e < 8; ++e) y[e] = x[e] * r * gw[d0 + e];
        if (pass == 1 && !sample && lane < 16) {
            const int hk = lane >> 3, b = row >> 8, tt = row & 255;
            float* o = out + O_GK + ((size_t)((b * 2 + hk) * 256 + tt)) * 64 + d0;
            *(f32x4*)o = (f32x4){y[0], y[1], y[2], y[3]}; *(f32x4*)(o + 4) = (f32x4){y[4], y[5], y[6], y[7]};
        }
        float z[8];
#pragma unroll
        for (int e = 0; e < 8; ++e) {
            const float partner = __shfl_xor(y[e], 2);
            if (sample) {
                const int i = (d0 + e) & 15;
                const float freq = __builtin_amdgcn_exp2f(-(float)i * (13.287712379549449f / 16.f));
                float rev = pos * freq * 0.15915494309189535f; rev -= floorf(rev);
                const float sn = __builtin_amdgcn_sinf(rev), cn = __builtin_amdgcn_cosf(rev);
                z[e] = (sub & 2) ? (partner * sn + y[e] * cn) : (y[e] * cn - partner * sn);
            } else z[e] = y[e];
        }
        if (pass == 0) {
#pragma unroll
            for (int e = 0; e < 8; ++e) z[e] *= QSCALE;
            u32x4 w; w.x = cvtpk(z[0], z[1]); w.y = cvtpk(z[2], z[3]); w.z = cvtpk(z[4], z[5]); w.w = cvtpk(z[6], z[7]);
            *(u32x4*)(Qb + (size_t)row * 512 + lane * 8) = w;
        } else if (lane < 16) {
            u32x4 w; w.x = cvtpk(z[0], z[1]); w.y = cvtpk(z[2], z[3]); w.z = cvtpk(z[4], z[5]); w.w = cvtpk(z[6], z[7]);
            *(u32x4*)(Kb + (size_t)row * 128 + lane * 8) = w;
        }
    }
}

DI void mlstm_u_item(LAS unsigned char* lds, int tid, int sid, int h, int dir, int js,
                     const float* SC, const float* CH, const float* state_m, const bf16_t* KT, const bf16_t* VT, bf16_t* U, float* Un, const WT& wtw, unsigned* ucnt) {
    const int lane = tid & 63, w = tid >> 6, l32 = lane & 31, half = lane >> 5;
    const int nc = sid < 16 ? 2 : 32, rb = seq_rowbase(sid);
    const int jt = dir ? nc - 1 - js : js, R0 = rb + jt * 128;
    const int base = chain_base(sid, h, dir), slot = base + js;
    const float Mx = CH[slot * 2 + 1];
    LAS float* wkL = (LAS float*)lds;
    if (tid < 128) wkL[tid] = expf(SC[((size_t)(R0 + tid) * 8 + h * 2 + dir) * 4] - Mx);
    const int vi = w & 3, kh = w >> 2;
    f32x16 acc0, acc1;
#pragma unroll
    for (int i = 0; i < 16; ++i) { acc0[i] = 0.f; acc1[i] = 0.f; }
    LAS unsigned char* VtL = lds + 1024; LAS unsigned char* KtL = lds + 1024 + 34816;
    {
        u32x4 rv[8];
        const int r0 = tid >> 4, pc = tid & 15;
        const bf16_t* gv = VT + (size_t)(h * 128 + r0) * MROWS + R0 + pc * 8;
        const bf16_t* gk = KT + (size_t)(h * 128 + r0) * MROWS + R0 + pc * 8;
#pragma unroll
        for (int i = 0; i < 8; ++i) rv[i] = *(const u32x4*)((i >> 2 ? gk : gv) + (size_t)(32 * (i & 3)) * MROWS);
        LAS unsigned char* lv = VtL + r0 * 272 + pc * 16;
#pragma unroll
        for (int i = 0; i < 8; ++i) *(LAS u32x4*)(lv + (i >> 2) * 34816 + (32 * (i & 3)) * 272) = rv[i];
    }
    __syncthreads();
#pragma unroll
    for (int s = 0; s < 8; ++s) {
        const int so = 16 * s + 8 * half;
        const u32x4 raw = *(const LAS u32x4*)(VtL + (vi * 32 + l32) * 272 + so * 2);
        const bf16x8 B0 = *(const LAS bf16x8*)(KtL + (kh * 64 + l32) * 272 + so * 2);
        const bf16x8 B1 = *(const LAS bf16x8*)(KtL + (kh * 64 + 32 + l32) * 272 + so * 2);
        const f32x4 wa = *(const LAS f32x4*)(wkL + so), wb = *(const LAS f32x4*)(wkL + so + 4);
        const bf16x8 A = pack8(__uint_as_float(raw.x << 16) * wa[0], __uint_as_float(raw.x & 0xffff0000u) * wa[1], __uint_as_float(raw.y << 16) * wa[2], __uint_as_float(raw.y & 0xffff0000u) * wa[3],
                               __uint_as_float(raw.z << 16) * wb[0], __uint_as_float(raw.z & 0xffff0000u) * wb[1], __uint_as_float(raw.w << 16) * wb[2], __uint_as_float(raw.w & 0xffff0000u) * wb[3]);
        acc0 = MFMA32(A, B0, acc0); acc1 = MFMA32(A, B1, acc1);
    }
    bf16_t* Uo = U + (size_t)slot * 16384;
    {
        LAS unsigned char* st = lds + 1024 + 2 * 34816 + w * 4608;
#pragma unroll
        for (int i = 0; i < 16; ++i) {
            const int v = crow(i, half);
            *(LAS bf16_t*)(st + v * 144 + l32 * 2) = f2bf(acc0[i]);
            *(LAS bf16_t*)(st + v * 144 + (32 + l32) * 2) = f2bf(acc1[i]);
        }
        asm volatile("s_waitcnt lgkmcnt(0)" ::: "memory");
#pragma unroll
        for (int j = 0; j < 4; ++j) {
            const int pidx = lane + 64 * j, row = pidx >> 3, pc = pidx & 7;
            const u32x4 val = *(const LAS u32x4*)(st + row * 144 + pc * 16);
            wt16(wtw, Uo + (vi * 32 + row) * 128 + kh * 64 + pc * 8, val);
        }
    }
    if (tid < 128) {
        float s = 0.f;
#pragma unroll
        for (int j = 0; j < 16; ++j) {
            const u32x4 raw = *(const LAS u32x4*)(KtL + tid * 272 + j * 16);
            s += __uint_as_float(raw.x << 16) * wkL[8 * j] + __uint_as_float(raw.x & 0xffff0000u) * wkL[8 * j + 1]
               + __uint_as_float(raw.y << 16) * wkL[8 * j + 2] + __uint_as_float(raw.y & 0xffff0000u) * wkL[8 * j + 3]
               + __uint_as_float(raw.z << 16) * wkL[8 * j + 4] + __uint_as_float(raw.z & 0xffff0000u) * wkL[8 * j + 5]
               + __uint_as_float(raw.w << 16) * wkL[8 * j + 6] + __uint_as_float(raw.w & 0xffff0000u) * wkL[8 * j + 7];
        }
        __hip_atomic_store(Un + slot * 128 + tid, s, __ATOMIC_RELAXED, __HIP_MEMORY_SCOPE_AGENT);
    }
    asm volatile("s_waitcnt vmcnt(0)" ::: "memory");
    __syncthreads();
    if (tid == 0 && ucnt) __hip_atomic_fetch_add(ucnt + 16 * (sid < 16 ? (sid * 4 + h) * 2 + dir : 128 + ((sid - 16) * 4 + h) * 2 + dir), 1u, __ATOMIC_RELAXED, __HIP_MEMORY_SCOPE_AGENT);
}

constexpr int ML_PITCH = 272, ML_ARR = 128 * ML_PITCH;
constexpr int ML_SCAL = 4 * ML_ARR;
DI void mlstm_out_item(LAS unsigned char* lds, int tid, int sid, int h, int jt,
                       const float* SC, const float* MJp, const float* nst, const bf16_t* Cst,
                       const bf16_t* P, const bf16_t* VT, const float* ghn, bf16_t* Yg, const WT& wtd, bool usewt, unsigned* pcnt) {
    const int lane = tid & 63, w = tid >> 6, l32 = lane & 31, half = lane >> 5;
    const int wt = w & 3, vh = w >> 2;
    const int nc = sid < 16 ? 2 : 32, rb = seq_rowbase(sid), R0 = rb + jt * 128;
    LAS unsigned char* KL = lds; LAS unsigned char* VL = lds + ML_ARR; LAS unsigned char* CL = lds + 2 * ML_ARR;
    LAS float* aL = (LAS float*)(lds + ML_SCAL);
    LAS float* nL = aL + 256;
    LAS float* ssqL = nL + 256;
    const int tl = wt * 32 + l32;
    const int qrow = R0 + tl;
    const int slot0 = chain_base(sid, h, 0) + jt, slot1 = chain_base(sid, h, 1) + (nc - 1 - jt);
    bf16x8 qf[8];
#pragma unroll
    for (int s = 0; s < 8; ++s) qf[s] = *(const bf16x8*)(P + (size_t)qrow * NP + C_QA + h * 128 + 16 * s + 8 * half);
    {
        u32x4 rk[4], rv[4], rc0[4], rc1[4];
#pragma unroll
        for (int i = 0; i < 4; ++i) {
            const int idx = tid + 512 * i, row = idx >> 4, pc = idx & 15;
            rk[i] = *(const u32x4*)(P + (size_t)(R0 + row) * NP + C_KA + h * 128 + pc * 8);
            rv[i] = *(const u32x4*)(VT + (size_t)(h * 128 + row) * MROWS + R0 + pc * 8);
            rc0[i] = *(const u32x4*)(Cst + (size_t)slot0 * 16384 + row * 128 + pc * 8);
            rc1[i] = *(const u32x4*)(Cst + (size_t)slot1 * 16384 + row * 128 + pc * 8);
        }
        float av = 0.f, nv = 0.f;
        if (tid < 256) {
            const int dir = tid >> 7, s2 = tid & 127;
            av = SC[((size_t)(R0 + s2) * 8 + h * 2 + dir) * 4];
            nv = nst[(size_t)(dir ? slot1 : slot0) * 128 + s2];
        }
#pragma unroll
        for (int i = 0; i < 4; ++i) {
            const int idx = tid + 512 * i, row = idx >> 4, pc = idx & 15;
            *(LAS u32x4*)(KL + row * ML_PITCH + pc * 16) = rk[i];
            *(LAS u32x4*)(CL + row * ML_PITCH + pc * 16) = rc0[i];
            *(LAS u32x4*)(CL + ML_ARR + row * ML_PITCH + pc * 16) = rc1[i];
            const int grp = pc >> 1, b3 = pc & 1;
            u32x2 lo = {rv[i].x, rv[i].y}, hi = {rv[i].z, rv[i].w};
            *(LAS u32x2*)(VL + row * ML_PITCH + (16 * grp + 4 * b3) * 2) = lo;
            *(LAS u32x2*)(VL + row * ML_PITCH + (16 * grp + 8 + 4 * b3) * 2) = hi;
        }
        if (tid < 256) { aL[tid] = av; nL[tid] = nv; }
    }
    __syncthreads();
    f32x16 hs0, hs1;
#pragma unroll
    for (int i = 0; i < 16; ++i) { hs0[i] = 0.f; hs1[i] = 0.f; }
#pragma unroll 1
    for (int dir = 0; dir < 2; ++dir) {
        const int js = dir ? nc - 1 - jt : jt;
        const float m = MJp[chain_base(sid, h, dir) + js];
        const f32x4 sc = *(const f32x4*)(SC + ((size_t)qrow * 8 + h * 2 + dir) * 4);
        const float mx = fmaxf(m, sc[2]);
        const float u_t = -mx, w_inter = expf(m - mx), flo = expf(-(sc[1] + mx));
        f32x16 a0, a1;
#pragma unroll
        for (int i = 0; i < 16; ++i) { a0[i] = 0.f; a1[i] = 0.f; }
        const LAS unsigned char* Cp = CL + dir * ML_ARR + (vh * 64 + l32) * ML_PITCH + 16 * half;
#pragma unroll
        for (int s = 0; s < 8; ++s) {
            const bf16x8 A0 = *(const LAS bf16x8*)(Cp + 32 * s);
            const bf16x8 A1 = *(const LAS bf16x8*)(Cp + 32 * ML_PITCH + 32 * s);
            a0 = MFMA32(A0, qf[s], a0); a1 = MFMA32(A1, qf[s], a1);
        }
#pragma unroll
        for (int i = 0; i < 16; ++i) { a0[i] *= w_inter; a1[i] *= w_inter; }
        float dq = 0.f;
#pragma unroll
        for (int s = 0; s < 8; ++s)
#pragma unroll
            for (int e = 0; e < 8; ++e) dq += bf2f((unsigned short)qf[s][e]) * nL[dir * 128 + 16 * s + 8 * half + e];
        dq += __shfl_xor(dq, 32);
        float rsum = 0.f;
        const int st_lo = dir ? wt : 0, st_hi = dir ? 3 : wt;
        for (int st = st_lo; st <= st_hi; ++st) {
            f32x16 S;
#pragma unroll
            for (int i = 0; i < 16; ++i) S[i] = 0.f;
            const LAS unsigned char* Kp = KL + (st * 32 + l32) * ML_PITCH + 16 * half;
#pragma unroll
            for (int s = 0; s < 8; ++s) { const bf16x8 A = *(const LAS bf16x8*)(Kp + 32 * s); S = MFMA32(A, qf[s], S); }
#pragma unroll
            for (int i = 0; i < 16; ++i) {
                const int sl = st * 32 + crow(i, half);
                const bool valid = dir ? (sl >= tl) : (sl <= tl);
                const float dcy = __expf(u_t + aL[dir * 128 + sl]);
                const float p = valid ? S[i] * dcy : 0.f;
                S[i] = p; rsum += p;
            }
            const bf16x8 pf0 = pack8(S[0], S[1], S[2], S[3], S[4], S[5], S[6], S[7]);
            const bf16x8 pf1 = pack8(S[8], S[9], S[10], S[11], S[12], S[13], S[14], S[15]);
            const LAS unsigned char* Vp = VL + (vh * 64 + l32) * ML_PITCH + (st * 32 + 8 * half) * 2;
            {
                const bf16x8 A0 = *(const LAS bf16x8*)(Vp), A1 = *(const LAS bf16x8*)(Vp + 32 * ML_PITCH);
                a0 = MFMA32(A0, pf0, a0); a1 = MFMA32(A1, pf0, a1);
                const bf16x8 B0 = *(const LAS bf16x8*)(Vp + 32), B1 = *(const LAS bf16x8*)(Vp + 32 * ML_PITCH + 32);
                a0 = MFMA32(B0, pf1, a0); a1 = MFMA32(B1, pf1, a1);
            }
        }
        rsum += __shfl_xor(rsum, 32);
        const float den = w_inter * dq + rsum;
        const float inv = 1.f / fmaxf(fabsf(den), flo);
#pragma unroll
        for (int i = 0; i < 16; ++i) { hs0[i] += a0[i] * inv; hs1[i] += a1[i] * inv; }
    }
    float ssq = 0.f;
#pragma unroll
    for (int i = 0; i < 16; ++i) ssq += hs0[i] * hs0[i] + hs1[i] * hs1[i];
    ssq += __shfl_xor(ssq, 32);
    if (half == 0) ssqL[w * 32 + l32] = ssq;
    __syncthreads();
    const float tot = ssq + ssqL[(w ^ 4) * 32 + l32];
    const float rn = rsqrtf(tot * (1.f / 128.f) + EPS);
    {
        LAS float* ht = (LAS float*)lds;
#pragma unroll
        for (int vt = 0; vt < 2; ++vt)
#pragma unroll
            for (int i = 0; i < 16; ++i) ht[tl * 129 + vh * 64 + vt * 32 + crow(i, half)] = (vt == 0 ? hs0[i] : hs1[i]) * rn;
        __syncthreads();
#pragma unroll
        for (int j = 0; j < 4; ++j) {
            const int idx = tid + 512 * j, row = idx >> 4, pc = idx & 15, col = h * 128 + pc * 8;
            const bf16_t* prow = P + (size_t)(R0 + row) * NP;
            const u32x4 oa = *(const u32x4*)(prow + C_OA + col), zz = *(const u32x4*)(prow + C_Z + col);
            const f32x4 g0 = *(const f32x4*)(ghn + col), g1 = *(const f32x4*)(ghn + col + 4);
            const LAS float* sp = ht + row * 129 + pc * 8;
            u32x4 ov;
            ov.x = cvtpk(sp[0] * g0[0] * sigmf(__uint_as_float(oa.x << 16)) * __uint_as_float(zz.x << 16), sp[1] * g0[1] * sigmf(__uint_as_float(oa.x & 0xffff0000u)) * __uint_as_float(zz.x & 0xffff0000u));
            ov.y = cvtpk(sp[2] * g0[2] * sigmf(__uint_as_float(oa.y << 16)) * __uint_as_float(zz.y << 16), sp[3] * g0[3] * sigmf(__uint_as_float(oa.y & 0xffff0000u)) * __uint_as_float(zz.y & 0xffff0000u));
            ov.z = cvtpk(sp[4] * g1[0] * sigmf(__uint_as_float(oa.z << 16)) * __uint_as_float(zz.z << 16), sp[5] * g1[1] * sigmf(__uint_as_float(oa.z & 0xffff0000u)) * __uint_as_float(zz.z & 0xffff0000u));
            ov.w = cvtpk(sp[6] * g1[2] * sigmf(__uint_as_float(oa.w << 16)) * __uint_as_float(zz.w << 16), sp[7] * g1[3] * sigmf(__uint_as_float(oa.w & 0xffff0000u)) * __uint_as_float(zz.w & 0xffff0000u));
            if (usewt) wt16(wtd, Yg + (size_t)(R0 + row) * DM + col, ov); else *(u32x4*)(Yg + (size_t)(R0 + row) * DM + col) = ov;
        }
    }
    if (pcnt) asm volatile("s_waitcnt vmcnt(0)" ::: "memory");
    __syncthreads();
    if (pcnt && tid == 0) __hip_atomic_fetch_add(pcnt + 16 * (R0 >> 8), 1u, __ATOMIC_RELAXED, __HIP_MEMORY_SCOPE_AGENT);
}

DI void transpose_item(const float* W, int K, int N, bf16_t* WT, LAS float* scr, int item, int lane) {
    const int nblk = (N + 31) / 32, kb = item / nblk, nb = item % nblk, k0 = 64 * kb, n0 = 32 * nb;
    const int nn = n0 + (lane & 31);
    float tv[32];
#pragma unroll
    for (int i = 0; i < 32; ++i) { const int kk = 2 * i + (lane >> 5); tv[i] = (nn < N) ? W[(size_t)(k0 + kk) * N + nn] : 0.f; }
#pragma unroll
    for (int i = 0; i < 32; ++i) { const int kk = 2 * i + (lane >> 5); scr[kk * 33 + (lane & 31)] = tv[i]; }
    asm volatile("s_waitcnt lgkmcnt(0)" ::: "memory");
    const int c = lane & 7;
#pragma unroll
    for (int j = 0; j < 4; ++j) { const int n = (lane >> 3) + 8 * j; const LAS float* s = scr + (8 * c) * 33 + n;
        u32x4 o; o.x = cvtpk(s[0 * 33], s[1 * 33]); o.y = cvtpk(s[2 * 33], s[3 * 33]); o.z = cvtpk(s[4 * 33], s[5 * 33]); o.w = cvtpk(s[6 * 33], s[7 * 33]);
        *(u32x4*)(WT + (size_t)(n0 + n) * K + k0 + 8 * c) = o; }
    asm volatile("s_waitcnt lgkmcnt(0)" ::: "memory");
}

template <int NR>
DI void prenorm_rows(const float* const (&xrow)[NR], const float* gpre, const float* const (&md)[NR], bf16_t* const (&orow)[NR], int lane) {
    f32x4 v[NR][4];
#pragma unroll
    for (int r = 0; r < NR; ++r)
#pragma unroll
        for (int j = 0; j < 4; ++j) v[r][j] = *(const f32x4*)(xrow[r] + 4 * lane + 256 * j);
#pragma unroll
    for (int r = 0; r < NR; ++r) {
        float s = 0.f;
#pragma unroll
        for (int j = 0; j < 4; ++j) s += (v[r][j].x * v[r][j].x + v[r][j].y * v[r][j].y) + (v[r][j].z * v[r][j].z + v[r][j].w * v[r][j].w);
        const float rr = rsqrtf(wave_sum(s) * (1.f / DM) + EPS);
#pragma unroll
        for (int j = 0; j < 4; ++j) {
            const int c = 4 * lane + 256 * j;
            const f32x4 g = *(const f32x4*)(gpre + c), a = *(const f32x4*)(md[r] + 1024 + c), b = *(const f32x4*)(md[r] + c);
            f32x4 o;
#pragma unroll
            for (int e = 0; e < 4; ++e) o[e] = v[r][j][e] * rr * g[e] * (1.f + a[e]) + b[e];
            u32x2 w; w.x = cvtpk(o[0], o[1]); w.y = cvtpk(o[2], o[3]);
            *(u32x2*)(orow[r] + c) = w;
        }
    }
}
template <bool NEXT, int NR, bool XBF, bool X1BF>
DI void postnorm_rows(const float* const (&xrow)[NR], const bf16_t* const (&yrow)[NR], const float* gpost, const float* const (&md0)[NR], float* const (&x1row)[NR],
                      const float* gpre, const float* const (&md1)[NR], bf16_t* const (&hrow)[NR], int lane) {
    f32x4 y[NR][4], x[NR][4];
#pragma unroll
    for (int r = 0; r < NR; ++r)
#pragma unroll
        for (int j = 0; j < 4; ++j) {
            const u32x2 raw = *(const u32x2*)(yrow[r] + 4 * lane + 256 * j);
            y[r][j] = (f32x4){__uint_as_float(raw.x << 16), __uint_as_float(raw.x & 0xffff0000u), __uint_as_float(raw.y << 16), __uint_as_float(raw.y & 0xffff0000u)};
            if (XBF) {
                const u32x2 rx = *(const u32x2*)((const bf16_t*)xrow[r] + 4 * lane + 256 * j);
                x[r][j] = (f32x4){__uint_as_float(rx.x << 16), __uint_as_float(rx.x & 0xffff0000u), __uint_as_float(rx.y << 16), __uint_as_float(rx.y & 0xffff0000u)};
            } else x[r][j] = *(const f32x4*)(xrow[r] + 4 * lane + 256 * j);
        }
#pragma unroll
    for (int r = 0; r < NR; ++r) {
        float s = 0.f;
#pragma unroll
        for (int j = 0; j < 4; ++j) s += (y[r][j].x * y[r][j].x + y[r][j].y * y[r][j].y) + (y[r][j].z * y[r][j].z + y[r][j].w * y[r][j].w);
        const float rr = rsqrtf(wave_sum(s) * (1.f / DM) + EPS);
        float s1 = 0.f;
#pragma unroll
        for (int j = 0; j < 4; ++j) {
            const int c = 4 * lane + 256 * j;
            const f32x4 g = *(const f32x4*)(gpost + c), gt = *(const f32x4*)(md0[r] + 2048 + c);
#pragma unroll
            for (int e = 0; e < 4; ++e) x[r][j][e] = x[r][j][e] + gt[e] * (y[r][j][e] * rr * g[e]);
            if (X1BF) { u32x2 wx; wx.x = cvtpk(x[r][j][0], x[r][j][1]); wx.y = cvtpk(x[r][j][2], x[r][j][3]); *(u32x2*)((bf16_t*)x1row[r] + c) = wx; }
            else *(f32x4*)(x1row[r] + c) = x[r][j];
            s1 += (x[r][j].x * x[r][j].x + x[r][j].y * x[r][j].y) + (x[r][j].z * x[r][j].z + x[r][j].w * x[r][j].w);
        }
        if (NEXT) {
            const float r1 = rsqrtf(wave_sum(s1) * (1.f / DM) + EPS);
#pragma unroll
            for (int j = 0; j < 4; ++j) {
                const int c = 4 * lane + 256 * j;
                const f32x4 g = *(const f32x4*)(gpre + c), a = *(const f32x4*)(md1[r] + 1024 + c), b = *(const f32x4*)(md1[r] + c);
                f32x4 o;
#pragma unroll
                for (int e = 0; e < 4; ++e) o[e] = x[r][j][e] * r1 * g[e] * (1.f + a[e]) + b[e];
                u32x2 w; w.x = cvtpk(o[0], o[1]); w.y = cvtpk(o[2], o[3]);
                *(u32x2*)(hrow[r] + c) = w;
            }
        }
    }
}

#define XB_TMO      128
#define XB_XCNT(j)  (256  + 64 * (j))
#define XB_XSUB(j)  (1280 + 64 * (j))
#define XB_XGEN(j)  (2304 + 64 * (j))
#define XB_TOP      3328
#define XB_TOPGEN   3392
#define XCD_BAR_WORDS 3456
#define XB_SPIN_CAP (1u << 18)
DI unsigned xb_ld(unsigned* p)              { return __hip_atomic_load(p, __ATOMIC_RELAXED, __HIP_MEMORY_SCOPE_AGENT); }
DI unsigned xb_add(unsigned* p, unsigned v) { return __hip_atomic_fetch_add(p, v, __ATOMIC_RELAXED, __HIP_MEMORY_SCOPE_AGENT); }
DI unsigned xb_xcc_id() { return (unsigned)__builtin_amdgcn_s_getreg((3 << 11) | 20) & 0xFu; }
#define XB_SPIN(cond, bar) do { unsigned _sp = 0; while (cond) { __builtin_amdgcn_s_sleep(1); \
    if ((++_sp & 255u) == 0u) { if (xb_ld(&(bar)[XB_TMO])) break; if (_sp > XB_SPIN_CAP) { atomicAdd(&(bar)[XB_TMO], 1u); break; } } } } while (0)
struct XcdBarrier { unsigned* bar; unsigned x; volatile LAS unsigned* st; };
DI XcdBarrier xcd_barrier_post(unsigned* bar, volatile LAS unsigned* st) {
    XcdBarrier b; b.bar = bar; b.x = xb_xcc_id(); b.st = st;
    if (threadIdx.x == 0) (void)xb_add(&bar[XB_XCNT(b.x)], 1u);
    return b;
}
DI void xcd_barrier_complete(unsigned* bar, unsigned x, unsigned& nloc, unsigned& nx) {
    const unsigned G = gridDim.x * gridDim.y * gridDim.z;
    unsigned sum, cnt, mine, sp = 0u;
    for (;;) {
        sum = 0u; cnt = 0u; mine = 0u;
#pragma unroll
        for (unsigned j = 0; j < 16; ++j) { const unsigned c = xb_ld(&bar[XB_XCNT(j)]); sum += c; cnt += (c > 0u) ? 1u : 0u; mine = (j == x) ? c : mine; }
        if (sum == G) break;
        __builtin_amdgcn_s_sleep(1);
        if ((++sp & 255u) == 0u) { if (xb_ld(&bar[XB_TMO])) break; if (sp > XB_SPIN_CAP) { atomicAdd(&bar[XB_TMO], 1u); break; } }
    }
    nloc = mine > 0u ? mine : 1u; nx = cnt > 0u ? cnt : 1u;
}
DI void xcd_barrier(const XcdBarrier& b) {
    asm volatile("s_waitcnt vmcnt(0)" ::: "memory");
    __syncthreads();
    if (threadIdx.x == 0) {
        unsigned* bar = b.bar;
        __builtin_amdgcn_s_waitcnt(0);
        unsigned nloc = b.st[0], nx = b.st[1];
        if (nloc == 0u) { xcd_barrier_complete(bar, b.x, nloc, nx); b.st[0] = nloc; b.st[1] = nx; }
        const unsigned old = xb_add(&bar[XB_XSUB(b.x)], 1u);
        const unsigned gen = old / nloc;
        if (old + 1u == (gen + 1u) * nloc) {
            __builtin_amdgcn_fence(__ATOMIC_RELEASE, "agent");
            asm volatile("s_waitcnt vmcnt(0)" ::: "memory");
            const unsigned og = xb_add(&bar[XB_TOP], 1u);
            const unsigned tg = og / nx;
            if (og + 1u == (tg + 1u) * nx) xb_add(&bar[XB_TOPGEN], 1u);
            else XB_SPIN(xb_ld(&bar[XB_TOPGEN]) == tg, bar);
            __builtin_amdgcn_fence(__ATOMIC_ACQUIRE, "agent");
            xb_add(&bar[XB_XGEN(b.x)], 1u);
            asm volatile("s_waitcnt vmcnt(0)" ::: "memory");
        } else {
            XB_SPIN(xb_ld(&bar[XB_XGEN(b.x)]) == gen, bar);
            __builtin_amdgcn_fence(__ATOMIC_ACQUIRE, "agent");
            asm volatile("s_waitcnt vmcnt(0)" ::: "memory");
        }
    }
    __syncthreads();
}

__global__ void __launch_bounds__(512, 2) fwd_megakernel(Params p) {
    extern __shared__ __attribute__((aligned(16))) unsigned char lds_raw[];
    LAS unsigned char* lds = (LAS unsigned char*)lds_raw;
    cg::grid_group grid = cg::this_grid();
    const int tid = threadIdx.x;
    const int G = gridDim.x, blk = blockIdx.x;
#define lane ((int)(threadIdx.x & 63u))
#define wave (__builtin_amdgcn_readfirstlane((int)(threadIdx.x >> 6)))
#define gw (blk * 8 + wave)
    const int NGW = G * 8;
    unsigned char* ws = p.ws;
    float* out = p.out;
    const float* x_prompt = p.in[0]; const float* x_sample = p.in[1];
    const float* st_C = p.in[2]; const float* st_n = p.in[3]; const float* st_m = p.in[4];
    const float* gpre = p.in[13]; const float* gpost = p.in[14];
    float* MOD = (float*)(ws + WS_MOD); float* Gt = (float*)(ws + WS_G); float* SC = (float*)(ws + WS_SC); float* CH = (float*)(ws + WS_CH);
    float* UN = (float*)(ws + WS_UN); float* NST = (float*)(ws + WS_NST); float* MJ = (float*)(ws + WS_MJ);
    bf16_t* CK = (bf16_t*)(ws + WS_CK); bf16_t* CVT = (bf16_t*)(ws + WS_CVT); bf16_t* NK = (bf16_t*)(ws + WS_NK); bf16_t* NVT = (bf16_t*)(ws + WS_NVT);
    bf16_t* WINE = (bf16_t*)(ws + WS_WINE); bf16_t* WOUTE = (bf16_t*)(ws + WS_WOUTE); bf16_t* WINO = (bf16_t*)(ws + WS_WINO); bf16_t* WOUTO = (bf16_t*)(ws + WS_WOUTO);
    bf16_t* H = (bf16_t*)(ws + WS_H); bf16_t* KT = (bf16_t*)(ws + WS_KT); bf16_t* VT = (bf16_t*)(ws + WS_VT); bf16_t* Y2 = (bf16_t*)(ws + WS_Y2);
    bf16_t* P = (bf16_t*)(ws + WS_P); bf16_t* CST = (bf16_t*)(ws + WS_CST); bf16_t* QB = (bf16_t*)(ws + WS_QB); bf16_t* KB = (bf16_t*)(ws + WS_KB);
    bf16_t* VBT = (bf16_t*)(ws + WS_VBT); bf16_t* U = (bf16_t*)(ws + WS_U); bf16_t* VCT = (bf16_t*)(ws + WS_VCT);
    bf16_t* X1P = (bf16_t*)(ws + WS_X1P); bf16_t* X1S = (bf16_t*)(ws + WS_X1S);
#define X1ROW(r) ((r) < MP ? X1P + (size_t)(r) * DM : X1S + (size_t)((r) - MP) * DM)
    const int lo = p.ph_lo, hi = p.ph_hi;
    volatile LAS unsigned* bst = (volatile LAS unsigned*)(lds + LDS_BYTES - 64);
    if (tid == 0) { bst[0] = 0u; bst[1] = 0u; }
    __syncthreads();
    XcdBarrier xbar = xcd_barrier_post((unsigned*)(ws + WS_BAR), bst);
    if (p.coop == 2) grid.sync();
#define IN(k) (lo <= (k) && (k) < hi)
#define SEAM(k) do { if (p.coop && IN(k) && IN((k) + 1)) { for (int sr_ = 0; sr_ < SYNC_REP; ++sr_) xcd_barrier(xbar); } } while (0)
#define REPEAT(k) _Pragma("unroll 1") for (int rep_ = 0; rep_ < 1 + ((REP_MASK >> (k)) & 1); ++rep_)

    if (IN(0)) REPEAT(0) {
        for (int mb = blk; mb < 192; mb += G) {
            const int l = mb / 96, j0 = (mb % 96) * 32;
            LAS float* sL = (LAS float*)lds;
            LAS float* red = sL + 3072;
            for (int i = tid; i < 3072; i += 512) { const int v = i >> 10, k = i & 1023; const float cv = (v == 0) ? p.in[10][k] : p.in[9][(v - 1) * 1024 + k]; sL[i] = siluf(cv); }
            __syncthreads();
            const int col = tid & 31, kg = tid >> 5;
            float a0 = 0.f, a1 = 0.f, a2 = 0.f;
            const float* wp = p.in[11] + ((size_t)l * 1024 + kg * 64) * 3072 + j0 + col;
#pragma unroll
            for (int i0 = 0; i0 < 64; i0 += 32) {
                float wv[32];
#pragma unroll
                for (int i = 0; i < 32; ++i) wv[i] = wp[(size_t)(i0 + i) * 3072];
#pragma unroll
                for (int i = 0; i < 32; ++i) { const int k = kg * 64 + i0 + i; a0 += sL[k] * wv[i]; a1 += sL[1024 + k] * wv[i]; a2 += sL[2048 + k] * wv[i]; }
            }
            red[(0 * 16 + kg) * 32 + col] = a0; red[(1 * 16 + kg) * 32 + col] = a1; red[(2 * 16 + kg) * 32 + col] = a2;
            __syncthreads();
            if (tid < 96) { const int v = tid >> 5, c = tid & 31; float s = p.in[12][l * 3072 + j0 + c];
                for (int k2 = 0; k2 < 16; ++k2) s += red[(v * 16 + k2) * 32 + c];
                __hip_atomic_store(MOD + (l * 3 + v) * 3072 + j0 + c, s, __ATOMIC_RELAXED, __HIP_MEMORY_SCOPE_AGENT); }
            asm volatile("s_waitcnt vmcnt(0)" ::: "memory");
            __syncthreads();
            if (tid == 0) __hip_atomic_fetch_add((unsigned*)(ws + 16384) + 16 * 160, 1u, __ATOMIC_RELAXED, __HIP_MEMORY_SCOPE_AGENT);
        }
        {
            LAS float* scr = (LAS float*)(lds + wave * 16384);
            const int I_E = 16 * 121, I_O = 16 * 32, I_C = 16 * 128;
            const int NIT = I_E + I_O + I_C + I_O;
            for (int it = gw; it < NIT; it += NGW) {
                int r = it;
                if (r < I_E) { transpose_item(p.in[15], 1024, 3856, WINE, scr, r, lane); continue; } r -= I_E;
                if (r < I_O) { transpose_item(p.in[20], 1024, 1024, WOUTE, scr, r, lane); continue; } r -= I_O;
                if (r < I_C) { transpose_item(p.in[21], 1024, 4096, WINO, scr, r, lane); continue; } r -= I_C;
                transpose_item(p.in[23], 1024, 1024, WOUTO, scr, r, lane);
            }
        }
        {
            const int gt = blk * 512 + tid, NT = G * 512;
            for (int i = gt; i < 65536; i += NT) {
                CK[i] = f2bf(p.in[5][i]);
                const int d = i & 63, s = (i >> 6) & 255, bh = i >> 14;
                CVT[(bh * 64 + d) * 256 + s] = f2bf(p.in[6][i]);
            }
            for (int i = gt; i < 524288; i += NT) {
                NK[i] = f2bf(p.in[7][i]);
                const int d = i & 63, s = (i >> 6) & 255, bh = i >> 14;
                NVT[(bh * 64 + d) * 256 + s] = f2bf(p.in[8][i]);
            }
        }
        __syncthreads();
        if (tid == 0) {
            unsigned* c = (unsigned*)(ws + 16384) + 16 * 160; unsigned spins = 0;
            while (__hip_atomic_load(c, __ATOMIC_RELAXED, __HIP_MEMORY_SCOPE_AGENT) < 192u) { __builtin_amdgcn_s_sleep(1); if (++spins > (1u << 22)) break; }
            __builtin_amdgcn_fence(__ATOMIC_ACQUIRE, "agent");
            asm volatile("s_waitcnt vmcnt(0)" ::: "memory");
        }
        __syncthreads();
    }
    if (IN(1)) REPEAT(1) {
        for (int row0 = gw; row0 < MROWS; row0 += 2 * NGW) {
            const float* xr[2]; const float* md[2]; bf16_t* orow[2];
#pragma unroll
            for (int r = 0; r < 2; ++r) {
                const int row = min(row0 + r * NGW, MROWS - 1);
                const int v = row < MP ? 0 : 1 + ((row - MP) >> 12);
                xr[r] = row < MP ? x_prompt + (size_t)row * DM : x_sample + (size_t)(row - MP) * DM;
                md[r] = MOD + (0 * 3 + v) * 3072; orow[r] = H + (size_t)row * DM;
            }
            prenorm_rows<2>(xr, gpre, md, orow, lane);
        }
    }
    SEAM(1);
    if (IN(2)) REPEAT(2) {
        pg8::Gemm g{H, WINE, MROWS, 4096, 1024}; pg8::StaticOrder S; S.init(MROWS, 4096, G, blk);
        EpiEvenIn E{P, KT, VT, VBT, Gt, out};
        pg8::gemm_phase(lds, g, S, E);
    }
    SEAM(2);
    if (IN(3)) REPEAT(3) {
        for (int it = gw; it < 768; it += NGW) {
            int sid, h, dir, js;
            if (it < 256) { js = it & 1; dir = (it >> 1) & 1; h = (it >> 2) & 3; sid = it >> 4; }
            else { const int r = it - 256; js = r & 31; dir = (r >> 5) & 1; h = (r >> 6) & 3; sid = 16 + (r >> 8); }
            gate_scan_item(sid, h, dir, js, lane, Gt, p.in[16], SC, CH);
        }
        for (int row0 = gw; row0 < MROWS; row0 += 2 * NGW) {
            const int row1 = row0 + NGW; const bool two = row1 < MROWS;
            u32x4 ra[2], rb[2];
            ra[0] = *(const u32x4*)(P + (size_t)row0 * NP + C_QB + lane * 8); ra[1] = *(const u32x4*)(P + (size_t)row0 * NP + C_KB + lane * 8);
            if (two) { rb[0] = *(const u32x4*)(P + (size_t)row1 * NP + C_QB + lane * 8); rb[1] = *(const u32x4*)(P + (size_t)row1 * NP + C_KB + lane * 8); }
            qknorm_item(row0, lane, ra, p.in[18], p.in[19], QB, KB, out);
            if (two) qknorm_item(row1, lane, rb, p.in[18], p.in[19], QB, KB, out);
        }
    }
    SEAM(3);
    const bool gate67 = (G >= (MROWS / 256) * (DM / 256)) && p.coop && IN(4) && IN(5) && IN(6) && IN(7);
    unsigned* pcntA = (unsigned*)(ws + 65536);
    const bool gate45 = (G == 256) && p.coop && IN(4) && IN(5) && IN(6);
    unsigned* ucnt = (unsigned*)(ws + 49152);
    if (IN(4)) REPEAT(4) {
        const WT wtw4 = mk_wt(ws, (unsigned)WS_END);
        const int NIT = 256 + 768 + 128;
        for (int it = blk; it < NIT; it += G) {
            if (it < 256) {
                const int xcd = it & 7, jj = it >> 3, b = xcd >> 2, kv = (xcd >> 1) & 1, idx = (xcd & 1) * 32 + jj, qh = kv * 4 + (idx & 3), qblk = idx >> 2;
                const int rowq = MP + b * 4096 + qblk * 256;
                attn_item<0>(lds, tid, QB + (size_t)rowq * 512 + qh * 64, 512,
                             CK + (size_t)((b * 2 + kv) * 256) * 64, 64, CVT + (size_t)((b * 2 + kv) * 64) * 256, 256, 4,
                             KB + (size_t)(MP + b * 4096) * 128 + kv * 64, 128, VBT + (size_t)(kv * 64) * MROWS + MP + b * 4096, MROWS, 64,
                             0, 0, nullptr,
                             P + (size_t)rowq * NP + C_Z + 512 + qh * 64, NP, H + (size_t)rowq * DM + 512 + qh * 64, DM, wtw4, gate67, gate67 ? pcntA + 16 * (rowq >> 8) : nullptr);
            } else if (it < 256 + 768) {
                const int r0 = it - 256; int sid, h, dir, js;
                if (r0 < 256) { js = r0 & 1; dir = (r0 >> 1) & 1; h = (r0 >> 2) & 3; sid = r0 >> 4; }
                else { const int r = r0 - 256; js = r & 31; dir = (r >> 5) & 1; h = (r >> 6) & 3; sid = 16 + (r >> 8); }
                mlstm_u_item(lds, tid, sid, h, dir, js, SC, CH, st_m, KT, VT, U, UN, wtw4, gate45 ? ucnt : nullptr);
            } else {
                const int r = it - 1024, qh = r & 7, b = r >> 3, kv = qh >> 2;
                const int rowq = b * 256;
                attn_item<0>(lds, tid, QB + (size_t)rowq * 512 + qh * 64, 512,
                             KB, 128, VBT, MROWS, 0,
                             KB + (size_t)rowq * 128 + kv * 64, 128, VBT + (size_t)(kv * 64) * MROWS + rowq, MROWS, 4,
                             0, 0, nullptr,
                             P + (size_t)rowq * NP + C_Z + 512 + qh * 64, NP, H + (size_t)rowq * DM + 512 + qh * 64, DM, wtw4, gate67, gate67 ? pcntA + 16 * (rowq >> 8) : nullptr);
            }
        }
    }
    if (!gate45) SEAM(4);
    const bool gate56 = (G == 256) && p.coop && IN(5) && IN(6);
    unsigned* chcnt = (unsigned*)(ws + 32768);
    if (IN(5)) REPEAT(5) {
        const WT wtw = mk_wt(ws, (unsigned)WS_END);
        const int NT = G * 512;
        const int nS = 16 * 2048, nP = 128 * 2048;
        const int perS = (nS + G - 1) / G;
        const int nvb = gate56 ? 2 : 1;
        const int sblk = gate56 ? blk - 128 : blk;
        if (!gate56 || blk >= 128) {
            for (int ps = 0; ps < 2; ++ps) {
                const int pass = 1 - ps;
                if (gate45) {
                    if (tid == 0) {
                        unsigned spins = 0; bool ok = false;
                        while (!ok) {
                            ok = true;
                            for (int vbi = 0; vbi < 2; ++vbi) {
                                const int vb = sblk + 128 * vbi;
                                if (pass == 1) {
                                    ok = ok && __hip_atomic_load(ucnt + 16 * (vb >> 2), __ATOMIC_RELAXED, __HIP_MEMORY_SCOPE_AGENT) >= 2u
                                            && __hip_atomic_load(ucnt + 16 * ((vb >> 2) + 64), __ATOMIC_RELAXED, __HIP_MEMORY_SCOPE_AGENT) >= 2u;
                                    if (vb < 36) for (int q = 0; q < 4; ++q) { const int c = vb * 4 + q; ok = ok && __hip_atomic_load(ucnt + 16 * c, __ATOMIC_RELAXED, __HIP_MEMORY_SCOPE_AGENT) >= (c < 128 ? 2u : 32u); }
                                } else ok = ok && __hip_atomic_load(ucnt + 16 * (128 + (vb >> 4)), __ATOMIC_RELAXED, __HIP_MEMORY_SCOPE_AGENT) >= 32u;
                            }
                            if (!ok) { __builtin_amdgcn_s_sleep(1); if (++spins > (1u << 22)) break; }
                        }
                        __builtin_amdgcn_fence(__ATOMIC_ACQUIRE, "agent");
                        asm volatile("s_waitcnt vmcnt(0)" ::: "memory");
                    }
                    __syncthreads();
                }
                for (int vbi = 0; vbi < nvb; ++vbi) {
                    const int vb = sblk + 128 * vbi;
                    int i0, i1, st;
                    if (pass == 1) { i0 = vb * 512 + tid; i1 = nP; st = NT; }
                    else if (gate56) { const bool on = (vbi == 0) && (tid < 256); i0 = on ? (sblk + 128 * (tid >> 7)) * 128 + (tid & 127) : 0; i1 = on ? i0 + 1 : 0; st = 1; }
                    else { i0 = vb * perS + tid; i1 = min((vb + 1) * perS, nS); st = 512; }
                    for (int idx0 = i0; idx0 < i1; idx0 += st) {
            const int idx = pass == 0 ? nP + idx0 : idx0;
            const int chain = idx >> 11, e8 = (idx & 2047) * 8;
            int sid, h, dir;
            if (chain < 128) { dir = chain & 1; h = (chain >> 1) & 3; sid = chain >> 3; } else { const int r = chain - 128; dir = r & 1; h = (r >> 1) & 3; sid = 16 + (r >> 3); }
            const int nc = sid < 16 ? 2 : 32, base = chain_base(sid, h, dir);
            float cur[8];
            if (sid < 16) {
#pragma unroll
                for (int e = 0; e < 8; ++e) cur[e] = 0.f;
            } else {
                const float* c0 = st_C + ((size_t)(((sid - 16) * 2 + dir) * 4 + h)) * 16384 + e8;
                const f32x4 a = *(const f32x4*)c0, b = *(const f32x4*)(c0 + 4);
                cur[0] = a[0]; cur[1] = a[1]; cur[2] = a[2]; cur[3] = a[3]; cur[4] = b[0]; cur[5] = b[1]; cur[6] = b[2]; cur[7] = b[3];
            }
            float m = chain_m0(st_m, sid, h, dir);
            const bf16_t* __restrict__ Ub = U + (size_t)base * 16384 + e8;
            bf16_t* __restrict__ Cb = CST + (size_t)base * 16384 + e8;
            for (int js0 = 0; js0 < nc; js0 += 8) {
                u32x4 raw[8];
#pragma unroll
                for (int j = 0; j < 8; ++j) if (js0 + j < nc) raw[j] = *(const u32x4*)(Ub + (size_t)(js0 + j) * 16384);
#pragma unroll
                for (int j = 0; j < 8; ++j) if (js0 + j < nc) {
                    const int js = js0 + j;
                    const float bL = CH[(base + js) * 2], rmL = CH[(base + js) * 2 + 1];
                    const float Mx = fmaxf(m, rmL), a = expf(m - Mx), f = expf(rmL - Mx);
                    if (e8 == 0) __hip_atomic_store(MJ + base + js, m, __ATOMIC_RELAXED, __HIP_MEMORY_SCOPE_AGENT);
                    u32x4 wv; wv.x = cvtpk(cur[0], cur[1]); wv.y = cvtpk(cur[2], cur[3]); wv.z = cvtpk(cur[4], cur[5]); wv.w = cvtpk(cur[6], cur[7]);
                    wt16(wtw, Cb + (size_t)js * 16384, wv);
                    cur[0] = a * cur[0] + f * __uint_as_float(raw[j].x << 16); cur[1] = a * cur[1] + f * __uint_as_float(raw[j].x & 0xffff0000u);
                    cur[2] = a * cur[2] + f * __uint_as_float(raw[j].y << 16); cur[3] = a * cur[3] + f * __uint_as_float(raw[j].y & 0xffff0000u);
                    cur[4] = a * cur[4] + f * __uint_as_float(raw[j].z << 16); cur[5] = a * cur[5] + f * __uint_as_float(raw[j].z & 0xffff0000u);
                    cur[6] = a * cur[6] + f * __uint_as_float(raw[j].w << 16); cur[7] = a * cur[7] + f * __uint_as_float(raw[j].w & 0xffff0000u);
                    m = bL + Mx;
                }
            }
            if (sid < 16) {
                float* o = out + O_C + ((size_t)((sid * 2 + dir) * 4 + h)) * 16384 + e8;
                *(f32x4*)o = (f32x4){cur[0], cur[1], cur[2], cur[3]}; *(f32x4*)(o + 4) = (f32x4){cur[4], cur[5], cur[6], cur[7]};
            }
                            }
                }
                if (pass == 1) {
                    for (int vbi = 0; vbi < nvb; ++vbi)
                    for (int idx = (sblk + 128 * vbi) * 512 + tid; idx < 144 * 128; idx += NT) {
            const int chain = idx >> 7, k = idx & 127;
            int sid, h, dir;
            if (chain < 128) { dir = chain & 1; h = (chain >> 1) & 3; sid = chain >> 3; } else { const int r = chain - 128; dir = r & 1; h = (r >> 1) & 3; sid = 16 + (r >> 3); }
            const int nc = sid < 16 ? 2 : 32, base = chain_base(sid, h, dir);
            float cur = sid < 16 ? 0.f : st_n[(((sid - 16) * 2 + dir) * 4 + h) * 128 + k];
            float m = chain_m0(st_m, sid, h, dir);
            for (int js0 = 0; js0 < nc; js0 += 8) {
                float un[8];
#pragma unroll
                for (int j = 0; j < 8; ++j) if (js0 + j < nc) un[j] = UN[(size_t)(base + js0 + j) * 128 + k];
#pragma unroll
                for (int j = 0; j < 8; ++j) if (js0 + j < nc) {
                    const int js = js0 + j;
                    const float bL = CH[(base + js) * 2], rmL = CH[(base + js) * 2 + 1];
                    const float Mx = fmaxf(m, rmL), a = expf(m - Mx), f = expf(rmL - Mx);
                    __hip_atomic_store(NST + (size_t)(base + js) * 128 + k, cur, __ATOMIC_RELAXED, __HIP_MEMORY_SCOPE_AGENT);
                    cur = a * cur + f * un[j];
                    m = bL + Mx;
                }
            }
            if (sid < 16) {
                out[O_N + ((size_t)((sid * 2 + dir) * 4 + h)) * 128 + k] = cur;
                if (k == 0) out[O_M + (sid * 2 + dir) * 4 + h] = m;
            }
                            }
                }
                if (gate56) {
                    asm volatile("s_waitcnt vmcnt(0)" ::: "memory");
                    __syncthreads();
                    if (tid == 0) {
                        for (int vbi = 0; vbi < 2; ++vbi) {
                            const int vb = sblk + 128 * vbi;
                            if (pass == 1) {
                                __hip_atomic_fetch_add(chcnt + 16 * (vb >> 2), 1u, __ATOMIC_RELAXED, __HIP_MEMORY_SCOPE_AGENT);
                                __hip_atomic_fetch_add(chcnt + 16 * ((vb >> 2) + 64), 1u, __ATOMIC_RELAXED, __HIP_MEMORY_SCOPE_AGENT);
                                if (vb < 36) for (int q = 0; q < 4; ++q) __hip_atomic_fetch_add(chcnt + 16 * (vb * 4 + q), 1u, __ATOMIC_RELAXED, __HIP_MEMORY_SCOPE_AGENT);
                            } else {
                                __hip_atomic_fetch_add(chcnt + 16 * (128 + (vb >> 4)), 1u, __ATOMIC_RELAXED, __HIP_MEMORY_SCOPE_AGENT);
                            }
                        }
                    }
                }
            }
        } else {
            const int r = blk, jt = r & 1, h = (r >> 1) & 3, sid = r >> 3;
            if (tid == 0) {
                const int c0 = (sid * 4 + h) * 2; unsigned spins = 0;
                while (__hip_atomic_load(chcnt + 16 * c0, __ATOMIC_RELAXED, __HIP_MEMORY_SCOPE_AGENT) < 5u ||
                       __hip_atomic_load(chcnt + 16 * (c0 + 1), __ATOMIC_RELAXED, __HIP_MEMORY_SCOPE_AGENT) < 5u) { __builtin_amdgcn_s_sleep(1); if (++spins > (1u << 22)) break; }
                __builtin_amdgcn_fence(__ATOMIC_ACQUIRE, "agent");
                asm volatile("s_waitcnt vmcnt(0)" ::: "memory");
            }
            __syncthreads();
            mlstm_out_item(lds, tid, sid, h, jt, SC, MJ, NST, CST, P, VT, p.in[17], H, wtw, gate67, gate67 ? pcntA : nullptr);
        }
    }
    if (!gate56) SEAM(5);
    if (IN(6)) REPEAT(6) {
        const WT wtw = mk_wt(ws, (unsigned)WS_END);
        for (int it = blk; it < (gate56 ? 256 : 384); it += G) {
            int sid, h, jt;
            if (it < 256) { jt = it & 31; h = (it >> 5) & 3; sid = 16 + (it >> 7); }
            else { const int r = it - 256; jt = r & 1; h = (r >> 1) & 3; sid = r >> 3; }
            if (gate56) {
                if (tid == 0) {
                    const int c0 = 128 + ((sid - 16) * 4 + h) * 2; unsigned spins = 0;
                    while (__hip_atomic_load(chcnt + 16 * c0, __ATOMIC_RELAXED, __HIP_MEMORY_SCOPE_AGENT) < 17u ||
                           __hip_atomic_load(chcnt + 16 * (c0 + 1), __ATOMIC_RELAXED, __HIP_MEMORY_SCOPE_AGENT) < 17u) { __builtin_amdgcn_s_sleep(1); if (++spins > (1u << 22)) break; }
                    __builtin_amdgcn_fence(__ATOMIC_ACQUIRE, "agent");
                    asm volatile("s_waitcnt vmcnt(0)" ::: "memory");
                }
                __syncthreads();
            }
            mlstm_out_item(lds, tid, sid, h, jt, SC, MJ, NST, CST, P, VT, p.in[17], H, wtw, gate67, gate67 ? pcntA : nullptr);
        }
    }
    if (!gate67) SEAM(6);
    const bool fuse_mid = (G >= (MROWS / 256) * (DM / 256));
    if (IN(7)) REPEAT(7) {
        pg8::Gemm g{H, WOUTE, MROWS, 1024, 1024}; pg8::StaticOrder S; S.init(MROWS, 1024, G, blk);
        if (fuse_mid) {
            if (gate67) {
                pg8::Unit u0;
                if (S.next(0, u0)) {
                    if (tid == 0) {
                        unsigned spins = 0;
                        while (__hip_atomic_load(pcntA + 16 * u0.pm, __ATOMIC_RELAXED, __HIP_MEMORY_SCOPE_AGENT) < 16u) { __builtin_amdgcn_s_sleep(1); if (++spins > (1u << 22)) break; }
                        __builtin_amdgcn_fence(__ATOMIC_ACQUIRE, "agent");
                        asm volatile("s_waitcnt vmcnt(0)" ::: "memory");
                    }
                }
                __syncthreads();
            }
            EpiMid E{x_prompt, x_sample, MOD, gpost, gpre + DM, X1P, X1S, H, (float*)(ws + WS_G), (unsigned*)(ws + 16384)};
            pg8::gemm_phase(lds, g, S, E);
        } else {
            EpiPlain E{Y2, DM};
            pg8::gemm_phase(lds, g, S, E);
        }
    }
    SEAM(7);
    if (!fuse_mid) {
    if (IN(8)) REPEAT(8) {
        for (int row0 = gw; row0 < MROWS; row0 += 2 * NGW) {
            const float* xr[2]; const bf16_t* yr[2]; const float* md0[2]; const float* md1[2]; float* x1r[2]; bf16_t* hr[2];
#pragma unroll
            for (int r = 0; r < 2; ++r) {
                const int row = min(row0 + r * NGW, MROWS - 1);
                const int v = row < MP ? 0 : 1 + ((row - MP) >> 12);
                xr[r] = row < MP ? x_prompt + (size_t)row * DM : x_sample + (size_t)(row - MP) * DM;
                yr[r] = Y2 + (size_t)row * DM; md0[r] = MOD + (0 * 3 + v) * 3072; md1[r] = MOD + (1 * 3 + v) * 3072;
                x1r[r] = (float*)X1ROW(row); hr[r] = H + (size_t)row * DM;
            }
            postnorm_rows<true, 2, false, true>(xr, yr, gpost, md0, x1r, gpre + DM, md1, hr, lane);
        }
    }
    SEAM(8);
    }
    if (IN(9)) REPEAT(9) {
        pg8::Gemm g{H, WINO, MROWS, 4096, 1024}; pg8::StaticOrder S; S.init(MROWS, 4096, G, blk);
        EpiOddIn E{P, VCT, out};
        pg8::gemm_phase(lds, g, S, E);
    }
    SEAM(9);
    const bool gate1011 = (G >= (MROWS / 256) * (DM / 256)) && p.coop && IN(10) && IN(11);
    unsigned* pcntB = (unsigned*)(ws + 62464);
    if (IN(10)) REPEAT(10) {
        const WT wtw10 = mk_wt(ws, (unsigned)WS_END);
        LAS float* rpbL = (LAS float*)(lds + 8 * AT_TILE);
        for (int it = blk; it < 512 + 256; it += G) {
            if (it < 512) {
                const int xcd = it & 7, jj = (it >> 3) & 31, b = it >> 8, h = 2 * xcd + (jj >> 4), rblk = jj & 15;
                for (int i = tid; i < 640; i += 512) { const int j = i - 64; rpbL[i] = (j >= 0 && j < 465) ? p.in[22][h * 465 + j] * LOG2E : 0.f; }
                const int r0 = rblk * 4;
                const int rs_lo = min(max(r0 - 4, 0), 56), rs_hi = min(max(r0 + 3 - 4, 0), 56) + 7;
                const int rowq = MP + b * 4096 + r0 * 64, rowk = MP + b * 4096 + rs_lo * 64;
                attn_item<1>(lds, tid, P + (size_t)rowq * NP + h * 64, NP,
                             NK + (size_t)((b * 16 + h) * 256) * 64, 64, NVT + (size_t)((b * 16 + h) * 64) * 256, 256, 4,
                             P + (size_t)rowk * NP + 1024 + h * 64, NP, VCT + (size_t)(h * 64) * MROWS + rowk, MROWS, rs_hi - rs_lo + 1,
                             r0, rs_lo, rpbL,
                             P + (size_t)rowq * NP + 3072 + h * 64, NP, H + (size_t)rowq * DM + h * 64, DM, wtw10, gate1011, gate1011 ? pcntB + 16 * (rowq >> 8) : nullptr);
            } else {
                const int r = it - 512, h = r & 15, b = r >> 4;
                const int rowq = b * 256;
                attn_item<0>(lds, tid, P + (size_t)rowq * NP + h * 64, NP,
                             P, NP, VCT, MROWS, 0,
                             P + (size_t)rowq * NP + 1024 + h * 64, NP, VCT + (size_t)(h * 64) * MROWS + rowq, MROWS, 4,
                             0, 0, nullptr,
                             P + (size_t)rowq * NP + 3072 + h * 64, NP, H + (size_t)rowq * DM + h * 64, DM, wtw10, gate1011, gate1011 ? pcntB + 16 * (rowq >> 8) : nullptr);
            }
        }
    }
    if (!gate1011) SEAM(10);
    const bool fuse_last = (G >= (MROWS / 256) * (DM / 256));
    if (IN(11)) REPEAT(11) {
        pg8::Gemm g{H, WOUTO, MROWS, 1024, 1024}; pg8::StaticOrder S; S.init(MROWS, 1024, G, blk);
        if (fuse_last) {
            if (gate1011) {
                pg8::Unit u0;
                if (S.next(0, u0)) {
                    if (tid == 0) {
                        unsigned spins = 0;
                        while (__hip_atomic_load(pcntB + 16 * u0.pm, __ATOMIC_RELAXED, __HIP_MEMORY_SCOPE_AGENT) < 16u) { __builtin_amdgcn_s_sleep(1); if (++spins > (1u << 22)) break; }
                        __builtin_amdgcn_fence(__ATOMIC_ACQUIRE, "agent");
                        asm volatile("s_waitcnt vmcnt(0)" ::: "memory");
                    }
                }
                __syncthreads();
            }
            EpiFinal E{X1P, X1S, MOD, gpost + DM, out, (float*)(ws + WS_G), (unsigned*)(ws + 16384)};
            pg8::gemm_phase(lds, g, S, E);
        } else {
            EpiPlain E{Y2, DM};
            pg8::gemm_phase(lds, g, S, E);
        }
    }
    if (!fuse_last) {
    SEAM(11);
    if (IN(12)) {
        for (int row0 = gw; row0 < MROWS; row0 += 2 * NGW) {
            const float* xr[2]; const bf16_t* yr[2]; const float* md1[2]; float* x1r[2]; bf16_t* hr[2];
#pragma unroll
            for (int r = 0; r < 2; ++r) {
                const int row = min(row0 + r * NGW, MROWS - 1);
                const int v = row < MP ? 0 : 1 + ((row - MP) >> 12);
                xr[r] = (const float*)X1ROW(row); yr[r] = Y2 + (size_t)row * DM; md1[r] = MOD + (1 * 3 + v) * 3072; x1r[r] = out + (size_t)row * DM; hr[r] = nullptr;
            }
            postnorm_rows<false, 2, true, false>(xr, yr, gpost + DM, md1, x1r, nullptr, md1, hr, lane);
        }
    }
    }
#undef IN
#undef SEAM
#undef REPEAT
#undef lane
#undef wave
#undef gw
#undef X1ROW
}

#ifndef MK_COOP
#define MK_COOP 1
#endif
extern "C" void kernel_launch(void* const* d_in, const int* in_sizes, int n_in, void* d_out, int out_size, void* d_ws, size_t ws_size, hipStream_t stream) {
    static int grid = 0;
    if (grid == 0) {
        int dev = 0, cus = 0, per_cu = 0;
        (void)hipGetDevice(&dev);
        (void)hipDeviceGetAttribute(&cus, hipDeviceAttributeMultiprocessorCount, dev);
        (void)hipFuncSetAttribute((const void*)fwd_megakernel, hipFuncAttributeMaxDynamicSharedMemorySize, LDS_BYTES);
        (void)hipOccupancyMaxActiveBlocksPerMultiprocessor(&per_cu, (const void*)fwd_megakernel, 512, LDS_BYTES);
        if (per_cu < 1) { fprintf(stderr, "kernel_launch: occupancy query returned %d\n", per_cu); per_cu = 1; }
        grid = cus * per_cu;
        if (ws_size < WS_END) fprintf(stderr, "kernel_launch: workspace too small (%zu < %zu)\n", ws_size, (size_t)WS_END);
    }
    Params p{};
    for (int i = 0; i < 24; ++i) p.in[i] = (const float*)d_in[i];
    p.out = (float*)d_out; p.ws = (unsigned char*)d_ws;
#if MK_COOP
    p.ph_lo = 0; p.ph_hi = 13; p.coop = 1; p.pad = 0;
    void* args[] = {&p};
    (void)hipMemsetAsync((char*)d_ws + WS_BAR, 0, 131072, stream);
    hipError_t e = hipLaunchCooperativeKernel((const void*)fwd_megakernel, dim3(grid), dim3(512), args, LDS_BYTES, stream);
    if (e != hipSuccess) fprintf(stderr, "cooperative launch failed: %s (grid %d)\n", hipGetErrorString(e), grid);
#else
    for (int ph = 0; ph < 13; ++ph) {
        p.ph_lo = ph; p.ph_hi = ph + 1; p.coop = 0; p.pad = 0;
        hipLaunchKernelGGL(fwd_megakernel, dim3(grid), dim3(512), LDS_BYTES, stream, p);
    }
#endif
}
```

```cpp
#include <hip/hip_runtime.h>
#include <hip/hip_cooperative_groups.h>
#include <cstdio>
#include <cstdint>
namespace cg = cooperative_groups;

#define LAS __attribute__((address_space(3)))
#define DI __device__ __forceinline__
typedef unsigned short bf16_t;
typedef short bf16x8 __attribute__((ext_vector_type(8)));
typedef short s16x4 __attribute__((ext_vector_type(4)));
typedef float f32x4 __attribute__((ext_vector_type(4)));
typedef float f32x2 __attribute__((ext_vector_type(2)));
typedef float f32x16 __attribute__((ext_vector_type(16)));
typedef unsigned u32x4 __attribute__((ext_vector_type(4)));
typedef unsigned u32x2 __attribute__((ext_vector_type(2)));
typedef __bf16 bf16x2_t __attribute__((ext_vector_type(2)));

constexpr int DM = 1024, MP = 4096, MS = 8192, MROWS = 12288, NP = 4096;
constexpr float EPS = 1e-6f;
constexpr float LOG2E = 1.4426950408889634f;
constexpr float QSCALE = 0.125f * LOG2E;
constexpr int C_QA = 0, C_KA = 512, C_VA = 1024, C_OA = 1536, C_G = 2048, C_QB = 2064, C_KB = 2576, C_VB = 2704, C_Z = 2832, C_END = 3856;
constexpr size_t O_YP = 0, O_YS = 4194304, O_C = 12582912, O_N = 14680064, O_M = 14696448, O_GK = 14696576, O_GV = 15220864, O_NK = 15745152, O_NV = 19939456;
constexpr size_t MiB = 1u << 20;
constexpr size_t WS_BAR = 0;
constexpr size_t WS_MOD = 1 * MiB;
constexpr size_t WS_G = 2 * MiB;
constexpr size_t WS_SC = 3 * MiB;
constexpr size_t WS_CH = 5 * MiB;
constexpr size_t WS_UN = 5 * MiB + 65536;
constexpr size_t WS_NST = 5 * MiB + 65536 + 393216;
constexpr size_t WS_MJ = 5 * MiB + 65536 + 786432;
constexpr size_t WS_CK = 6 * MiB;
constexpr size_t WS_CVT = 6 * MiB + 131072;
constexpr size_t WS_NK = 7 * MiB;
constexpr size_t WS_NVT = 8 * MiB;
constexpr size_t WS_WINE = 10 * MiB;
constexpr size_t WS_WOUTE = 18 * MiB;
constexpr size_t WS_WINO = 20 * MiB;
constexpr size_t WS_WOUTO = 28 * MiB;
constexpr size_t WS_H = 30 * MiB;
constexpr size_t WS_KT = 54 * MiB;
constexpr size_t WS_VT = 66 * MiB;
constexpr size_t WS_Y2 = 54 * MiB;
constexpr size_t WS_P = 78 * MiB;
constexpr size_t WS_CST = 174 * MiB;
constexpr size_t WS_QB = 198 * MiB;
constexpr size_t WS_KB = 210 * MiB;
constexpr size_t WS_VBT = 213 * MiB;
constexpr size_t WS_U = 216 * MiB;
constexpr size_t WS_VCT = 216 * MiB;
constexpr size_t WS_X1P = 10 * MiB;
constexpr size_t WS_X1S = 240 * MiB;
constexpr size_t WS_END = 256 * MiB;

constexpr int REP_MASK = 0, SYNC_REP = 1;
constexpr int LDS_BYTES = 147456;

DI float bf2f(unsigned short b) { return __uint_as_float(((unsigned)b) << 16); }
DI unsigned cvtpk(float lo, float hi) { f32x2 v = {lo, hi}; bf16x2_t b = __builtin_convertvector(v, bf16x2_t); return __builtin_bit_cast(unsigned, b); }
DI unsigned short f2bf(float x) { return (unsigned short)(cvtpk(x, 0.f) & 0xffffu); }
DI float siluf(float x) { return x / (1.f + __expf(-x)); }
DI float sigmf(float x) { return 1.f / (1.f + __expf(-x)); }
DI float wave_sum(float v) {
#pragma unroll
    for (int o = 1; o < 64; o <<= 1) v += __shfl_xor(v, o);
    return v;
}
DI int crow(int i, int h) { return (i & 3) + 8 * (i >> 2) + 4 * h; }
DI bf16x8 pack8(float a0, float a1, float a2, float a3, float a4, float a5, float a6, float a7) {
    u32x4 p; p.x = cvtpk(a0, a1); p.y = cvtpk(a2, a3); p.z = cvtpk(a4, a5); p.w = cvtpk(a6, a7);
    return __builtin_bit_cast(bf16x8, p);
}
#define MFMA32(a, b, c) __builtin_amdgcn_mfma_f32_32x32x16_bf16((a), (b), (c), 0, 0, 0)

namespace pg8 {
constexpr int BM = 256, BK = 64, HALF = 128, HTB = HALF * BK * 2, NXCD = 8, WGM = 8;
DI int lds_byte(int r, int c) { const int st = (r >> 4) * 2 + (c >> 5), rr = r & 15, cc = c & 31, ob = rr * 64 + cc * 2; return st * 1024 + (ob ^ (((ob >> 9) & 1) << 5)); }
DI void stage_rc(int b, int& R, int& C) { const int st = b / 1024, sb = b % 1024, swz = sb ^ (((sb >> 9) & 1) << 5); R = (st >> 1) * 16 + swz / 64; C = (st & 1) * 32 + (swz % 64) / 2; }
DI int perm32(int rho) { const int n = rho >> 4, i = rho & 15; return 8 * (i >> 2) + 4 * n + (i & 3); }
struct Unit { int pm, pn; };
struct Gemm { const bf16_t* A; const bf16_t* Bt; int M, N, K; };
struct StaticOrder {
    int nM, nN, nwg, G, c;
    DI void init(int M, int N, int G_, int c_) { nM = M / BM; nN = N / BM; nwg = nM * nN; G = G_; c = c_; }
    DI bool next(int i, Unit& u) const {
        const long L = (long)i * G + c; if (L >= nwg) return false;
        int wgid = (int)L; { const int q = nwg / NXCD, r = nwg % NXCD, xcd = wgid % NXCD, off = wgid / NXCD; wgid = (xcd < r ? xcd * (q + 1) : r * (q + 1) + (xcd - r) * q) + off; }
        const int nig = WGM * nN, gid = wgid / nig, fm = gid * WGM, gsz = (nM - fm) < WGM ? (nM - fm) : WGM;
        u.pm = fm + ((wgid % nig) % gsz); u.pn = (wgid % nig) / gsz; return true;
    }
};
template <class Epi>
DI void gemm_phase(LAS unsigned char* lds, const Gemm g, const StaticOrder& S, const Epi& E) {
    const int tid = threadIdx.x, wid = __builtin_amdgcn_readfirstlane(tid >> 6), lane = tid & 63, wr = wid >> 2, wc = wid & 3, fr = lane & 15, fq = lane >> 4;
    const int K = g.K, nt = K / BK;
    unsigned voffA[2], voffB[2];
#pragma unroll
    for (int i = 0; i < 2; ++i) { int R, C; stage_rc(tid * 16 + i * 8192, R, C); const int Rb = (R & ~31) + perm32(R & 31);
        voffA[i] = (unsigned)(R * K + C) * 2u; voffB[i] = (unsigned)(Rb * K + C) * 2u; }
    const size_t kstep = (size_t)(BK * 2);
    const size_t hstep = (size_t)HALF * K * 2;
    const size_t tstep = 2 * hstep;
    const unsigned ldsw = (unsigned)wid * 1024u;
    const int aoff = lds_byte(wr * 64 + fr, fq * 8), boff = lds_byte(wc * 32 + fr, fq * 8);
#define PG8_SA(b, h) (((b) * 2 + (h)) * HTB)
#define PG8_SB(b, h) ((4 + (b) * 2 + (h)) * HTB)
#define PG8_STAGE(bufoff, gbase, voff) do { _Pragma("unroll") for (int _i = 0; _i < 2; ++_i) \
        __builtin_amdgcn_global_load_lds((const unsigned*)((const char*)(gbase) + (voff)[_i]), (LAS unsigned*)(lds + (bufoff) + ldsw + _i * 8192), 16, 0, 0); } while (0)
#define PG8_LDA(dst, b, h) do { _Pragma("unroll") for (int m = 0; m < 4; ++m) _Pragma("unroll") for (int k = 0; k < 2; ++k) dst[m][k] = *(const LAS bf16x8*)(lds + PG8_SA(b, h) + aoff + m * 2048 + k * 1024); } while (0)
#define PG8_LDB(dst, b, h) do { _Pragma("unroll") for (int n = 0; n < 2; ++n) _Pragma("unroll") for (int k = 0; k < 2; ++k) dst[n][k] = *(const LAS bf16x8*)(lds + PG8_SB(b, h) + boff + n * 2048 + k * 1024); } while (0)
#define PG8_MMA(ai, bj, At, Bt) do { __builtin_amdgcn_s_setprio(1); _Pragma("unroll") for (int m = 0; m < 4; ++m) _Pragma("unroll") for (int n = 0; n < 2; ++n) _Pragma("unroll") for (int k = 0; k < 2; ++k) \
        acc[ai][bj][m][n] = __builtin_amdgcn_mfma_f32_16x16x32_bf16(Bt[n][k], At[m][k], acc[ai][bj][m][n], 0, 0, 0); __builtin_amdgcn_s_setprio(0); } while (0)
#define PG8_WAIT_V(n) asm volatile("s_waitcnt vmcnt(" #n ")" ::: "memory")
#define PG8_WAIT_L(n) asm volatile("s_waitcnt lgkmcnt(" #n ")" ::: "memory")
#define PG8_BAR __builtin_amdgcn_s_barrier()
#define PG8_SCHED __builtin_amdgcn_sched_barrier(0)
    Unit cur, nxt; int ui = 0;
    if (!S.next(0, cur)) return;
    f32x4 acc[2][2][4][2];
#pragma unroll
    for (int a = 0; a < 2; ++a)
#pragma unroll
        for (int b = 0; b < 2; ++b)
#pragma unroll
            for (int m = 0; m < 4; ++m)
#pragma unroll
                for (int n = 0; n < 2; ++n) acc[a][b][m][n] = (f32x4){0.f, 0.f, 0.f, 0.f};
    bf16x8 At[4][2], B0[2][2], B1[2][2];
    const char* cA = (const char*)g.A + (size_t)cur.pm * tstep; const char* cB = (const char*)g.Bt + (size_t)cur.pn * tstep;
    PG8_STAGE(PG8_SB(0, 0), cB, voffB); PG8_STAGE(PG8_SB(0, 1), cB + hstep, voffB); PG8_STAGE(PG8_SA(0, 0), cA, voffA); PG8_STAGE(PG8_SA(0, 1), cA + hstep, voffA);
    if (wr == 1) PG8_BAR;
    PG8_WAIT_V(2); PG8_BAR;
    PG8_STAGE(PG8_SB(1, 0), cB + kstep, voffB); PG8_STAGE(PG8_SA(1, 0), cA + kstep, voffA); PG8_STAGE(PG8_SB(1, 1), cB + hstep + kstep, voffB);
    PG8_WAIT_V(6); PG8_BAR;
    for (;;) {
        const bool has_next = S.next(ui + 1, nxt);
        const char* nA = has_next ? (const char*)g.A + (size_t)nxt.pm * tstep : cA; const char* nB = has_next ? (const char*)g.Bt + (size_t)nxt.pn * tstep : cB;
        for (int t = 0; t < nt; t += 2) {
            const bool last = (t == nt - 2);
            const char* a1 = cA + (size_t)(t + 1) * kstep;
            const char* a2 = last ? nA : cA + (size_t)(t + 2) * kstep; const char* b2 = last ? nB : cB + (size_t)(t + 2) * kstep;
            const char* a3 = a2 + kstep; const char* b3 = b2 + kstep;
            PG8_LDB(B0, 0, 0); PG8_LDB(B1, 0, 1); PG8_SCHED; PG8_LDA(At, 0, 0); PG8_STAGE(PG8_SA(1, 1), a1 + hstep, voffA);
            PG8_WAIT_V(8); PG8_WAIT_L(0); PG8_BAR; PG8_MMA(0, 0, At, B0); PG8_MMA(0, 1, At, B1); PG8_BAR; PG8_SCHED;
            PG8_LDA(At, 0, 1); PG8_STAGE(PG8_SB(0, 0), b2, voffB); PG8_STAGE(PG8_SB(0, 1), b2 + hstep, voffB); PG8_STAGE(PG8_SA(0, 0), a2, voffA);
            PG8_WAIT_V(8); PG8_WAIT_L(0); PG8_BAR; PG8_MMA(1, 0, At, B0); PG8_MMA(1, 1, At, B1); PG8_BAR; PG8_SCHED;
            PG8_LDB(B0, 1, 0); PG8_LDB(B1, 1, 1); PG8_SCHED; PG8_LDA(At, 1, 0); PG8_STAGE(PG8_SA(0, 1), a2 + hstep, voffA);
            PG8_WAIT_V(8); PG8_WAIT_L(0); PG8_BAR; PG8_MMA(0, 0, At, B0); PG8_MMA(0, 1, At, B1); PG8_BAR; PG8_SCHED;
            PG8_LDA(At, 1, 1); PG8_STAGE(PG8_SB(1, 0), b3, voffB); PG8_STAGE(PG8_SB(1, 1), b3 + hstep, voffB); PG8_STAGE(PG8_SA(1, 0), a3, voffA);
            PG8_WAIT_V(8); PG8_WAIT_L(0); PG8_BAR; PG8_MMA(1, 0, At, B0); PG8_MMA(1, 1, At, B1); PG8_BAR; PG8_SCHED;
        }
        if (wr == 0) PG8_BAR;
        if constexpr (!Epi::AFTER_DRAIN) E(acc, cur, wr, wc, fr, fq);
        if (!has_next) break;
#pragma unroll
        for (int a = 0; a < 2; ++a)
#pragma unroll
            for (int b = 0; b < 2; ++b)
#pragma unroll
                for (int m = 0; m < 4; ++m)
#pragma unroll
                    for (int n = 0; n < 2; ++n) acc[a][b][m][n] = (f32x4){0.f, 0.f, 0.f, 0.f};
        cur = nxt; cA = nA; cB = nB; ++ui;
        if (wr == 1) PG8_BAR;
    }
    PG8_WAIT_V(0);
    PG8_BAR;
    if constexpr (Epi::AFTER_DRAIN) E.fused(acc, cur, wr, wc, fr, fq, lds, wid, lane);
#undef PG8_SA
#undef PG8_SB
#undef PG8_STAGE
#undef PG8_LDA
#undef PG8_LDB
#undef PG8_MMA
#undef PG8_WAIT_V
#undef PG8_WAIT_L
#undef PG8_BAR
#undef PG8_SCHED
}
}

struct Params {
    const float* in[24];
    float* out;
    unsigned char* ws;
    int ph_lo, ph_hi, coop, pad;
};

struct WT { __amdgpu_buffer_rsrc_t rs; const unsigned char* base; };
DI WT mk_wt(const void* base, unsigned bytes) { WT w; w.rs = __builtin_amdgcn_make_buffer_rsrc((void*)base, (short)0, (int)bytes, 0x00020000); w.base = (const unsigned char*)base; return w; }
DI void wt16(const WT& w, const void* p, u32x4 v) { __builtin_amdgcn_raw_buffer_store_b128(v, w.rs, (unsigned)((const unsigned char*)p - w.base), 0, 16); }
DI void st_bf16x8(bf16_t* p, f32x4 a, f32x4 b) {
    u32x4 w; w.x = cvtpk(a[0], a[1]); w.y = cvtpk(a[2], a[3]); w.z = cvtpk(b[0], b[1]); w.w = cvtpk(b[2], b[3]);
    *(u32x4*)p = w;
}

struct EpiEvenIn {
    static constexpr bool AFTER_DRAIN = false;
    bf16_t* P; bf16_t* KT; bf16_t* VT; bf16_t* VbT; float* G; float* out;
    DI void operator()(const f32x4 (&acc)[2][2][4][2], const pg8::Unit& u, int wr, int wc, int fr, int fq) const {
#pragma unroll
        for (int bj = 0; bj < 2; ++bj) {
            const int c8 = u.pn * 256 + bj * 128 + wc * 32 + 8 * fq;
            if (c8 >= C_END) continue;
#pragma unroll
            for (int ai = 0; ai < 2; ++ai)
#pragma unroll
                for (int m = 0; m < 4; ++m) {
                    const int row = u.pm * 256 + ai * 128 + wr * 64 + m * 16 + fr;
                    f32x4 v0 = acc[ai][bj][m][0], v1 = acc[ai][bj][m][1];
                    if (c8 >= C_KA && c8 < C_VA) { v0 = v0 * 0.08838834764831845f; v1 = v1 * 0.08838834764831845f; }
                    if (c8 >= C_Z) {
#pragma unroll
                        for (int j = 0; j < 4; ++j) { v0[j] = siluf(v0[j]); v1[j] = siluf(v1[j]); }
                    }
                    if (c8 >= C_G && c8 < C_QB) {
                        *(f32x4*)(G + (size_t)row * 16 + (c8 - C_G)) = v0; *(f32x4*)(G + (size_t)row * 16 + (c8 - C_G) + 4) = v1;
                    } else {
                        st_bf16x8(P + (size_t)row * NP + c8, v0, v1);
                    }
                    bf16_t* T = nullptr; int tc = 0;
                    if (c8 >= C_KA && c8 < C_VA) { T = KT; tc = c8 - C_KA; }
                    else if (c8 >= C_VA && c8 < C_OA) { T = VT; tc = c8 - C_VA; }
                    else if (c8 >= C_VB && c8 < C_Z) { T = VbT; tc = c8 - C_VB; }
                    if (T) {
#pragma unroll
                        for (int j = 0; j < 4; ++j) { T[(size_t)(tc + j) * MROWS + row] = f2bf(v0[j]); T[(size_t)(tc + 4 + j) * MROWS + row] = f2bf(v1[j]); }
                    }
                    if (c8 >= C_VB && c8 < C_Z && row < MP) {
                        const int c = c8 - C_VB, hk = c >> 6, d = c & 63, b = row >> 8, t = row & 255;
                        float* o = out + O_GV + ((size_t)((b * 2 + hk) * 256 + t)) * 64 + d;
                        *(f32x4*)o = v0; *(f32x4*)(o + 4) = v1;
                    }
                }
        }
    }
};
struct EpiPlain {
    static constexpr bool AFTER_DRAIN = false;
    bf16_t* O; int ldc;
    DI void operator()(const f32x4 (&acc)[2][2][4][2], const pg8::Unit& u, int wr, int wc, int fr, int fq) const {
#pragma unroll
        for (int bj = 0; bj < 2; ++bj) {
            const int c8 = u.pn * 256 + bj * 128 + wc * 32 + 8 * fq;
#pragma unroll
            for (int ai = 0; ai < 2; ++ai)
#pragma unroll
                for (int m = 0; m < 4; ++m) {
                    const int row = u.pm * 256 + ai * 128 + wr * 64 + m * 16 + fr;
                    st_bf16x8(O + (size_t)row * ldc + c8, acc[ai][bj][m][0], acc[ai][bj][m][1]);
                }
        }
    }
};
struct EpiOddIn {
    static constexpr bool AFTER_DRAIN = false;
    bf16_t* P; bf16_t* VcT; float* out;
    DI void operator()(const f32x4 (&acc)[2][2][4][2], const pg8::Unit& u, int wr, int wc, int fr, int fq) const {
#pragma unroll
        for (int bj = 0; bj < 2; ++bj) {
            const int c8 = u.pn * 256 + bj * 128 + wc * 32 + 8 * fq;
            const int seg = c8 >> 10, c = c8 & 1023;
#pragma unroll
            for (int ai = 0; ai < 2; ++ai)
#pragma unroll
                for (int m = 0; m < 4; ++m) {
                    const int row = u.pm * 256 + ai * 128 + wr * 64 + m * 16 + fr;
                    f32x4 v0 = acc[ai][bj][m][0], v1 = acc[ai][bj][m][1];
                    if ((seg == 1 || seg == 2) && row < MP) {
                        const int h = c >> 6, d = c & 63, b = row >> 8, t = row & 255;
                        float* o = out + (seg == 1 ? O_NK : O_NV) + ((size_t)((b * 16 + h) * 256 + t)) * 64 + d;
                        *(f32x4*)o = v0; *(f32x4*)(o + 4) = v1;
                    }
                    if (seg == 2) {
#pragma unroll
                        for (int j = 0; j < 4; ++j) { VcT[(size_t)(c + j) * MROWS + row] = f2bf(v0[j]); VcT[(size_t)(c + 4 + j) * MROWS + row] = f2bf(v1[j]); }
                    } else {
                        if (seg == 0) { v0 = v0 * QSCALE; v1 = v1 * QSCALE; }
                        if (seg == 3) {
#pragma unroll
                            for (int j = 0; j < 4; ++j) { v0[j] = siluf(v0[j]); v1[j] = siluf(v1[j]); }
                        }
                        st_bf16x8(P + (size_t)row * NP + c8, v0, v1);
                    }
                }
        }
    }
};

DI void panel_row_rinv(const f32x4 (&v)[2][2][4][2], const pg8::Unit& u, int wr, int wc, int fr, int fq, LAS float* Pl, LAS float* Sl, int tid, float* slot, unsigned* c) {
#pragma unroll
    for (int ai = 0; ai < 2; ++ai)
#pragma unroll
        for (int m = 0; m < 4; ++m) {
            float sq = 0.f;
#pragma unroll
            for (int bj = 0; bj < 2; ++bj)
#pragma unroll
                for (int n = 0; n < 2; ++n) { const f32x4 x = v[ai][bj][m][n]; sq += (x[0] * x[0] + x[1] * x[1]) + (x[2] * x[2] + x[3] * x[3]); }
            sq += __shfl_xor(sq, 16); sq += __shfl_xor(sq, 32);
            if (fq == 0) Pl[(ai * 128 + wr * 64 + m * 16 + fr) * 4 + wc] = sq;
        }
    __syncthreads();
    if (tid < 256) {
        const float tot = (Pl[tid * 4 + 0] + Pl[tid * 4 + 1]) + (Pl[tid * 4 + 2] + Pl[tid * 4 + 3]);
        __hip_atomic_store(slot + tid * 4 + u.pn, tot, __ATOMIC_RELAXED, __HIP_MEMORY_SCOPE_AGENT);
    }
    asm volatile("s_waitcnt vmcnt(0)" ::: "memory");
    __syncthreads();
    if (tid == 0) {
        __hip_atomic_fetch_add(c, 1u, __ATOMIC_RELAXED, __HIP_MEMORY_SCOPE_AGENT);
        unsigned spins = 0;
        while (__hip_atomic_load(c, __ATOMIC_RELAXED, __HIP_MEMORY_SCOPE_AGENT) < 4u) { __builtin_amdgcn_s_sleep(1); if (++spins > (1u << 22)) break; }
        asm volatile("" ::: "memory");
    }
    __syncthreads();
    if (tid < 256) {
        float t = 0.f;
#pragma unroll
        for (int k = 0; k < 4; ++k) t += __hip_atomic_load(slot + tid * 4 + k, __ATOMIC_RELAXED, __HIP_MEMORY_SCOPE_AGENT);
        Sl[tid] = rsqrtf(t * (1.f / DM) + EPS);
    }
    __syncthreads();
}
struct EpiFinal {
    static constexpr bool AFTER_DRAIN = true;
    const bf16_t* X1P; const bf16_t* X1S; const float* MODl; const float* gpost; float* out; float* xbuf; unsigned* cnt;
    DI void fused(f32x4 (&acc)[2][2][4][2], const pg8::Unit& u, int wr, int wc, int fr, int fq, LAS unsigned char* lds, int wid, int lane) const {
        LAS float* Pl = (LAS float*)lds;
        LAS float* Sl = Pl + 1024;
        const int tid = wid * 64 + lane;
        panel_row_rinv(acc, u, wr, wc, fr, fq, Pl, Sl, tid, xbuf + (size_t)(u.pm * 256) * 4, cnt + 16 * u.pm);
        const int v = u.pm < 16 ? 0 : 1 + ((u.pm - 16) >> 4);
        const float* gate = MODl + (1 * 3 + v) * 3072 + 2048;
#pragma unroll
        for (int bj = 0; bj < 2; ++bj) {
            const int c8 = u.pn * 256 + bj * 128 + wc * 32 + 8 * fq;
            const f32x4 g0 = *(const f32x4*)(gpost + c8), g1 = *(const f32x4*)(gpost + c8 + 4);
            const f32x4 t0 = *(const f32x4*)(gate + c8), t1 = *(const f32x4*)(gate + c8 + 4);
#pragma unroll
            for (int ai = 0; ai < 2; ++ai)
#pragma unroll
                for (int m = 0; m < 4; ++m) {
                    const int rl = ai * 128 + wr * 64 + m * 16 + fr, row = u.pm * 256 + rl;
                    const float rinv = Sl[rl];
                    const u32x4 xr = *(const u32x4*)((row < MP ? X1P + (size_t)row * DM : X1S + (size_t)(row - MP) * DM) + c8);
                    const f32x4 y0 = acc[ai][bj][m][0], y1 = acc[ai][bj][m][1];
                    f32x4 o0, o1;
                    o0[0] = __uint_as_float(xr.x << 16) + t0[0] * (y0[0] * rinv * g0[0]); o0[1] = __uint_as_float(xr.x & 0xffff0000u) + t0[1] * (y0[1] * rinv * g0[1]);
                    o0[2] = __uint_as_float(xr.y << 16) + t0[2] * (y0[2] * rinv * g0[2]); o0[3] = __uint_as_float(xr.y & 0xffff0000u) + t0[3] * (y0[3] * rinv * g0[3]);
                    o1[0] = __uint_as_float(xr.z << 16) + t1[0] * (y1[0] * rinv * g1[0]); o1[1] = __uint_as_float(xr.z & 0xffff0000u) + t1[1] * (y1[1] * rinv * g1[1]);
                    o1[2] = __uint_as_float(xr.w << 16) + t1[2] * (y1[2] * rinv * g1[2]); o1[3] = __uint_as_float(xr.w & 0xffff0000u) + t1[3] * (y1[3] * rinv * g1[3]);
                    float* op = out + (size_t)row * DM + c8;
                    *(f32x4*)op = o0; *(f32x4*)(op + 4) = o1;
                }
        }
    }
};

struct EpiMid {
    static constexpr bool AFTER_DRAIN = true;
    const float* x_prompt; const float* x_sample; const float* MODl; const float* gpost; const float* gpre1; bf16_t* X1P; bf16_t* X1S; bf16_t* Hn; float* xbuf; unsigned* cnt;
    DI void fused(f32x4 (&acc)[2][2][4][2], const pg8::Unit& u, int wr, int wc, int fr, int fq, LAS unsigned char* lds, int wid, int lane) const {
        LAS float* Pl = (LAS float*)lds; LAS float* Sl = Pl + 1024;
        const int tid = wid * 64 + lane;
        panel_row_rinv(acc, u, wr, wc, fr, fq, Pl, Sl, tid, xbuf + (size_t)(12288 + u.pm * 256) * 4, cnt + 16 * (48 + u.pm));
        const int v = u.pm < 16 ? 0 : 1 + ((u.pm - 16) >> 4);
        const float* md0 = MODl + (0 * 3 + v) * 3072; const float* md1 = MODl + (1 * 3 + v) * 3072;
        const float* xbase = u.pm < 16 ? x_prompt + (size_t)(u.pm * 256) * DM : x_sample + (size_t)(u.pm * 256 - MP) * DM;
#pragma unroll
        for (int bj = 0; bj < 2; ++bj) {
            const int c8 = u.pn * 256 + bj * 128 + wc * 32 + 8 * fq;
            const f32x4 g0 = *(const f32x4*)(gpost + c8), g1 = *(const f32x4*)(gpost + c8 + 4);
            const f32x4 t0 = *(const f32x4*)(md0 + 2048 + c8), t1 = *(const f32x4*)(md0 + 2048 + c8 + 4);
#pragma unroll
            for (int ai = 0; ai < 2; ++ai)
#pragma unroll
                for (int m = 0; m < 4; ++m) {
                    const int rl = ai * 128 + wr * 64 + m * 16 + fr, row = u.pm * 256 + rl;
                    const float rinv = Sl[rl];
                    const f32x4 x0 = *(const f32x4*)(xbase + (size_t)rl * DM + c8), x1 = *(const f32x4*)(xbase + (size_t)rl * DM + c8 + 4);
                    f32x4 y0 = acc[ai][bj][m][0], y1 = acc[ai][bj][m][1];
#pragma unroll
                    for (int e = 0; e < 4; ++e) { y0[e] = x0[e] + t0[e] * (y0[e] * rinv * g0[e]); y1[e] = x1[e] + t1[e] * (y1[e] * rinv * g1[e]); }
                    acc[ai][bj][m][0] = y0; acc[ai][bj][m][1] = y1;
                    u32x4 w; w.x = cvtpk(y0[0], y0[1]); w.y = cvtpk(y0[2], y0[3]); w.z = cvtpk(y1[0], y1[1]); w.w = cvtpk(y1[2], y1[3]);
                    *(u32x4*)((row < MP ? X1P + (size_t)row * DM : X1S + (size_t)(row - MP) * DM) + c8) = w;
                }
        }
        panel_row_rinv(acc, u, wr, wc, fr, fq, Pl, Sl, tid, xbuf + (size_t)(2 * 12288 + u.pm * 256) * 4, cnt + 16 * (96 + u.pm));
#pragma unroll
        for (int bj = 0; bj < 2; ++bj) {
            const int c8 = u.pn * 256 + bj * 128 + wc * 32 + 8 * fq;
            const f32x4 g0 = *(const f32x4*)(gpre1 + c8), g1 = *(const f32x4*)(gpre1 + c8 + 4);
            const f32x4 a0 = *(const f32x4*)(md1 + 1024 + c8), a1 = *(const f32x4*)(md1 + 1024 + c8 + 4);
            const f32x4 b0 = *(const f32x4*)(md1 + c8), b1 = *(const f32x4*)(md1 + c8 + 4);
#pragma unroll
            for (int ai = 0; ai < 2; ++ai)
#pragma unroll
                for (int m = 0; m < 4; ++m) {
                    const int rl = ai * 128 + wr * 64 + m * 16 + fr, row = u.pm * 256 + rl;
                    const float r1 = Sl[rl];
                    const f32x4 y0 = acc[ai][bj][m][0], y1 = acc[ai][bj][m][1];
                    float o[8];
#pragma unroll
                    for (int e = 0; e < 4; ++e) { o[e] = y0[e] * r1 * g0[e] * (1.f + a0[e]) + b0[e]; o[4 + e] = y1[e] * r1 * g1[e] * (1.f + a1[e]) + b1[e]; }
                    u32x4 w; w.x = cvtpk(o[0], o[1]); w.y = cvtpk(o[2], o[3]); w.z = cvtpk(o[4], o[5]); w.w = cvtpk(o[6], o[7]);
                    *(u32x4*)(Hn + (size_t)row * DM + c8) = w;
                }
        }
    }
};

constexpr int AT_PITCH = 144, AT_TILE = 64 * AT_PITCH;
DI void attn_tile_load(int it, int nt0, const bf16_t* K0, int k0s, const bf16_t* V0, int v0s, const bf16_t* K1, int k1s, const bf16_t* V1, int v1s, int tid, u32x4& kr, u32x4& vr) {
    const int row = tid >> 3, pc = tid & 7;
    const bf16_t* K; const bf16_t* V; int ks, vs, tt;
    if (it < nt0) { K = K0; V = V0; ks = k0s; vs = v0s; tt = it; } else { K = K1; V = V1; ks = k1s; vs = v1s; tt = it - nt0; }
    kr = *(const u32x4*)(K + (size_t)(tt * 64 + row) * ks + pc * 8);
    vr = *(const u32x4*)(V + (size_t)row * vs + tt * 64 + pc * 8);
}
DI void attn_tile_store(LAS unsigned char* kb, LAS unsigned char* vb, int tid, const u32x4& kr, const u32x4& vr, bool nat) {
    const int row = tid >> 3, pc = tid & 7;
    *(LAS u32x4*)(kb + row * AT_PITCH + pc * 16) = kr;
    if (nat) { *(LAS u32x4*)(vb + row * AT_PITCH + pc * 16) = vr; return; }
    const int grp = pc >> 1, b3 = pc & 1;
    u32x2 lo = {vr.x, vr.y}, hi = {vr.z, vr.w};
    *(LAS u32x2*)(vb + row * AT_PITCH + (16 * grp + 4 * b3) * 2) = lo;
    *(LAS u32x2*)(vb + row * AT_PITCH + (16 * grp + 8 + 4 * b3) * 2) = hi;
}

DI void attn_qk(const LAS unsigned char* kb, const bf16x8 (&qf)[4], int l32, int half, float nm, f32x16& s0, f32x16& s1) {
    bf16x8 a[8];
#pragma unroll
    for (int s = 0; s < 4; ++s) {
        a[2 * s] = *(const LAS bf16x8*)(kb + l32 * AT_PITCH + s * 32 + half * 16);
        a[2 * s + 1] = *(const LAS bf16x8*)(kb + (32 + l32) * AT_PITCH + s * 32 + half * 16);
    }
    f32x16 nmC;
#pragma unroll
    for (int i = 0; i < 16; ++i) nmC[i] = nm;
    s0 = MFMA32(a[0], qf[0], nmC); s1 = MFMA32(a[1], qf[0], nmC);
#pragma unroll
    for (int s = 1; s < 4; ++s) { s0 = MFMA32(a[2 * s], qf[s], s0); s1 = MFMA32(a[2 * s + 1], qf[s], s1); }
}
DI void attn_bias(f32x16& s0, f32x16& s1, const LAS float* bp, int half, int cs) {
#pragma unroll
    for (int i = 0; i < 16; ++i) {
        const int kc0 = 8 * (i >> 2) + (i & 3);
        const int kca = kc0 + 4 * half, kcb = kca + 32;
        const float b0 = bp[kc0], b1 = bp[kc0 + 32];
        s0[i] = ((unsigned)(kca - cs) < 16u) ? s0[i] + b0 : -1e30f;
        s1[i] = ((unsigned)(kcb - cs) < 16u) ? s1[i] + b1 : -1e30f;
    }
}
DI float attn_max(const f32x16& s0, const f32x16& s1) {
    float mx = fmaxf(s0[0], s1[0]);
#pragma unroll
    for (int i = 1; i < 16; ++i) mx = fmaxf(mx, fmaxf(s0[i], s1[i]));
    return mx;
}
DI void attn_pv(const LAS unsigned char* vb, f32x16& s0, f32x16& s1, int l32, int half, const bf16x8& ones, f32x16& o0, f32x16& o1, f32x16& lacc) {
    bf16x8 v[8];
#pragma unroll
    for (int s = 0; s < 4; ++s) {
        v[2 * s] = *(const LAS bf16x8*)(vb + l32 * AT_PITCH + (16 * s + 8 * half) * 2);
        v[2 * s + 1] = *(const LAS bf16x8*)(vb + (32 + l32) * AT_PITCH + (16 * s + 8 * half) * 2);
    }
#pragma unroll
    for (int i = 0; i < 16; ++i) { s0[i] = __builtin_amdgcn_exp2f(s0[i]); s1[i] = __builtin_amdgcn_exp2f(s1[i]); }
    bf16x8 pf[4];
    pf[0] = pack8(s0[0], s0[1], s0[2], s0[3], s0[4], s0[5], s0[6], s0[7]);
    pf[1] = pack8(s0[8], s0[9], s0[10], s0[11], s0[12], s0[13], s0[14], s0[15]);
    pf[2] = pack8(s1[0], s1[1], s1[2], s1[3], s1[4], s1[5], s1[6], s1[7]);
    pf[3] = pack8(s1[8], s1[9], s1[10], s1[11], s1[12], s1[13], s1[14], s1[15]);
#pragma unroll
    for (int s = 0; s < 4; ++s) {
        o0 = MFMA32(v[2 * s], pf[s], o0); o1 = MFMA32(v[2 * s + 1], pf[s], o1);
        lacc = MFMA32(ones, pf[s], lacc);
    }
}

DI void attn_qk32(const LAS unsigned char* kb, const bf16x8 (&qf)[4], int krow, int half, float nm, f32x16& sv) {
    f32x16 nmC;
#pragma unroll
    for (int i = 0; i < 16; ++i) nmC[i] = nm;
    const LAS unsigned char* p = kb + krow * AT_PITCH + half * 16;
    sv = MFMA32(*(const LAS bf16x8*)p, qf[0], nmC);
#pragma unroll
    for (int s = 1; s < 4; ++s) sv = MFMA32(*(const LAS bf16x8*)(p + s * 32), qf[s], sv);
}
DI void attn_bias32(f32x16& sv, const LAS float* bp, int kcb, bool rowvalid) {
#pragma unroll
    for (int i = 0; i < 16; ++i) {
        const int kc0 = 8 * (i >> 2) + (i & 3);
        const float b0 = bp[kc0];
        sv[i] = (rowvalid && (unsigned)(kcb + kc0) < 16u) ? sv[i] + b0 : -1e30f;
    }
}
DI float attn_max16(const f32x16& sv) {
    float mx = sv[0];
#pragma unroll
    for (int i = 1; i < 16; ++i) mx = fmaxf(mx, sv[i]);
    return mx;
}
DI void attn_pv32(const LAS unsigned char* vb, f32x16& sv, int l32, int half, int k0, const bf16x8& ones, f32x16& o0, f32x16& o1, f32x16& lacc) {
#pragma unroll
    for (int i = 0; i < 16; ++i) sv[i] = __builtin_amdgcn_exp2f(sv[i]);
    const bf16x8 pf0 = pack8(sv[0], sv[1], sv[2], sv[3], sv[4], sv[5], sv[6], sv[7]);
    const bf16x8 pf1 = pack8(sv[8], sv[9], sv[10], sv[11], sv[12], sv[13], sv[14], sv[15]);
#pragma unroll
    for (int s2 = 0; s2 < 2; ++s2) {
        const LAS unsigned char* p0 = vb + l32 * AT_PITCH + (k0 + 16 * s2 + 4 * half) * 2;
        const LAS unsigned char* p1 = p0 + 32 * AT_PITCH;
        const s16x4 lo0 = *(const LAS s16x4*)p0, hi0 = *(const LAS s16x4*)(p0 + 16);
        const s16x4 lo1 = *(const LAS s16x4*)p1, hi1 = *(const LAS s16x4*)(p1 + 16);
        const bf16x8 A0 = __builtin_shufflevector(lo0, hi0, 0, 1, 2, 3, 4, 5, 6, 7);
        const bf16x8 A1 = __builtin_shufflevector(lo1, hi1, 0, 1, 2, 3, 4, 5, 6, 7);
        o0 = MFMA32(A0, s2 == 0 ? pf0 : pf1, o0); o1 = MFMA32(A1, s2 == 0 ? pf0 : pf1, o1);
        lacc = MFMA32(ones, s2 == 0 ? pf0 : pf1, lacc);
    }
}

template <int MODE>
DI void attn_item(LAS unsigned char* lds, int tid,
                  const bf16_t* Q, int qstride,
                  const bf16_t* K0, int k0s, const bf16_t* V0, int v0s, int nt0,
                  const bf16_t* K1, int k1s, const bf16_t* V1, int v1s, int nt1,
                  int r0, int rs_lo, const LAS float* rpbL,
                  const bf16_t* Z, int zstride, bf16_t* O, int ostride, const WT& wt, bool usewt, unsigned* pcnt) {
    const int lane = tid & 63, w = tid >> 6, l32 = lane & 31, half = lane >> 5;
    const int np = (nt0 + nt1 + 1) >> 1;
    const int ng = w & 3, nrp = w >> 2;
    const int qc = (MODE == 1) ? 16 * ng + (l32 & 15) : 0;
    const int qrw = (MODE == 1) ? 2 * nrp + (l32 >> 4) : 0;
    const int qr = r0 + qrw;
    const int qrow = (MODE == 1) ? qrw * 64 + qc : w * 32 + l32;
    const int k0 = (ng == 0) ? 0 : (ng == 1) ? 8 : (ng == 2) ? 24 : 32;
    bf16x8 qf[4];
#pragma unroll
    for (int s = 0; s < 4; ++s) qf[s] = *(const bf16x8*)(Q + (size_t)qrow * qstride + 16 * s + 8 * half);
    f32x16 o0, o1, lacc;
#pragma unroll
    for (int i = 0; i < 16; ++i) { o0[i] = 0.f; o1[i] = 0.f; lacc[i] = 0.f; }
    float m_run = 0.f;
    const bf16x8 ones = {0x3F80, 0x3F80, 0x3F80, 0x3F80, 0x3F80, 0x3F80, 0x3F80, 0x3F80};
    const int cs = min(max(qc - 8, 0), 48);
    const int rsq = min(max(qr - 4, 0), 56);
    const int rsw_lo = min(max(r0 + 2 * nrp - 4, 0), 56), rsw_hi = min(max(r0 + 2 * nrp + 1 - 4, 0), 56) + 8;

    u32x4 eka, eva, ekb, evb;
#define AT_LOAD(pair, ka, va, kb_, vb_) do { attn_tile_load(2 * (pair), nt0, K0, k0s, V0, v0s, K1, k1s, V1, v1s, tid, ka, va); \
        attn_tile_load(2 * (pair) + 1, nt0, K0, k0s, V0, v0s, K1, k1s, V1, v1s, tid, kb_, vb_); } while (0)
#define AT_STORE(stage, pair, ka, va, kb_, vb_) do { LAS unsigned char* nb_ = lds + (stage) * 4 * AT_TILE; const bool nat_ = (MODE == 1) && (2 * (pair) >= nt0); \
        attn_tile_store(nb_, nb_ + AT_TILE, tid, ka, va, nat_); attn_tile_store(nb_ + 2 * AT_TILE, nb_ + 3 * AT_TILE, tid, kb_, vb_, nat_); } while (0)
#define AT_SLOWPATH(ip_, EXTRA) \
            mx = fmaxf(mx, __shfl_xor(mx, 32)); \
            const bool need = ((ip_) == 0) || (mx > 8.f); \
            if (__builtin_amdgcn_ballot_w64(need) != 0ull) { \
                const float delta = need ? mx : 0.f; \
                const float alpha = __builtin_amdgcn_exp2f(-delta); \
                m_run += delta; \
                _Pragma("unroll") for (int i = 0; i < 16; ++i) { EXTRA; o0[i] *= alpha; o1[i] *= alpha; lacc[i] *= alpha; } \
            }
#define AT_COMPUTE(ip_) do { \
        LAS unsigned char* base = lds + ((ip_) & 1) * 4 * AT_TILE; \
        const int ita = 2 * (ip_), itb = 2 * (ip_) + 1; \
        if (MODE == 1 && ita >= nt0) { \
            const int kra_ = rs_lo + (ita - nt0), krb_ = kra_ + 1; \
            const bool acta = (kra_ >= rsw_lo) && (kra_ < rsw_hi), actb = (krb_ >= rsw_lo) && (krb_ < rsw_hi); \
            if (acta || actb) { \
                f32x16 sa, sb; \
                _Pragma("unroll") for (int i = 0; i < 16; ++i) { sa[i] = -1e30f; sb[i] = -1e30f; } \
                float mx = -3.0e38f; \
                if (acta) { attn_qk32(base, qf, k0 + l32, half, -m_run, sa); \
                    attn_bias32(sa, rpbL + 64 + (kra_ - qr + 7) * 31 + (k0 - qc + 15) + 4 * half, k0 + 4 * half - cs, (kra_ >= rsq) && (kra_ < rsq + 8)); mx = attn_max16(sa); } \
                if (actb) { attn_qk32(base + 2 * AT_TILE, qf, k0 + l32, half, -m_run, sb); \
                    attn_bias32(sb, rpbL + 64 + (krb_ - qr + 7) * 31 + (k0 - qc + 15) + 4 * half, k0 + 4 * half - cs, (krb_ >= rsq) && (krb_ < rsq + 8)); mx = fmaxf(mx, attn_max16(sb)); } \
                AT_SLOWPATH(ip_, sa[i] -= delta; sb[i] -= delta) \
                if (acta) attn_pv32(base + AT_TILE, sa, l32, half, k0, ones, o0, o1, lacc); \
                if (actb) attn_pv32(base + 3 * AT_TILE, sb, l32, half, k0, ones, o0, o1, lacc); \
            } \
        } else { \
            f32x16 sa0, sa1, sb0, sb1; \
            attn_qk(base, qf, l32, half, -m_run, sa0, sa1); \
            attn_qk(base + 2 * AT_TILE, qf, l32, half, -m_run, sb0, sb1); \
            float mx = fmaxf(attn_max(sa0, sa1), attn_max(sb0, sb1)); \
            AT_SLOWPATH(ip_, sa0[i] -= delta; sa1[i] -= delta; sb0[i] -= delta; sb1[i] -= delta) \
            attn_pv(base + AT_TILE, sa0, sa1, l32, half, ones, o0, o1, lacc); \
            attn_pv(base + 3 * AT_TILE, sb0, sb1, l32, half, ones, o0, o1, lacc); \
        } } while (0)
    AT_LOAD(0, eka, eva, ekb, evb);
    AT_STORE(0, 0, eka, eva, ekb, evb);
    __syncthreads();
    for (int ip = 0; ip < np; ++ip) {
        if (ip + 1 < np) AT_LOAD(ip + 1, eka, eva, ekb, evb);
        AT_COMPUTE(ip);
        if (ip + 1 < np) AT_STORE((ip + 1) & 1, ip + 1, eka, eva, ekb, evb);
        __syncthreads();
    }
#undef AT_LOAD
#undef AT_STORE
#undef AT_COMPUTE
#undef AT_SLOWPATH
    const float inv = 1.f / lacc[0];
    {
        LAS float* ot = (LAS float*)lds;
#pragma unroll
        for (int dt = 0; dt < 2; ++dt)
#pragma unroll
            for (int i = 0; i < 16; ++i) ot[qrow * 65 + dt * 32 + crow(i, half)] = (dt == 0 ? o0[i] : o1[i]) * inv;
        __syncthreads();
#pragma unroll
        for (int j = 0; j < 4; ++j) {
            const int idx = tid + 512 * j, row = idx >> 3, pc = idx & 7;
            const u32x4 zz = *(const u32x4*)(Z + (size_t)row * zstride + pc * 8);
            const LAS float* sp = ot + row * 65 + pc * 8;
            u32x4 ov;
            ov.x = cvtpk(sp[0] * __uint_as_float(zz.x << 16), sp[1] * __uint_as_float(zz.x & 0xffff0000u));
            ov.y = cvtpk(sp[2] * __uint_as_float(zz.y << 16), sp[3] * __uint_as_float(zz.y & 0xffff0000u));
            ov.z = cvtpk(sp[4] * __uint_as_float(zz.z << 16), sp[5] * __uint_as_float(zz.z & 0xffff0000u));
            ov.w = cvtpk(sp[6] * __uint_as_float(zz.w << 16), sp[7] * __uint_as_float(zz.w & 0xffff0000u));
            if (usewt) wt16(wt, O + (size_t)row * ostride + pc * 8, ov); else *(u32x4*)(O + (size_t)row * ostride + pc * 8) = ov;
        }
        if (pcnt) asm volatile("s_waitcnt vmcnt(0)" ::: "memory");
        __syncthreads();
        if (pcnt && tid == 0) __hip_atomic_fetch_add(pcnt, 1u, __ATOMIC_RELAXED, __HIP_MEMORY_SCOPE_AGENT);
    }
}

DI int chain_base(int sid, int h, int dir) { return sid < 16 ? ((sid * 4 + h) * 2 + dir) * 2 : 256 + (((sid - 16) * 4 + h) * 2 + dir) * 32; }
DI int seq_rowbase(int sid) { return sid < 16 ? sid * 256 : MP + (sid - 16) * 4096; }
DI float chain_m0(const float* state_m, int sid, int h, int dir) { return sid < 16 ? 0.f : state_m[((sid - 16) * 2 + dir) * 4 + h]; }
DI float chain_m_at(const float* CH, int base, int js, float m0) {
    float m = m0;
    for (int i = 0; i < js; ++i) { const float bL = CH[(base + i) * 2], rmL = CH[(base + i) * 2 + 1]; m = bL + fmaxf(m, rmL); }
    return m;
}

DI void gate_scan_item(int sid, int h, int dir, int js, int lane, const float* G, const float* bg, float* SC, float* CH) {
    const int nc = sid < 16 ? 2 : 32, T = nc * 128, rb = seq_rowbase(sid);
    const float bi = bg[(dir * 2) * 4 + h], bff = bg[(dir * 2 + 1) * 4 + h];
    float ig[2], lf[2]; int row[2];
#pragma unroll
    for (int e = 0; e < 2; ++e) {
        const int Ppos = js * 128 + 2 * lane + e; const int t = dir ? (T - 1 - Ppos) : Ppos; row[e] = rb + t;
        ig[e] = G[(size_t)row[e] * 16 + (dir * 2) * 4 + h] + bi;
        const float fg = G[(size_t)row[e] * 16 + (dir * 2 + 1) * 4 + h] + bff;
        lf[e] = fminf(fg, 0.f) - log1pf(expf(-fabsf(fg)));
    }
    const float tot = lf[0] + lf[1];
    float x = tot;
#pragma unroll
    for (int o = 1; o < 64; o <<= 1) { const float y = __shfl_up(x, o); if (lane >= o) x += y; }
    const float excl = x - tot;
    const float b0 = excl + lf[0], b1 = excl + tot;
    const float a0 = ig[0] - b0, a1 = ig[1] - b1;
    const float lm = fmaxf(a0, a1);
    float xm = lm;
#pragma unroll
    for (int o = 1; o < 64; o <<= 1) { const float y = __shfl_up(xm, o); if (lane >= o) xm = fmaxf(xm, y); }
    float em = __shfl_up(xm, 1); if (lane == 0) em = -3.0e38f;
    const float rm0 = fmaxf(em, a0), rm1 = fmaxf(em, lm);
    *(f32x4*)(SC + ((size_t)row[0] * 8 + h * 2 + dir) * 4) = (f32x4){a0, b0, rm0, 0.f};
    *(f32x4*)(SC + ((size_t)row[1] * 8 + h * 2 + dir) * 4) = (f32x4){a1, b1, rm1, 0.f};
    if (lane == 63) { const int slot = chain_base(sid, h, dir) + js; CH[slot * 2] = b1; CH[slot * 2 + 1] = rm1; }
}

DI void qknorm_item(int row, int lane, const u32x4 (&rawqk)[2], const float* gq, const float* gk, bf16_t* Qb, bf16_t* Kb, float* out) {
    const bool sample = row >= MP;
    const int t = sample ? ((row - MP) & 4095) : 0;
    const int grow = t >> 6, gcol = t & 63;
    const int sub = lane & 7, d0 = sub * 8;
    const float pos = (float)((sub < 4) ? grow : gcol);
#pragma unroll
    for (int pass = 0; pass < 2; ++pass) {
        const u32x4 raw = rawqk[pass];
        float x[8];
        x[0] = __uint_as_float(raw.x << 16); x[1] = __uint_as_float(raw.x & 0xffff0000u);
        x[2] = __uint_as_float(raw.y << 16); x[3] = __uint_as_float(raw.y & 0xffff0000u);
        x[4] = __uint_as_float(raw.z << 16); x[5] = __uint_as_float(raw.z & 0xffff0000u);
        x[6] = __uint_as_float(raw.w << 16); x[7] = __uint_as_float(raw.w & 0xffff0000u);
        float ss = 0.f;
#pragma unroll
        for (int e = 0; e < 8; ++e) ss += x[e] * x[e];
        ss += __shfl_xor(ss, 1); ss += __shfl_xor(ss, 2); ss += __shfl_xor(ss, 4);
        const float r = rsqrtf(ss * (1.f / 64.f) + EPS);
        const float* gw = pass == 0 ? gq : gk;
        float y[8];
#pragma unroll
        for (int e = 0; e < 8; ++e) y[e] = x[e] * r * gw[d0 + e];
        if (pass == 1 && !sample && lane < 16) {
            const int hk = lane >> 3, b = row >> 8, tt = row & 255;
            float* o = out + O_GK + ((size_t)((b * 2 + hk) * 256 + tt)) * 64 + d0;
            *(f32x4*)o = (f32x4){y[0], y[1], y[2], y[3]}; *(f32x4*)(o + 4) = (f32x4){y[4], y[5], y[6], y[7]};
        }
        float z[8];
#pragma unroll
        for (int e = 0; e < 8; ++e) {
            const float partner = __shfl_xor(y[e], 2);
            if (sample) {
                const int i = (d0 + e) & 15;
                const float freq = __builtin_amdgcn_exp2f(-(float)i * (13.287712379549449f / 16.f));
                float rev = pos * freq * 0.15915494309189535f; rev -= floorf(rev);
                const float sn = __builtin_amdgcn_sinf(rev), cn = __builtin_amdgcn_cosf(rev);
                z[e] = (sub & 2) ? (partner * sn + y[e] * cn) : (y[e] * cn - partner * sn);
            } else z[e] = y[e];
        }
        if (pass == 0) {
#pragma unroll
            for (int e = 0; e < 8; ++e) z[e] *= QSCALE;
            u32x4 w; w.x = cvtpk(z[0], z[1]); w.y = cvtpk(z[2], z[3]); w.z = cvtpk(z[4], z[5]); w.w = cvtpk(z[6], z[7]);
            *(u32x4*)(Qb + (size_t)row * 512 + lane * 8) = w;
        } else if (lane < 16) {
            u32x4 w; w.x = cvtpk(z[0], z[1]); w.y = cvtpk(z[2], z[3]); w.z = cvtpk(z[4], z[5]); w.w = cvtpk(z[6], z[7]);
            *(u32x4*)(Kb + (size_t)row * 128 + lane * 8) = w;
        }
    }
}

DI void mlstm_u_item(LAS unsigned char* lds, int tid, int sid, int h, int dir, int js,
                     const float* SC, const float* CH, const float* state_m, const bf16_t* KT, const bf16_t* VT, bf16_t* U, float* Un, const WT& wtw, unsigned* ucnt) {
    const int lane = tid & 63, w = tid >> 6, l32 = lane & 31, half = lane >> 5;
    const int nc = sid < 16 ? 2 : 32, rb = seq_rowbase(sid);
    const int jt = dir ? nc - 1 - js : js, R0 = rb + jt * 128;
    const int base = chain_base(sid, h, dir), slot = base + js;
    const float Mx = CH[slot * 2 + 1];
    LAS float* wkL = (LAS float*)lds;
    if (tid < 128) wkL[tid] = expf(SC[((size_t)(R0 + tid) * 8 + h * 2 + dir) * 4] - Mx);
    const int vi = w & 3, kh = w >> 2;
    f32x16 acc0, acc1;
#pragma unroll
    for (int i = 0; i < 16; ++i) { acc0[i] = 0.f; acc1[i] = 0.f; }
    LAS unsigned char* VtL = lds + 1024; LAS unsigned char* KtL = lds + 1024 + 34816;
    {
        u32x4 rv[8];
        const int r0 = tid >> 4, pc = tid & 15;
        const bf16_t* gv = VT + (size_t)(h * 128 + r0) * MROWS + R0 + pc * 8;
        const bf16_t* gk = KT + (size_t)(h * 128 + r0) * MROWS + R0 + pc * 8;
#pragma unroll
        for (int i = 0; i < 8; ++i) rv[i] = *(const u32x4*)((i >> 2 ? gk : gv) + (size_t)(32 * (i & 3)) * MROWS);
        LAS unsigned char* lv = VtL + r0 * 272 + pc * 16;
#pragma unroll
        for (int i = 0; i < 8; ++i) *(LAS u32x4*)(lv + (i >> 2) * 34816 + (32 * (i & 3)) * 272) = rv[i];
    }
    __syncthreads();
#pragma unroll
    for (int s = 0; s < 8; ++s) {
        const int so = 16 * s + 8 * half;
        const u32x4 raw = *(const LAS u32x4*)(VtL + (vi * 32 + l32) * 272 + so * 2);
        const bf16x8 B0 = *(const LAS bf16x8*)(KtL + (kh * 64 + l32) * 272 + so * 2);
        const bf16x8 B1 = *(const LAS bf16x8*)(KtL + (kh * 64 + 32 + l32) * 272 + so * 2);
        const f32x4 wa = *(const LAS f32x4*)(wkL + so), wb = *(const LAS f32x4*)(wkL + so + 4);
        const bf16x8 A = pack8(__uint_as_float(raw.x << 16) * wa[0], __uint_as_float(raw.x & 0xffff0000u) * wa[1], __uint_as_float(raw.y << 16) * wa[2], __uint_as_float(raw.y & 0xffff0000u) * wa[3],
                               __uint_as_float(raw.z << 16) * wb[0], __uint_as_float(raw.z & 0xffff0000u) * wb[1], __uint_as_float(raw.w << 16) * wb[2], __uint_as_float(raw.w & 0xffff0000u) * wb[3]);
        acc0 = MFMA32(A, B0, acc0); acc1 = MFMA32(A, B1, acc1);
    }
    bf16_t* Uo = U + (size_t)slot * 16384;
    {
        LAS unsigned char* st = lds + 1024 + 2 * 34816 + w * 4608;
#pragma unroll
        for (int i = 0; i < 16; ++i) {
            const int v = crow(i, half);
            *(LAS bf16_t*)(st + v * 144 + l32 * 2) = f2bf(acc0[i]);
            *(LAS bf16_t*)(st + v * 144 + (32 + l32) * 2) = f2bf(acc1[i]);
        }
        asm volatile("s_waitcnt lgkmcnt(0)" ::: "memory");
#pragma unroll
        for (int j = 0; j < 4; ++j) {
            const int pidx = lane + 64 * j, row = pidx >> 3, pc = pidx & 7;
            const u32x4 val = *(const LAS u32x4*)(st + row * 144 + pc * 16);
            wt16(wtw, Uo + (vi * 32 + row) * 128 + kh * 64 + pc * 8, val);
        }
    }
    if (tid < 128) {
        float s = 0.f;
#pragma unroll
        for (int j = 0; j < 16; ++j) {
            const u32x4 raw = *(const LAS u32x4*)(KtL + tid * 272 + j * 16);
            s += __uint_as_float(raw.x << 16) * wkL[8 * j] + __uint_as_float(raw.x & 0xffff0000u) * wkL[8 * j + 1]
               + __uint_as_float(raw.y << 16) * wkL[8 * j + 2] + __uint_as_float(raw.y & 0xffff0000u) * wkL[8 * j + 3]
               + __uint_as_float(raw.z << 16) * wkL[8 * j + 4] + __uint_as_float(raw.z & 0xffff0000u) * wkL[8 * j + 5]
               + __uint_as_float(raw.w << 16) * wkL[8 * j + 6] + __uint_as_float(raw.w & 0xffff0000u) * wkL[8 * j + 7];
        }
        __hip_atomic_store(Un + slot * 128 + tid, s, __ATOMIC_RELAXED, __HIP_MEMORY_SCOPE_AGENT);
    }
    asm volatile("s_waitcnt vmcnt(0)" ::: "memory");
    __syncthreads();
    if (tid == 0 && ucnt) __hip_atomic_fetch_add(ucnt + 16 * (sid < 16 ? (sid * 4 + h) * 2 + dir : 128 + ((sid - 16) * 4 + h) * 2 + dir), 1u, __ATOMIC_RELAXED, __HIP_MEMORY_SCOPE_AGENT);
}

constexpr int ML_PITCH = 272, ML_ARR = 128 * ML_PITCH;
constexpr int ML_SCAL = 4 * ML_ARR;
DI void mlstm_out_item(LAS unsigned char* lds, int tid, int sid, int h, int jt,
                       const float* SC, const float* MJp, const float* nst, const bf16_t* Cst,
                       const bf16_t* P, const bf16_t* VT, const float* ghn, bf16_t* Yg, const WT& wtd, bool usewt, unsigned* pcnt) {
    const int lane = tid & 63, w = tid >> 6, l32 = lane & 31, half = lane >> 5;
    const int wt = w & 3, vh = w >> 2;
    const int nc = sid < 16 ? 2 : 32, rb = seq_rowbase(sid), R0 = rb + jt * 128;
    LAS unsigned char* KL = lds; LAS unsigned char* VL = lds + ML_ARR; LAS unsigned char* CL = lds + 2 * ML_ARR;
    LAS float* aL = (LAS float*)(lds + ML_SCAL);
    LAS float* nL = aL + 256;
    LAS float* ssqL = nL + 256;
    const int tl = wt * 32 + l32;
    const int qrow = R0 + tl;
    const int slot0 = chain_base(sid, h, 0) + jt, slot1 = chain_base(sid, h, 1) + (nc - 1 - jt);
    bf16x8 qf[8];
#pragma unroll
    for (int s = 0; s < 8; ++s) qf[s] = *(const bf16x8*)(P + (size_t)qrow * NP + C_QA + h * 128 + 16 * s + 8 * half);
    {
        u32x4 rk[4], rv[4], rc0[4], rc1[4];
#pragma unroll
        for (int i = 0; i < 4; ++i) {
            const int idx = tid + 512 * i, row = idx >> 4, pc = idx & 15;
            rk[i] = *(const u32x4*)(P + (size_t)(R0 + row) * NP + C_KA + h * 128 + pc * 8);
            rv[i] = *(const u32x4*)(VT + (size_t)(h * 128 + row) * MROWS + R0 + pc * 8);
            rc0[i] = *(const u32x4*)(Cst + (size_t)slot0 * 16384 + row * 128 + pc * 8);
            rc1[i] = *(const u32x4*)(Cst + (size_t)slot1 * 16384 + row * 128 + pc * 8);
        }
        float av = 0.f, nv = 0.f;
        if (tid < 256) {
            const int dir = tid >> 7, s2 = tid & 127;
            av = SC[((size_t)(R0 + s2) * 8 + h * 2 + dir) * 4];
            nv = nst[(size_t)(dir ? slot1 : slot0) * 128 + s2];
        }
#pragma unroll
        for (int i = 0; i < 4; ++i) {
            const int idx = tid + 512 * i, row = idx >> 4, pc = idx & 15;
            *(LAS u32x4*)(KL + row * ML_PITCH + pc * 16) = rk[i];
            *(LAS u32x4*)(CL + row * ML_PITCH + pc * 16) = rc0[i];
            *(LAS u32x4*)(CL + ML_ARR + row * ML_PITCH + pc * 16) = rc1[i];
            const int grp = pc >> 1, b3 = pc & 1;
            u32x2 lo = {rv[i].x, rv[i].y}, hi = {rv[i].z, rv[i].w};
            *(LAS u32x2*)(VL + row * ML_PITCH + (16 * grp + 4 * b3) * 2) = lo;
            *(LAS u32x2*)(VL + row * ML_PITCH + (16 * grp + 8 + 4 * b3) * 2) = hi;
        }
        if (tid < 256) { aL[tid] = av; nL[tid] = nv; }
    }
    __syncthreads();
    f32x16 hs0, hs1;
#pragma unroll
    for (int i = 0; i < 16; ++i) { hs0[i] = 0.f; hs1[i] = 0.f; }
#pragma unroll 1
    for (int dir = 0; dir < 2; ++dir) {
        const int js = dir ? nc - 1 - jt : jt;
        const float m = MJp[chain_base(sid, h, dir) + js];
        const f32x4 sc = *(const f32x4*)(SC + ((size_t)qrow * 8 + h * 2 + dir) * 4);
        const float mx = fmaxf(m, sc[2]);
        const float u_t = -mx, w_inter = expf(m - mx), flo = expf(-(sc[1] + mx));
        f32x16 a0, a1;
#pragma unroll
        for (int i = 0; i < 16; ++i) { a0[i] = 0.f; a1[i] = 0.f; }
        const LAS unsigned char* Cp = CL + dir * ML_ARR + (vh * 64 + l32) * ML_PITCH + 16 * half;
#pragma unroll
        for (int s = 0; s < 8; ++s) {
            const bf16x8 A0 = *(const LAS bf16x8*)(Cp + 32 * s);
            const bf16x8 A1 = *(const LAS bf16x8*)(Cp + 32 * ML_PITCH + 32 * s);
            a0 = MFMA32(A0, qf[s], a0); a1 = MFMA32(A1, qf[s], a1);
        }
#pragma unroll
        for (int i = 0; i < 16; ++i) { a0[i] *= w_inter; a1[i] *= w_inter; }
        float dq = 0.f;
#pragma unroll
        for (int s = 0; s < 8; ++s)
#pragma unroll
            for (int e = 0; e < 8; ++e) dq += bf2f((unsigned short)qf[s][e]) * nL[dir * 128 + 16 * s + 8 * half + e];
        dq += __shfl_xor(dq, 32);
        float rsum = 0.f;
        const int st_lo = dir ? wt : 0, st_hi = dir ? 3 : wt;
        for (int st = st_lo; st <= st_hi; ++st) {
            f32x16 S;
#pragma unroll
            for (int i = 0; i < 16; ++i) S[i] = 0.f;
            const LAS unsigned char* Kp = KL + (st * 32 + l32) * ML_PITCH + 16 * half;
#pragma unroll
            for (int s = 0; s < 8; ++s) { const bf16x8 A = *(const LAS bf16x8*)(Kp + 32 * s); S = MFMA32(A, qf[s], S); }
#pragma unroll
            for (int i = 0; i < 16; ++i) {
                const int sl = st * 32 + crow(i, half);
                const bool valid = dir ? (sl >= tl) : (sl <= tl);
                const float dcy = __expf(u_t + aL[dir * 128 + sl]);
                const float p = valid ? S[i] * dcy : 0.f;
                S[i] = p; rsum += p;
            }
            const bf16x8 pf0 = pack8(S[0], S[1], S[2], S[3], S[4], S[5], S[6], S[7]);
            const bf16x8 pf1 = pack8(S[8], S[9], S[10], S[11], S[12], S[13], S[14], S[15]);
            const LAS unsigned char* Vp = VL + (vh * 64 + l32) * ML_PITCH + (st * 32 + 8 * half) * 2;
            {
                const bf16x8 A0 = *(const LAS bf16x8*)(Vp), A1 = *(const LAS bf16x8*)(Vp + 32 * ML_PITCH);
                a0 = MFMA32(A0, pf0, a0); a1 = MFMA32(A1, pf0, a1);
                const bf16x8 B0 = *(const LAS bf16x8*)(Vp + 32), B1 = *(const LAS bf16x8*)(Vp + 32 * ML_PITCH + 32);
                a0 = MFMA32(B0, pf1, a0); a1 = MFMA32(B1, pf1, a1);
            }
        }
        rsum += __shfl_xor(rsum, 32);
        const float den = w_inter * dq + rsum;
        const float inv = 1.f / fmaxf(fabsf(den), flo);
#pragma unroll
        for (int i = 0; i < 16; ++i) { hs0[i] += a0[i] * inv; hs1[i] += a1[i] * inv; }
    }
    float ssq = 0.f;
#pragma unroll
    for (int i = 0; i < 16; ++i) ssq += hs0[i] * hs0[i] + hs1[i] * hs1[i];
    ssq += __shfl_xor(ssq, 32);
    if (half == 0) ssqL[w * 32 + l32] = ssq;
    __syncthreads();
    const float tot = ssq + ssqL[(w ^ 4) * 32 + l32];
    const float rn = rsqrtf(tot * (1.f / 128.f) + EPS);
    {
        LAS float* ht = (LAS float*)lds;
#pragma unroll
        for (int vt = 0; vt < 2; ++vt)
#pragma unroll
            for (int i = 0; i < 16; ++i) ht[tl * 129 + vh * 64 + vt * 32 + crow(i, half)] = (vt == 0 ? hs0[i] : hs1[i]) * rn;
        __syncthreads();
#pragma unroll
        for (int j = 0; j < 4; ++j) {
            const int idx = tid + 512 * j, row = idx >> 4, pc = idx & 15, col = h * 128 + pc * 8;
            const bf16_t* prow = P + (size_t)(R0 + row) * NP;
            const u32x4 oa = *(const u32x4*)(prow + C_OA + col), zz = *(const u32x4*)(prow + C_Z + col);
            const f32x4 g0 = *(const f32x4*)(ghn + col), g1 = *(const f32x4*)(ghn + col + 4);
            const LAS float* sp = ht + row * 129 + pc * 8;
            u32x4 ov;
            ov.x = cvtpk(sp[0] * g0[0] * sigmf(__uint_as_float(oa.x << 16)) * __uint_as_float(zz.x << 16), sp[1] * g0[1] * sigmf(__uint_as_float(oa.x & 0xffff0000u)) * __uint_as_float(zz.x & 0xffff0000u));
            ov.y = cvtpk(sp[2] * g0[2] * sigmf(__uint_as_float(oa.y << 16)) * __uint_as_float(zz.y << 16), sp[3] * g0[3] * sigmf(__uint_as_float(oa.y & 0xffff0000u)) * __uint_as_float(zz.y & 0xffff0000u));
            ov.z = cvtpk(sp[4] * g1[0] * sigmf(__uint_as_float(oa.z << 16)) * __uint_as_float(zz.z << 16), sp[5] * g1[1] * sigmf(__uint_as_float(oa.z & 0xffff0000u)) * __uint_as_float(zz.z & 0xffff0000u));
            ov.w = cvtpk(sp[6] * g1[2] * sigmf(__uint_as_float(oa.w << 16)) * __uint_as_float(zz.w << 16), sp[7] * g1[3] * sigmf(__uint_as_float(oa.w & 0xffff0000u)) * __uint_as_float(zz.w & 0xffff0000u));
            if (usewt) wt16(wtd, Yg + (size_t)(R0 + row) * DM + col, ov); else *(u32x4*)(Yg + (size_t)(R0 + row) * DM + col) = ov;
        }
    }
    if (pcnt) asm volatile("s_waitcnt vmcnt(0)" ::: "memory");
    __syncthreads();
    if (pcnt && tid == 0) __hip_atomic_fetch_add(pcnt + 16 * (R0 >> 8), 1u, __ATOMIC_RELAXED, __HIP_MEMORY_SCOPE_AGENT);
}

DI void transpose_item(const float* W, int K, int N, bf16_t* WT, LAS float* scr, int item, int lane) {
    const int nblk = (N + 31) / 32, kb = item / nblk, nb = item % nblk, k0 = 64 * kb, n0 = 32 * nb;
    const int nn = n0 + (lane & 31);
    float tv[32];
#pragma unroll
    for (int i = 0; i < 32; ++i) { const int kk = 2 * i + (lane >> 5); tv[i] = (nn < N) ? W[(size_t)(k0 + kk) * N + nn] : 0.f; }
#pragma unroll
    for (int i = 0; i < 32; ++i) { const int kk = 2 * i + (lane >> 5); scr[kk * 33 + (lane & 31)] = tv[i]; }
    asm volatile("s_waitcnt lgkmcnt(0)" ::: "memory");
    const int c = lane & 7;
#pragma unroll
    for (int j = 0; j < 4; ++j) { const int n = (lane >> 3) + 8 * j; const LAS float* s = scr + (8 * c) * 33 + n;
        u32x4 o; o.x = cvtpk(s[0 * 33], s[1 * 33]); o.y = cvtpk(s[2 * 33], s[3 * 33]); o.z = cvtpk(s[4 * 33], s[5 * 33]); o.w = cvtpk(s[6 * 33], s[7 * 33]);
        *(u32x4*)(WT + (size_t)(n0 + n) * K + k0 + 8 * c) = o; }
    asm volatile("s_waitcnt lgkmcnt(0)" ::: "memory");
}

template <int NR>
DI void prenorm_rows(const float* const (&xrow)[NR], const float* gpre, const float* const (&md)[NR], bf16_t* const (&orow)[NR], int lane) {
    f32x4 v[NR][4];
#pragma unroll
    for (int r = 0; r < NR; ++r)
#pragma unroll
        for (int j = 0; j < 4; ++j) v[r][j] = *(const f32x4*)(xrow[r] + 4 * lane + 256 * j);
#pragma unroll
    for (int r = 0; r < NR; ++r) {
        float s = 0.f;
#pragma unroll
        for (int j = 0; j < 4; ++j) s += (v[r][j].x * v[r][j].x + v[r][j].y * v[r][j].y) + (v[r][j].z * v[r][j].z + v[r][j].w * v[r][j].w);
        const float rr = rsqrtf(wave_sum(s) * (1.f / DM) + EPS);
#pragma unroll
        for (int j = 0; j < 4; ++j) {
            const int c = 4 * lane + 256 * j;
            const f32x4 g = *(const f32x4*)(gpre + c), a = *(const f32x4*)(md[r] + 1024 + c), b = *(const f32x4*)(md[r] + c);
            f32x4 o;
#pragma unroll
            for (int e = 0; e < 4; ++e) o[e] = v[r][j][e] * rr * g[e] * (1.f + a[e]) + b[e];
            u32x2 w; w.x = cvtpk(o[0], o[1]); w.y = cvtpk(o[2], o[3]);
            *(u32x2*)(orow[r] + c) = w;
        }
    }
}
template <bool NEXT, int NR, bool XBF, bool X1BF>
DI void postnorm_rows(const float* const (&xrow)[NR], const bf16_t* const (&yrow)[NR], const float* gpost, const float* const (&md0)[NR], float* const (&x1row)[NR],
                      const float* gpre, const float* const (&md1)[NR], bf16_t* const (&hrow)[NR], int lane) {
    f32x4 y[NR][4], x[NR][4];
#pragma unroll
    for (int r = 0; r < NR; ++r)
#pragma unroll
        for (int j = 0; j < 4; ++j) {
            const u32x2 raw = *(const u32x2*)(yrow[r] + 4 * lane + 256 * j);
            y[r][j] = (f32x4){__uint_as_float(raw.x << 16), __uint_as_float(raw.x & 0xffff0000u), __uint_as_float(raw.y << 16), __uint_as_float(raw.y & 0xffff0000u)};
            if (XBF) {
                const u32x2 rx = *(const u32x2*)((const bf16_t*)xrow[r] + 4 * lane + 256 * j);
                x[r][j] = (f32x4){__uint_as_float(rx.x << 16), __uint_as_float(rx.x & 0xffff0000u), __uint_as_float(rx.y << 16), __uint_as_float(rx.y & 0xffff0000u)};
            } else x[r][j] = *(const f32x4*)(xrow[r] + 4 * lane + 256 * j);
        }
#pragma unroll
    for (int r = 0; r < NR; ++r) {
        float s = 0.f;
#pragma unroll
        for (int j = 0; j < 4; ++j) s += (y[r][j].x * y[r][j].x + y[r][j].y * y[r][j].y) + (y[r][j].z * y[r][j].z + y[r][j].w * y[r][j].w);
        const float rr = rsqrtf(wave_sum(s) * (1.f / DM) + EPS);
        float s1 = 0.f;
#pragma unroll
        for (int j = 0; j < 4; ++j) {
            const int c = 4 * lane + 256 * j;
            const f32x4 g = *(const f32x4*)(gpost + c), gt = *(const f32x4*)(md0[r] + 2048 + c);
#pragma unroll
            for (int e = 0; e < 4; ++e) x[r][j][e] = x[r][j][e] + gt[e] * (y[r][j][e] * rr * g[e]);
            if (X1BF) { u32x2 wx; wx.x = cvtpk(x[r][j][0], x[r][j][1]); wx.y = cvtpk(x[r][j][2], x[r][j][3]); *(u32x2*)((bf16_t*)x1row[r] + c) = wx; }
            else *(f32x4*)(x1row[r] + c) = x[r][j];
            s1 += (x[r][j].x * x[r][j].x + x[r][j].y * x[r][j].y) + (x[r][j].z * x[r][j].z + x[r][j].w * x[r][j].w);
        }
        if (NEXT) {
            const float r1 = rsqrtf(wave_sum(s1) * (1.f / DM) + EPS);
#pragma unroll
            for (int j = 0; j < 4; ++j) {
                const int c = 4 * lane + 256 * j;
                const f32x4 g = *(const f32x4*)(gpre + c), a = *(const f32x4*)(md1[r] + 1024 + c), b = *(const f32x4*)(md1[r] + c);
                f32x4 o;
#pragma unroll
                for (int e = 0; e < 4; ++e) o[e] = x[r][j][e] * r1 * g[e] * (1.f + a[e]) + b[e];
                u32x2 w; w.x = cvtpk(o[0], o[1]); w.y = cvtpk(o[2], o[3]);
                *(u32x2*)(hrow[r] + c) = w;
            }
        }
    }
}

#define XB_TMO      128
#define XB_XCNT(j)  (256  + 64 * (j))
#define XB_XSUB(j)  (1280 + 64 * (j))
#define XB_XGEN(j)  (2304 + 64 * (j))
#define XB_TOP      3328
#define XB_TOPGEN   3392
#define XCD_BAR_WORDS 3456
#define XB_SPIN_CAP (1u << 18)
DI unsigned xb_ld(unsigned* p)              { return __hip_atomic_load(p, __ATOMIC_RELAXED, __HIP_MEMORY_SCOPE_AGENT); }
DI unsigned xb_add(unsigned* p, unsigned v) { return __hip_atomic_fetch_add(p, v, __ATOMIC_RELAXED, __HIP_MEMORY_SCOPE_AGENT); }
DI unsigned xb_xcc_id() { return (unsigned)__builtin_amdgcn_s_getreg((3 << 11) | 20) & 0xFu; }
#define XB_SPIN(cond, bar) do { unsigned _sp = 0; while (cond) { __builtin_amdgcn_s_sleep(1); \
    if ((++_sp & 255u) == 0u) { if (xb_ld(&(bar)[XB_TMO])) break; if (_sp > XB_SPIN_CAP) { atomicAdd(&(bar)[XB_TMO], 1u); break; } } } } while (0)
struct XcdBarrier { unsigned* bar; unsigned x; volatile LAS unsigned* st; };
DI XcdBarrier xcd_barrier_post(unsigned* bar, volatile LAS unsigned* st) {
    XcdBarrier b; b.bar = bar; b.x = xb_xcc_id(); b.st = st;
    if (threadIdx.x == 0) (void)xb_add(&bar[XB_XCNT(b.x)], 1u);
    return b;
}
DI void xcd_barrier_complete(unsigned* bar, unsigned x, unsigned& nloc, unsigned& nx) {
    const unsigned G = gridDim.x * gridDim.y * gridDim.z;
    unsigned sum, cnt, mine, sp = 0u;
    for (;;) {
        sum = 0u; cnt = 0u; mine = 0u;
#pragma unroll
        for (unsigned j = 0; j < 16; ++j) { const unsigned c = xb_ld(&bar[XB_XCNT(j)]); sum += c; cnt += (c > 0u) ? 1u : 0u; mine = (j == x) ? c : mine; }
        if (sum == G) break;
        __builtin_amdgcn_s_sleep(1);
        if ((++sp & 255u) == 0u) { if (xb_ld(&bar[XB_TMO])) break; if (sp > XB_SPIN_CAP) { atomicAdd(&bar[XB_TMO], 1u); break; } }
    }
    nloc = mine > 0u ? mine : 1u; nx = cnt > 0u ? cnt : 1u;
}
DI void xcd_barrier(const XcdBarrier& b) {
    asm volatile("s_waitcnt vmcnt(0)" ::: "memory");
    __syncthreads();
    if (threadIdx.x == 0) {
        unsigned* bar = b.bar;
        __builtin_amdgcn_s_waitcnt(0);
        unsigned nloc = b.st[0], nx = b.st[1];
        if (nloc == 0u) { xcd_barrier_complete(bar, b.x, nloc, nx); b.st[0] = nloc; b.st[1] = nx; }
        const unsigned old = xb_add(&bar[XB_XSUB(b.x)], 1u);
        const unsigned gen = old / nloc;
        if (old + 1u == (gen + 1u) * nloc) {
            __builtin_amdgcn_fence(__ATOMIC_RELEASE, "agent");
            asm volatile("s_waitcnt vmcnt(0)" ::: "memory");
            const unsigned og = xb_add(&bar[XB_TOP], 1u);
            const unsigned tg = og / nx;
            if (og + 1u == (tg + 1u) * nx) xb_add(&bar[XB_TOPGEN], 1u);
            else XB_SPIN(xb_ld(&bar[XB_TOPGEN]) == tg, bar);
            __builtin_amdgcn_fence(__ATOMIC_ACQUIRE, "agent");
            xb_add(&bar[XB_XGEN(b.x)], 1u);
            asm volatile("s_waitcnt vmcnt(0)" ::: "memory");
        } else {
            XB_SPIN(xb_ld(&bar[XB_XGEN(b.x)]) == gen, bar);
            __builtin_amdgcn_fence(__ATOMIC_ACQUIRE, "agent");
            asm volatile("s_waitcnt vmcnt(0)" ::: "memory");
        }
    }
    __syncthreads();
}

__global__ void __launch_bounds__(512, 2) fwd_megakernel(Params p) {
    extern __shared__ __attribute__((aligned(16))) unsigned char lds_raw[];
    LAS unsigned char* lds = (LAS unsigned char*)lds_raw;
    cg::grid_group grid = cg::this_grid();
    const int tid = threadIdx.x;
    const int G = gridDim.x, blk = blockIdx.x;
#define lane ((int)(threadIdx.x & 63u))
#define wave (__builtin_amdgcn_readfirstlane((int)(threadIdx.x >> 6)))
#define gw (blk * 8 + wave)
    const int NGW = G * 8;
    unsigned char* ws = p.ws;
    float* out = p.out;
    const float* x_prompt = p.in[0]; const float* x_sample = p.in[1];
    const float* st_C = p.in[2]; const float* st_n = p.in[3]; const float* st_m = p.in[4];
    const float* gpre = p.in[13]; const float* gpost = p.in[14];
    float* MOD = (float*)(ws + WS_MOD); float* Gt = (float*)(ws + WS_G); float* SC = (float*)(ws + WS_SC); float* CH = (float*)(ws + WS_CH);
    float* UN = (float*)(ws + WS_UN); float* NST = (float*)(ws + WS_NST); float* MJ = (float*)(ws + WS_MJ);
    bf16_t* CK = (bf16_t*)(ws + WS_CK); bf16_t* CVT = (bf16_t*)(ws + WS_CVT); bf16_t* NK = (bf16_t*)(ws + WS_NK); bf16_t* NVT = (bf16_t*)(ws + WS_NVT);
    bf16_t* WINE = (bf16_t*)(ws + WS_WINE); bf16_t* WOUTE = (bf16_t*)(ws + WS_WOUTE); bf16_t* WINO = (bf16_t*)(ws + WS_WINO); bf16_t* WOUTO = (bf16_t*)(ws + WS_WOUTO);
    bf16_t* H = (bf16_t*)(ws + WS_H); bf16_t* KT = (bf16_t*)(ws + WS_KT); bf16_t* VT = (bf16_t*)(ws + WS_VT); bf16_t* Y2 = (bf16_t*)(ws + WS_Y2);
    bf16_t* P = (bf16_t*)(ws + WS_P); bf16_t* CST = (bf16_t*)(ws + WS_CST); bf16_t* QB = (bf16_t*)(ws + WS_QB); bf16_t* KB = (bf16_t*)(ws + WS_KB);
    bf16_t* VBT = (bf16_t*)(ws + WS_VBT); bf16_t* U = (bf16_t*)(ws + WS_U); bf16_t* VCT = (bf16_t*)(ws + WS_VCT);
    bf16_t* X1P = (bf16_t*)(ws + WS_X1P); bf16_t* X1S = (bf16_t*)(ws + WS_X1S);
#define X1ROW(r) ((r) < MP ? X1P + (size_t)(r) * DM : X1S + (size_t)((r) - MP) * DM)
    const int lo = p.ph_lo, hi = p.ph_hi;
    volatile LAS unsigned* bst = (volatile LAS unsigned*)(lds + LDS_BYTES - 64);
    if (tid == 0) { bst[0] = 0u; bst[1] = 0u; }
    __syncthreads();
    XcdBarrier xbar = xcd_barrier_post((unsigned*)(ws + WS_BAR), bst);
    if (p.coop == 2) grid.sync();
#define IN(k) (lo <= (k) && (k) < hi)
#define SEAM(k) do { if (p.coop && IN(k) && IN((k) + 1)) { for (int sr_ = 0; sr_ < SYNC_REP; ++sr_) xcd_barrier(xbar); } } while (0)
#define REPEAT(k) _Pragma("unroll 1") for (int rep_ = 0; rep_ < 1 + ((REP_MASK >> (k)) & 1); ++rep_)

    if (IN(0)) REPEAT(0) {
        for (int mb = blk; mb < 192; mb += G) {
            const int l = mb / 96, j0 = (mb % 96) * 32;
            LAS float* sL = (LAS float*)lds;
            LAS float* red = sL + 3072;
            for (int i = tid; i < 3072; i += 512) { const int v = i >> 10, k = i & 1023; const float cv = (v == 0) ? p.in[10][k] : p.in[9][(v - 1) * 1024 + k]; sL[i] = siluf(cv); }
            __syncthreads();
            const int col = tid & 31, kg = tid >> 5;
            float a0 = 0.f, a1 = 0.f, a2 = 0.f;
            const float* wp = p.in[11] + ((size_t)l * 1024 + kg * 64) * 3072 + j0 + col;
#pragma unroll
            for (int i0 = 0; i0 < 64; i0 += 32) {
                float wv[32];
#pragma unroll
                for (int i = 0; i < 32; ++i) wv[i] = wp[(size_t)(i0 + i) * 3072];
#pragma unroll
                for (int i = 0; i < 32; ++i) { const int k = kg * 64 + i0 + i; a0 += sL[k] * wv[i]; a1 += sL[1024 + k] * wv[i]; a2 += sL[2048 + k] * wv[i]; }
            }
            red[(0 * 16 + kg) * 32 + col] = a0; red[(1 * 16 + kg) * 32 + col] = a1; red[(2 * 16 + kg) * 32 + col] = a2;
            __syncthreads();
            if (tid < 96) { const int v = tid >> 5, c = tid & 31; float s = p.in[12][l * 3072 + j0 + c];
                for (int k2 = 0; k2 < 16; ++k2) s += red[(v * 16 + k2) * 32 + c];
                __hip_atomic_store(MOD + (l * 3 + v) * 3072 + j0 + c, s, __ATOMIC_RELAXED, __HIP_MEMORY_SCOPE_AGENT); }
            asm volatile("s_waitcnt vmcnt(0)" ::: "memory");
            __syncthreads();
            if (tid == 0) __hip_atomic_fetch_add((unsigned*)(ws + 16384) + 16 * 160, 1u, __ATOMIC_RELAXED, __HIP_MEMORY_SCOPE_AGENT);
        }
        {
            LAS float* scr = (LAS float*)(lds + wave * 16384);
            const int I_E = 16 * 121, I_O = 16 * 32;
            for (int it = gw; it < I_E + I_O; it += NGW) {
                if (it < I_E) transpose_item(p.in[15], 1024, 3856, WINE, scr, it, lane);
                else transpose_item(p.in[20], 1024, 1024, WOUTE, scr, it - I_E, lane);
            }
        }
        {
            const int gt = blk * 512 + tid, NT = G * 512;
            for (int i = gt; i < 65536; i += NT) {
                CK[i] = f2bf(p.in[5][i]);
                const int d = i & 63, s = (i >> 6) & 255, bh = i >> 14;
                CVT[(bh * 64 + d) * 256 + s] = f2bf(p.in[6][i]);
            }
        }
        __syncthreads();
        if (tid == 0) {
            unsigned* c = (unsigned*)(ws + 16384) + 16 * 160; unsigned spins = 0;
            while (__hip_atomic_load(c, __ATOMIC_RELAXED, __HIP_MEMORY_SCOPE_AGENT) < 192u) { __builtin_amdgcn_s_sleep(1); if (++spins > (1u << 22)) break; }
            __builtin_amdgcn_fence(__ATOMIC_ACQUIRE, "agent");
            asm volatile("s_waitcnt vmcnt(0)" ::: "memory");
        }
        __syncthreads();
    }
    if (IN(1)) REPEAT(1) {
        for (int row0 = gw; row0 < MROWS; row0 += 2 * NGW) {
            const float* xr[2]; const float* md[2]; bf16_t* orow[2];
#pragma unroll
            for (int r = 0; r < 2; ++r) {
                const int row = min(row0 + r * NGW, MROWS - 1);
                const int v = row < MP ? 0 : 1 + ((row - MP) >> 12);
                xr[r] = row < MP ? x_prompt + (size_t)row * DM : x_sample + (size_t)(row - MP) * DM;
                md[r] = MOD + (0 * 3 + v) * 3072; orow[r] = H + (size_t)row * DM;
            }
            prenorm_rows<2>(xr, gpre, md, orow, lane);
        }
    }
    SEAM(1);
    if (IN(2)) REPEAT(2) {
        pg8::Gemm g{H, WINE, MROWS, 4096, 1024}; pg8::StaticOrder S; S.init(MROWS, 4096, G, blk);
        EpiEvenIn E{P, KT, VT, VBT, Gt, out};
        pg8::gemm_phase(lds, g, S, E);
    }
    SEAM(2);
    if (IN(3)) REPEAT(3) {
        for (int it = gw; it < 768; it += NGW) {
            int sid, h, dir, js;
            if (it < 256) { js = it & 1; dir = (it >> 1) & 1; h = (it >> 2) & 3; sid = it >> 4; }
            else { const int r = it - 256; js = r & 31; dir = (r >> 5) & 1; h = (r >> 6) & 3; sid = 16 + (r >> 8); }
            gate_scan_item(sid, h, dir, js, lane, Gt, p.in[16], SC, CH);
        }
        for (int row0 = gw; row0 < MROWS; row0 += 2 * NGW) {
            const int row1 = row0 + NGW; const bool two = row1 < MROWS;
            u32x4 ra[2], rb[2];
            ra[0] = *(const u32x4*)(P + (size_t)row0 * NP + C_QB + lane * 8); ra[1] = *(const u32x4*)(P + (size_t)row0 * NP + C_KB + lane * 8);
            if (two) { rb[0] = *(const u32x4*)(P + (size_t)row1 * NP + C_QB + lane * 8); rb[1] = *(const u32x4*)(P + (size_t)row1 * NP + C_KB + lane * 8); }
            qknorm_item(row0, lane, ra, p.in[18], p.in[19], QB, KB, out);
            if (two) qknorm_item(row1, lane, rb, p.in[18], p.in[19], QB, KB, out);
        }
    }
    SEAM(3);
    const bool gate67 = (G >= (MROWS / 256) * (DM / 256)) && p.coop && IN(4) && IN(5) && IN(6) && IN(7);
    unsigned* pcntA = (unsigned*)(ws + 65536);
    const bool gate45 = (G == 256) && p.coop && IN(4) && IN(5) && IN(6);
    unsigned* ucnt = (unsigned*)(ws + 49152);
    if (IN(4)) REPEAT(4) {
        const WT wtw4 = mk_wt(ws, (unsigned)WS_END);
        const int NIT = 256 + 768 + 128;
        for (int it = blk; it < NIT; it += G) {
            if (it < 256) {
                const int xcd = it & 7, jj = it >> 3, b = xcd >> 2, kv = (xcd >> 1) & 1, idx = (xcd & 1) * 32 + jj, qh = kv * 4 + (idx & 3), qblk = idx >> 2;
                const int rowq = MP + b * 4096 + qblk * 256;
                attn_item<0>(lds, tid, QB + (size_t)rowq * 512 + qh * 64, 512,
                             CK + (size_t)((b * 2 + kv) * 256) * 64, 64, CVT + (size_t)((b * 2 + kv) * 64) * 256, 256, 4,
                             KB + (size_t)(MP + b * 4096) * 128 + kv * 64, 128, VBT + (size_t)(kv * 64) * MROWS + MP + b * 4096, MROWS, 64,
                             0, 0, nullptr,
                             P + (size_t)rowq * NP + C_Z + 512 + qh * 64, NP, H + (size_t)rowq * DM + 512 + qh * 64, DM, wtw4, gate67, gate67 ? pcntA + 16 * (rowq >> 8) : nullptr);
            } else if (it < 256 + 768) {
                const int r0 = it - 256; int sid, h, dir, js;
                if (r0 < 256) { js = r0 & 1; dir = (r0 >> 1) & 1; h = (r0 >> 2) & 3; sid = r0 >> 4; }
                else { const int r = r0 - 256; js = r & 31; dir = (r >> 5) & 1; h = (r >> 6) & 3; sid = 16 + (r >> 8); }
                mlstm_u_item(lds, tid, sid, h, dir, js, SC, CH, st_m, KT, VT, U, UN, wtw4, gate45 ? ucnt : nullptr);
            } else {
                const int r = it - 1024, qh = r & 7, b = r >> 3, kv = qh >> 2;
                const int rowq = b * 256;
                attn_item<0>(lds, tid, QB + (size_t)rowq * 512 + qh * 64, 512,
                             KB, 128, VBT, MROWS, 0,
                             KB + (size_t)rowq * 128 + kv * 64, 128, VBT + (size_t)(kv * 64) * MROWS + rowq, MROWS, 4,
                             0, 0, nullptr,
                             P + (size_t)rowq * NP + C_Z + 512 + qh * 64, NP, H + (size_t)rowq * DM + 512 + qh * 64, DM, wtw4, gate67, gate67 ? pcntA + 16 * (rowq >> 8) : nullptr);
            }
        }
    }
    if (!gate45) SEAM(4);
    const bool gate56 = (G == 256) && p.coop && IN(5) && IN(6);
    unsigned* chcnt = (unsigned*)(ws + 32768);
    if (IN(5)) REPEAT(5) {
        const WT wtw = mk_wt(ws, (unsigned)WS_END);
        const int NT = G * 512;
        const int nS = 16 * 2048, nP = 128 * 2048;
        const int perS = (nS + G - 1) / G;
        const int nvb = gate56 ? 2 : 1;
        const int sblk = gate56 ? blk - 128 : blk;
        if (!gate56 || blk >= 128) {
            for (int ps = 0; ps < 2; ++ps) {
                const int pass = 1 - ps;
                if (gate45) {
                    if (tid == 0) {
                        unsigned spins = 0; bool ok = false;
                        while (!ok) {
                            ok = true;
                            for (int vbi = 0; vbi < 2; ++vbi) {
                                const int vb = sblk + 128 * vbi;
                                if (pass == 1) {
                                    ok = ok && __hip_atomic_load(ucnt + 16 * (vb >> 2), __ATOMIC_RELAXED, __HIP_MEMORY_SCOPE_AGENT) >= 2u
                                            && __hip_atomic_load(ucnt + 16 * ((vb >> 2) + 64), __ATOMIC_RELAXED, __HIP_MEMORY_SCOPE_AGENT) >= 2u;
                                    if (vb < 36) for (int q = 0; q < 4; ++q) { const int c = vb * 4 + q; ok = ok && __hip_atomic_load(ucnt + 16 * c, __ATOMIC_RELAXED, __HIP_MEMORY_SCOPE_AGENT) >= (c < 128 ? 2u : 32u); }
                                } else ok = ok && __hip_atomic_load(ucnt + 16 * (128 + (vb >> 4)), __ATOMIC_RELAXED, __HIP_MEMORY_SCOPE_AGENT) >= 32u;
                            }
                            if (!ok) { __builtin_amdgcn_s_sleep(1); if (++spins > (1u << 22)) break; }
                        }
                        __builtin_amdgcn_fence(__ATOMIC_ACQUIRE, "agent");
                        asm volatile("s_waitcnt vmcnt(0)" ::: "memory");
                    }
                    __syncthreads();
                }
                for (int vbi = 0; vbi < nvb; ++vbi) {
                    const int vb = sblk + 128 * vbi;
                    int i0, i1, st;
                    if (pass == 1) { i0 = vb * 512 + tid; i1 = nP; st = NT; }
                    else if (gate56) { const bool on = (vbi == 0) && (tid < 256); i0 = on ? (sblk + 128 * (tid >> 7)) * 128 + (tid & 127) : 0; i1 = on ? i0 + 1 : 0; st = 1; }
                    else { i0 = vb * perS + tid; i1 = min((vb + 1) * perS, nS); st = 512; }
                    for (int idx0 = i0; idx0 < i1; idx0 += st) {
            const int idx = pass == 0 ? nP + idx0 : idx0;
            const int chain = idx >> 11, e8 = (idx & 2047) * 8;
            int sid, h, dir;
            if (chain < 128) { dir = chain & 1; h = (chain >> 1) & 3; sid = chain >> 3; } else { const int r = chain - 128; dir = r & 1; h = (r >> 1) & 3; sid = 16 + (r >> 3); }
            const int nc = sid < 16 ? 2 : 32, base = chain_base(sid, h, dir);
            float cur[8];
            if (sid < 16) {
#pragma unroll
                for (int e = 0; e < 8; ++e) cur[e] = 0.f;
            } else {
                const float* c0 = st_C + ((size_t)(((sid - 16) * 2 + dir) * 4 + h)) * 16384 + e8;
                const f32x4 a = *(const f32x4*)c0, b = *(const f32x4*)(c0 + 4);
                cur[0] = a[0]; cur[1] = a[1]; cur[2] = a[2]; cur[3] = a[3]; cur[4] = b[0]; cur[5] = b[1]; cur[6] = b[2]; cur[7] = b[3];
            }
            float m = chain_m0(st_m, sid, h, dir);
            const bf16_t* __restrict__ Ub = U + (size_t)base * 16384 + e8;
            bf16_t* __restrict__ Cb = CST + (size_t)base * 16384 + e8;
            for (int js0 = 0; js0 < nc; js0 += 8) {
                u32x4 raw[8];
#pragma unroll
                for (int j = 0; j < 8; ++j) if (js0 + j < nc) raw[j] = *(const u32x4*)(Ub + (size_t)(js0 + j) * 16384);
#pragma unroll
                for (int j = 0; j < 8; ++j) if (js0 + j < nc) {
                    const int js = js0 + j;
                    const float bL = CH[(base + js) * 2], rmL = CH[(base + js) * 2 + 1];
                    const float Mx = fmaxf(m, rmL), a = expf(m - Mx), f = expf(rmL - Mx);
                    if (e8 == 0) __hip_atomic_store(MJ + base + js, m, __ATOMIC_RELAXED, __HIP_MEMORY_SCOPE_AGENT);
                    u32x4 wv; wv.x = cvtpk(cur[0], cur[1]); wv.y = cvtpk(cur[2], cur[3]); wv.z = cvtpk(cur[4], cur[5]); wv.w = cvtpk(cur[6], cur[7]);
                    wt16(wtw, Cb + (size_t)js * 16384, wv);
                    cur[0] = a * cur[0] + f * __uint_as_float(raw[j].x << 16); cur[1] = a * cur[1] + f * __uint_as_float(raw[j].x & 0xffff0000u);
                    cur[2] = a * cur[2] + f * __uint_as_float(raw[j].y << 16); cur[3] = a * cur[3] + f * __uint_as_float(raw[j].y & 0xffff0000u);
                    cur[4] = a * cur[4] + f * __uint_as_float(raw[j].z << 16); cur[5] = a * cur[5] + f * __uint_as_float(raw[j].z & 0xffff0000u);
                    cur[6] = a * cur[6] + f * __uint_as_float(raw[j].w << 16); cur[7] = a * cur[7] + f * __uint_as_float(raw[j].w & 0xffff0000u);
                    m = bL + Mx;
                }
            }
            if (sid < 16) {
                float* o = out + O_C + ((size_t)((sid * 2 + dir) * 4 + h)) * 16384 + e8;
                *(f32x4*)o = (f32x4){cur[0], cur[1], cur[2], cur[3]}; *(f32x4*)(o + 4) = (f32x4){cur[4], cur[5], cur[6], cur[7]};
            }
                            }
                }
                if (pass == 1) {
                    for (int vbi = 0; vbi < nvb; ++vbi)
                    for (int idx = (sblk + 128 * vbi) * 512 + tid; idx < 144 * 128; idx += NT) {
            const int chain = idx >> 7, k = idx & 127;
            int sid, h, dir;
            if (chain < 128) { dir = chain & 1; h = (chain >> 1) & 3; sid = chain >> 3; } else { const int r = chain - 128; dir = r & 1; h = (r >> 1) & 3; sid = 16 + (r >> 3); }
            const int nc = sid < 16 ? 2 : 32, base = chain_base(sid, h, dir);
            float cur = sid < 16 ? 0.f : st_n[(((sid - 16) * 2 + dir) * 4 + h) * 128 + k];
            float m = chain_m0(st_m, sid, h, dir);
            for (int js0 = 0; js0 < nc; js0 += 8) {
                float un[8];
#pragma unroll
                for (int j = 0; j < 8; ++j) if (js0 + j < nc) un[j] = UN[(size_t)(base + js0 + j) * 128 + k];
#pragma unroll
                for (int j = 0; j < 8; ++j) if (js0 + j < nc) {
                    const int js = js0 + j;
                    const float bL = CH[(base + js) * 2], rmL = CH[(base + js) * 2 + 1];
                    const float Mx = fmaxf(m, rmL), a = expf(m - Mx), f = expf(rmL - Mx);
                    __hip_atomic_store(NST + (size_t)(base + js) * 128 + k, cur, __ATOMIC_RELAXED, __HIP_MEMORY_SCOPE_AGENT);
                    cur = a * cur + f * un[j];
                    m = bL + Mx;
                }
            }
            if (sid < 16) {
                out[O_N + ((size_t)((sid * 2 + dir) * 4 + h)) * 128 + k] = cur;
                if (k == 0) out[O_M + (sid * 2 + dir) * 4 + h] = m;
            }
                            }
                }
                if (gate56) {
                    asm volatile("s_waitcnt vmcnt(0)" ::: "memory");
                    __syncthreads();
                    if (tid == 0) {
                        for (int vbi = 0; vbi < 2; ++vbi) {
                            const int vb = sblk + 128 * vbi;
                            if (pass == 1) {
                                __hip_atomic_fetch_add(chcnt + 16 * (vb >> 2), 1u, __ATOMIC_RELAXED, __HIP_MEMORY_SCOPE_AGENT);
                                __hip_atomic_fetch_add(chcnt + 16 * ((vb >> 2) + 64), 1u, __ATOMIC_RELAXED, __HIP_MEMORY_SCOPE_AGENT);
                                if (vb < 36) for (int q = 0; q < 4; ++q) __hip_atomic_fetch_add(chcnt + 16 * (vb * 4 + q), 1u, __ATOMIC_RELAXED, __HIP_MEMORY_SCOPE_AGENT);
                            } else {
                                __hip_atomic_fetch_add(chcnt + 16 * (128 + (vb >> 4)), 1u, __ATOMIC_RELAXED, __HIP_MEMORY_SCOPE_AGENT);
                            }
                        }
                    }
                }
            }
        } else {
            const int r = blk, jt = r & 1, h = (r >> 1) & 3, sid = r >> 3;
            if (tid == 0) {
                const int c0 = (sid * 4 + h) * 2; unsigned spins = 0;
                while (__hip_atomic_load(chcnt + 16 * c0, __ATOMIC_RELAXED, __HIP_MEMORY_SCOPE_AGENT) < 5u ||
                       __hip_atomic_load(chcnt + 16 * (c0 + 1), __ATOMIC_RELAXED, __HIP_MEMORY_SCOPE_AGENT) < 5u) { __builtin_amdgcn_s_sleep(1); if (++spins > (1u << 22)) break; }
                __builtin_amdgcn_fence(__ATOMIC_ACQUIRE, "agent");
                asm volatile("s_waitcnt vmcnt(0)" ::: "memory");
            }
            __syncthreads();
            mlstm_out_item(lds, tid, sid, h, jt, SC, MJ, NST, CST, P, VT, p.in[17], H, wtw, gate67, gate67 ? pcntA : nullptr);
        }
    }
    if (!gate56) SEAM(5);
    if (IN(6)) REPEAT(6) {
        const WT wtw = mk_wt(ws, (unsigned)WS_END);
        for (int it = blk; it < (gate56 ? 256 : 384); it += G) {
            int sid, h, jt;
            if (it < 256) { jt = it & 31; h = (it >> 5) & 3; sid = 16 + (it >> 7); }
            else { const int r = it - 256; jt = r & 1; h = (r >> 1) & 3; sid = r >> 3; }
            if (gate56) {
                if (tid == 0) {
                    const int c0 = 128 + ((sid - 16) * 4 + h) * 2; unsigned spins = 0;
                    while (__hip_atomic_load(chcnt + 16 * c0, __ATOMIC_RELAXED, __HIP_MEMORY_SCOPE_AGENT) < 17u ||
                           __hip_atomic_load(chcnt + 16 * (c0 + 1), __ATOMIC_RELAXED, __HIP_MEMORY_SCOPE_AGENT) < 17u) { __builtin_amdgcn_s_sleep(1); if (++spins > (1u << 22)) break; }
                    __builtin_amdgcn_fence(__ATOMIC_ACQUIRE, "agent");
                    asm volatile("s_waitcnt vmcnt(0)" ::: "memory");
                }
                __syncthreads();
            }
            mlstm_out_item(lds, tid, sid, h, jt, SC, MJ, NST, CST, P, VT, p.in[17], H, wtw, gate67, gate67 ? pcntA : nullptr);
        }
    }
    if (!gate67) SEAM(6);
    const bool fuse_mid = (G >= (MROWS / 256) * (DM / 256));
    if (IN(7)) REPEAT(7) {
        pg8::Gemm g{H, WOUTE, MROWS, 1024, 1024}; pg8::StaticOrder S; S.init(MROWS, 1024, G, blk);
        if (fuse_mid) {
            if (gate67) {
                pg8::Unit u0;
                if (S.next(0, u0)) {
                    if (tid == 0) {
                        unsigned spins = 0;
                        while (__hip_atomic_load(pcntA + 16 * u0.pm, __ATOMIC_RELAXED, __HIP_MEMORY_SCOPE_AGENT) < 16u) { __builtin_amdgcn_s_sleep(1); if (++spins > (1u << 22)) break; }
                        __builtin_amdgcn_fence(__ATOMIC_ACQUIRE, "agent");
                        asm volatile("s_waitcnt vmcnt(0)" ::: "memory");
                    }
                }
                __syncthreads();
            }
            EpiMid E{x_prompt, x_sample, MOD, gpost, gpre + DM, X1P, X1S, H, (float*)(ws + WS_G), (unsigned*)(ws + 16384)};
            pg8::gemm_phase(lds, g, S, E);
        } else {
            EpiPlain E{Y2, DM};
            pg8::gemm_phase(lds, g, S, E);
        }
        {
            const int nunits = (MROWS / 256) * (DM / 256);
            const bool some_idle = G > nunits;
            if (!some_idle || blk >= nunits) {
                const int nw = some_idle ? G - nunits : G, ib = some_idle ? blk - nunits : blk;
                LAS float* scr = (LAS float*)(lds + wave * 16384);
                const int I_C = 16 * 128, I_O = 16 * 32;
                for (int it = ib * 8 + wave; it < I_C + I_O; it += nw * 8) {
                    if (it < I_C) transpose_item(p.in[21], 1024, 4096, WINO, scr, it, lane);
                    else transpose_item(p.in[23], 1024, 1024, WOUTO, scr, it - I_C, lane);
                }
                const int NT = nw * 512;
                for (int i0 = ib * 512 + tid; i0 < 524288; i0 += 4 * NT) {
                    float ka[4], va[4];
#pragma unroll
                    for (int k = 0; k < 4; ++k) { const int i = i0 + k * NT; if (i < 524288) { ka[k] = p.in[7][i]; va[k] = p.in[8][i]; } }
#pragma unroll
                    for (int k = 0; k < 4; ++k) { const int i = i0 + k * NT; if (i < 524288) {
                        NK[i] = f2bf(ka[k]);
                        const int d = i & 63, s2 = (i >> 6) & 255, bh = i >> 14;
                        NVT[(bh * 64 + d) * 256 + s2] = f2bf(va[k]); } }
                }
            }
        }
    }
    SEAM(7);
    if (!fuse_mid) {
    if (IN(8)) REPEAT(8) {
        for (int row0 = gw; row0 < MROWS; row0 += 2 * NGW) {
            const float* xr[2]; const bf16_t* yr[2]; const float* md0[2]; const float* md1[2]; float* x1r[2]; bf16_t* hr[2];
#pragma unroll
            for (int r = 0; r < 2; ++r) {
                const int row = min(row0 + r * NGW, MROWS - 1);
                const int v = row < MP ? 0 : 1 + ((row - MP) >> 12);
                xr[r] = row < MP ? x_prompt + (size_t)row * DM : x_sample + (size_t)(row - MP) * DM;
                yr[r] = Y2 + (size_t)row * DM; md0[r] = MOD + (0 * 3 + v) * 3072; md1[r] = MOD + (1 * 3 + v) * 3072;
                x1r[r] = (float*)X1ROW(row); hr[r] = H + (size_t)row * DM;
            }
            postnorm_rows<true, 2, false, true>(xr, yr, gpost, md0, x1r, gpre + DM, md1, hr, lane);
        }
    }
    SEAM(8);
    }
    if (IN(9)) REPEAT(9) {
        pg8::Gemm g{H, WINO, MROWS, 4096, 1024}; pg8::StaticOrder S; S.init(MROWS, 4096, G, blk);
        EpiOddIn E{P, VCT, out};
        pg8::gemm_phase(lds, g, S, E);
    }
    SEAM(9);
    const bool gate1011 = (G >= (MROWS / 256) * (DM / 256)) && p.coop && IN(10) && IN(11);
    unsigned* pcntB = (unsigned*)(ws + 62464);
    if (IN(10)) REPEAT(10) {
        const WT wtw10 = mk_wt(ws, (unsigned)WS_END);
        LAS float* rpbL = (LAS float*)(lds + 8 * AT_TILE);
        for (int it = blk; it < 512 + 256; it += G) {
            if (it < 512) {
                const int xcd = it & 7, jj = (it >> 3) & 31, b = it >> 8, h = 2 * xcd + (jj >> 4), rblk = jj & 15;
                for (int i = tid; i < 640; i += 512) { const int j = i - 64; rpbL[i] = (j >= 0 && j < 465) ? p.in[22][h * 465 + j] * LOG2E : 0.f; }
                const int r0 = rblk * 4;
                const int rs_lo = min(max(r0 - 4, 0), 56), rs_hi = min(max(r0 + 3 - 4, 0), 56) + 7;
                const int rowq = MP + b * 4096 + r0 * 64, rowk = MP + b * 4096 + rs_lo * 64;
                attn_item<1>(lds, tid, P + (size_t)rowq * NP + h * 64, NP,
                             NK + (size_t)((b * 16 + h) * 256) * 64, 64, NVT + (size_t)((b * 16 + h) * 64) * 256, 256, 4,
                             P + (size_t)rowk * NP + 1024 + h * 64, NP, VCT + (size_t)(h * 64) * MROWS + rowk, MROWS, rs_hi - rs_lo + 1,
                             r0, rs_lo, rpbL,
                             P + (size_t)rowq * NP + 3072 + h * 64, NP, H + (size_t)rowq * DM + h * 64, DM, wtw10, gate1011, gate1011 ? pcntB + 16 * (rowq >> 8) : nullptr);
            } else {
                const int r = it - 512, h = r & 15, b = r >> 4;
                const int rowq = b * 256;
                attn_item<0>(lds, tid, P + (size_t)rowq * NP + h * 64, NP,
                             P, NP, VCT, MROWS, 0,
                             P + (size_t)rowq * NP + 1024 + h * 64, NP, VCT + (size_t)(h * 64) * MROWS + rowq, MROWS, 4,
                             0, 0, nullptr,
                             P + (size_t)rowq * NP + 3072 + h * 64, NP, H + (size_t)rowq * DM + h * 64, DM, wtw10, gate1011, gate1011 ? pcntB + 16 * (rowq >> 8) : nullptr);
            }
        }
    }
    if (!gate1011) SEAM(10);
    const bool fuse_last = (G >= (MROWS / 256) * (DM / 256));
    if (IN(11)) REPEAT(11) {
        pg8::Gemm g{H, WOUTO, MROWS, 1024, 1024}; pg8::StaticOrder S; S.init(MROWS, 1024, G, blk);
        if (fuse_last) {
            if (gate1011) {
                pg8::Unit u0;
                if (S.next(0, u0)) {
                    if (tid == 0) {
                        unsigned spins = 0;
                        while (__hip_atomic_load(pcntB + 16 * u0.pm, __ATOMIC_RELAXED, __HIP_MEMORY_SCOPE_AGENT) < 16u) { __builtin_amdgcn_s_sleep(1); if (++spins > (1u << 22)) break; }
                        __builtin_amdgcn_fence(__ATOMIC_ACQUIRE, "agent");
                        asm volatile("s_waitcnt vmcnt(0)" ::: "memory");
                    }
                }
                __syncthreads();
            }
            EpiFinal E{X1P, X1S, MOD, gpost + DM, out, (float*)(ws + WS_G), (unsigned*)(ws + 16384)};
            pg8::gemm_phase(lds, g, S, E);
        } else {
            EpiPlain E{Y2, DM};
            pg8::gemm_phase(lds, g, S, E);
        }
    }
    if (!fuse_last) {
    SEAM(11);
    if (IN(12)) {
        for (int row0 = gw; row0 < MROWS; row0 += 2 * NGW) {
            const float* xr[2]; const bf16_t* yr[2]; const float* md1[2]; float* x1r[2]; bf16_t* hr[2];
#pragma unroll
            for (int r = 0; r < 2; ++r) {
                const int row = min(row0 + r * NGW, MROWS - 1);
                const int v = row < MP ? 0 : 1 + ((row - MP) >> 12);
                xr[r] = (const float*)X1ROW(row); yr[r] = Y2 + (size_t)row * DM; md1[r] = MOD + (1 * 3 + v) * 3072; x1r[r] = out + (size_t)row * DM; hr[r] = nullptr;
            }
            postnorm_rows<false, 2, true, false>(xr, yr, gpost + DM, md1, x1r, nullptr, md1, hr, lane);
        }
    }
    }
#undef IN
#undef SEAM
#undef REPEAT
#undef lane
#undef wave
#undef gw
#undef X1ROW
}

#ifndef MK_COOP
#define MK_COOP 1
#endif
extern "C" void kernel_launch(void* const* d_in, const int* in_sizes, int n_in, void* d_out, int out_size, void* d_ws, size_t ws_size, hipStream_t stream) {
    static int grid = 0;
    if (grid == 0) {
        int dev = 0, cus = 0, per_cu = 0;
        (void)hipGetDevice(&dev);
        (void)hipDeviceGetAttribute(&cus, hipDeviceAttributeMultiprocessorCount, dev);
        (void)hipFuncSetAttribute((const void*)fwd_megakernel, hipFuncAttributeMaxDynamicSharedMemorySize, LDS_BYTES);
        (void)hipOccupancyMaxActiveBlocksPerMultiprocessor(&per_cu, (const void*)fwd_megakernel, 512, LDS_BYTES);
        if (per_cu < 1) { fprintf(stderr, "kernel_launch: occupancy query returned %d\n", per_cu); per_cu = 1; }
        grid = cus * per_cu;
        if (ws_size < WS_END) fprintf(stderr, "kernel_launch: workspace too small (%zu < %zu)\n", ws_size, (size_t)WS_END);
    }
    Params p{};
    for (int i = 0; i < 24; ++i) p.in[i] = (const float*)d_in[i];
    p.out = (float*)d_out; p.ws = (unsigned char*)d_ws;
#if MK_COOP
    p.ph_lo = 0; p.ph_hi = 13; p.coop = 1; p.pad = 0;
    void* args[] = {&p};
    (void)hipMemsetAsync((char*)d_ws + WS_BAR, 0, 131072, stream);
    hipError_t e = hipLaunchCooperativeKernel((const void*)fwd_megakernel, dim3(grid), dim3(512), args, LDS_BYTES, stream);
    if (e != hipSuccess) fprintf(stderr, "cooperative launch failed: %s (grid %d)\n", hipGetErrorString(e), grid);
#else
    for (int ph = 0; ph < 13; ++ph) {
        p.ph_lo = ph; p.ph_hi = ph + 1; p.coop = 0; p.pad = 0;
        hipLaunchKernelGGL(fwd_megakernel, dim3(grid), dim3(512), LDS_BYTES, stream, p);
    }
#endif
}
```

```cpp
#include <hip/hip_runtime.h>
#include <hip/hip_cooperative_groups.h>
#include <cstdio>
#include <cstdint>
namespace cg = cooperative_groups;

#define LAS __attribute__((address_space(3)))
#define DI __device__ __forceinline__
typedef unsigned short bf16_t;
typedef short bf16x8 __attribute__((ext_vector_type(8)));
typedef short s16x4 __attribute__((ext_vector_type(4)));
typedef float f32x4 __attribute__((ext_vector_type(4)));
typedef float f32x2 __attribute__((ext_vector_type(2)));
typedef float f32x16 __attribute__((ext_vector_type(16)));
typedef unsigned u32x4 __attribute__((ext_vector_type(4)));
typedef unsigned u32x2 __attribute__((ext_vector_type(2)));
typedef __bf16 bf16x2_t __attribute__((ext_vector_type(2)));

constexpr int DM = 1024, MP = 4096, MS = 8192, MROWS = 12288, NP = 4096;
constexpr float EPS = 1e-6f;
constexpr float LOG2E = 1.4426950408889634f;
constexpr float QSCALE = 0.125f * LOG2E;
constexpr int C_QA = 0, C_KA = 512, C_VA = 1024, C_OA = 1536, C_G = 2048, C_QB = 2064, C_KB = 2576, C_VB = 2704, C_Z = 2832, C_END = 3856;
constexpr size_t O_YP = 0, O_YS = 4194304, O_C = 12582912, O_N = 14680064, O_M = 14696448, O_GK = 14696576, O_GV = 15220864, O_NK = 15745152, O_NV = 19939456;
constexpr size_t MiB = 1u << 20;
constexpr size_t WS_BAR = 0;
constexpr size_t WS_MOD = 1 * MiB;
constexpr size_t WS_G = 2 * MiB;
constexpr size_t WS_SC = 3 * MiB;
constexpr size_t WS_CH = 5 * MiB;
constexpr size_t WS_UN = 5 * MiB + 65536;
constexpr size_t WS_NST = 5 * MiB + 65536 + 393216;
constexpr size_t WS_MJ = 5 * MiB + 65536 + 786432;
constexpr size_t WS_CK = 6 * MiB;
constexpr size_t WS_CVT = 6 * MiB + 131072;
constexpr size_t WS_NK = 7 * MiB;
constexpr size_t WS_NVT = 8 * MiB;
constexpr size_t WS_WINE = 10 * MiB;
constexpr size_t WS_WOUTE = 18 * MiB;
constexpr size_t WS_WINO = 20 * MiB;
constexpr size_t WS_WOUTO = 28 * MiB;
constexpr size_t WS_H = 30 * MiB;
constexpr size_t WS_KT = 54 * MiB;
constexpr size_t WS_VT = 66 * MiB;
constexpr size_t WS_Y2 = 54 * MiB;
constexpr size_t WS_P = 78 * MiB;
constexpr size_t WS_CST = 174 * MiB;
constexpr size_t WS_QB = 198 * MiB;
constexpr size_t WS_KB = 210 * MiB;
constexpr size_t WS_VBT = 213 * MiB;
constexpr size_t WS_U = 216 * MiB;
constexpr size_t WS_VCT = 216 * MiB;
constexpr size_t WS_X1P = 10 * MiB;
constexpr size_t WS_X1S = 240 * MiB;
constexpr size_t WS_END = 256 * MiB;

constexpr int REP_MASK = 0, SYNC_REP = 1;
constexpr int LDS_BYTES = 147456;

DI float bf2f(unsigned short b) { return __uint_as_float(((unsigned)b) << 16); }
DI unsigned cvtpk(float lo, float hi) { f32x2 v = {lo, hi}; bf16x2_t b = __builtin_convertvector(v, bf16x2_t); return __builtin_bit_cast(unsigned, b); }
DI unsigned short f2bf(float x) { return (unsigned short)(cvtpk(x, 0.f) & 0xffffu); }
DI float siluf(float x) { return x / (1.f + __expf(-x)); }
DI float sigmf(float x) { return 1.f / (1.f + __expf(-x)); }
DI float wave_sum(float v) {
#pragma unroll
    for (int o = 1; o < 64; o <<= 1) v += __shfl_xor(v, o);
    return v;
}
DI int crow(int i, int h) { return (i & 3) + 8 * (i >> 2) + 4 * h; }
DI bf16x8 pack8(float a0, float a1, float a2, float a3, float a4, float a5, float a6, float a7) {
    u32x4 p; p.x = cvtpk(a0, a1); p.y = cvtpk(a2, a3); p.z = cvtpk(a4, a5); p.w = cvtpk(a6, a7);
    return __builtin_bit_cast(bf16x8, p);
}
#define MFMA32(a, b, c) __builtin_amdgcn_mfma_f32_32x32x16_bf16((a), (b), (c), 0, 0, 0)

namespace pg8 {
constexpr int BM = 256, BK = 64, HALF = 128, HTB = HALF * BK * 2, NXCD = 8, WGM = 8;
DI int lds_byte(int r, int c) { const int st = (r >> 4) * 2 + (c >> 5), rr = r & 15, cc = c & 31, ob = rr * 64 + cc * 2; return st * 1024 + (ob ^ (((ob >> 9) & 1) << 5)); }
DI void stage_rc(int b, int& R, int& C) { const int st = b / 1024, sb = b % 1024, swz = sb ^ (((sb >> 9) & 1) << 5); R = (st >> 1) * 16 + swz / 64; C = (st & 1) * 32 + (swz % 64) / 2; }
DI int perm32(int rho) { const int n = rho >> 4, i = rho & 15; return 8 * (i >> 2) + 4 * n + (i & 3); }
struct Unit { int pm, pn; };
struct Gemm { const bf16_t* A; const bf16_t* Bt; int M, N, K; };
struct StaticOrder {
    int nM, nN, nwg, G, c;
    DI void init(int M, int N, int G_, int c_) { nM = M / BM; nN = N / BM; nwg = nM * nN; G = G_; c = c_; }
    DI bool next(int i, Unit& u) const {
        const long L = (long)i * G + c; if (L >= nwg) return false;
        int wgid = (int)L; { const int q = nwg / NXCD, r = nwg % NXCD, xcd = wgid % NXCD, off = wgid / NXCD; wgid = (xcd < r ? xcd * (q + 1) : r * (q + 1) + (xcd - r) * q) + off; }
        const int nig = WGM * nN, gid = wgid / nig, fm = gid * WGM, gsz = (nM - fm) < WGM ? (nM - fm) : WGM;
        u.pm = fm + ((wgid % nig) % gsz); u.pn = (wgid % nig) / gsz; return true;
    }
};
template <class Epi>
DI void gemm_phase(LAS unsigned char* lds, const Gemm g, const StaticOrder& S, const Epi& E) {
    const int tid = threadIdx.x, wid = __builtin_amdgcn_readfirstlane(tid >> 6), lane = tid & 63, wr = wid >> 2, wc = wid & 3, fr = lane & 15, fq = lane >> 4;
    const int K = g.K, nt = K / BK;
    unsigned voffA[2], voffB[2];
#pragma unroll
    for (int i = 0; i < 2; ++i) { int R, C; stage_rc(tid * 16 + i * 8192, R, C); const int Rb = (R & ~31) + perm32(R & 31);
        voffA[i] = (unsigned)(R * K + C) * 2u; voffB[i] = (unsigned)(Rb * K + C) * 2u; }
    const size_t kstep = (size_t)(BK * 2);
    const size_t hstep = (size_t)HALF * K * 2;
    const size_t tstep = 2 * hstep;
    const unsigned ldsw = (unsigned)wid * 1024u;
    const int aoff = lds_byte(wr * 64 + fr, fq * 8), boff = lds_byte(wc * 32 + fr, fq * 8);
#define PG8_SA(b, h) (((b) * 2 + (h)) * HTB)
#define PG8_SB(b, h) ((4 + (b) * 2 + (h)) * HTB)
#define PG8_STAGE(bufoff, gbase, voff) do { _Pragma("unroll") for (int _i = 0; _i < 2; ++_i) \
        __builtin_amdgcn_global_load_lds((const unsigned*)((const char*)(gbase) + (voff)[_i]), (LAS unsigned*)(lds + (bufoff) + ldsw + _i * 8192), 16, 0, 0); } while (0)
#define PG8_LDA(dst, b, h) do { _Pragma("unroll") for (int m = 0; m < 4; ++m) _Pragma("unroll") for (int k = 0; k < 2; ++k) dst[m][k] = *(const LAS bf16x8*)(lds + PG8_SA(b, h) + aoff + m * 2048 + k * 1024); } while (0)
#define PG8_LDB(dst, b, h) do { _Pragma("unroll") for (int n = 0; n < 2; ++n) _Pragma("unroll") for (int k = 0; k < 2; ++k) dst[n][k] = *(const LAS bf16x8*)(lds + PG8_SB(b, h) + boff + n * 2048 + k * 1024); } while (0)
#define PG8_MMA(ai, bj, At, Bt) do { __builtin_amdgcn_s_setprio(1); _Pragma("unroll") for (int m = 0; m < 4; ++m) _Pragma("unroll") for (int n = 0; n < 2; ++n) _Pragma("unroll") for (int k = 0; k < 2; ++k) \
        acc[ai][bj][m][n] = __builtin_amdgcn_mfma_f32_16x16x32_bf16(Bt[n][k], At[m][k], acc[ai][bj][m][n], 0, 0, 0); __builtin_amdgcn_s_setprio(0); } while (0)
#define PG8_WAIT_V(n) asm volatile("s_waitcnt vmcnt(" #n ")" ::: "memory")
#define PG8_WAIT_L(n) asm volatile("s_waitcnt lgkmcnt(" #n ")" ::: "memory")
#define PG8_BAR __builtin_amdgcn_s_barrier()
#define PG8_SCHED __builtin_amdgcn_sched_barrier(0)
    Unit cur, nxt; int ui = 0;
    if (!S.next(0, cur)) return;
    f32x4 acc[2][2][4][2];
#pragma unroll
    for (int a = 0; a < 2; ++a)
#pragma unroll
        for (int b = 0; b < 2; ++b)
#pragma unroll
            for (int m = 0; m < 4; ++m)
#pragma unroll
                for (int n = 0; n < 2; ++n) acc[a][b][m][n] = (f32x4){0.f, 0.f, 0.f, 0.f};
    bf16x8 At[4][2], B0[2][2], B1[2][2];
    const char* cA = (const char*)g.A + (size_t)cur.pm * tstep; const char* cB = (const char*)g.Bt + (size_t)cur.pn * tstep;
    PG8_STAGE(PG8_SB(0, 0), cB, voffB); PG8_STAGE(PG8_SB(0, 1), cB + hstep, voffB); PG8_STAGE(PG8_SA(0, 0), cA, voffA); PG8_STAGE(PG8_SA(0, 1), cA + hstep, voffA);
    if (wr == 1) PG8_BAR;
    PG8_WAIT_V(2); PG8_BAR;
    PG8_STAGE(PG8_SB(1, 0), cB + kstep, voffB); PG8_STAGE(PG8_SA(1, 0), cA + kstep, voffA); PG8_STAGE(PG8_SB(1, 1), cB + hstep + kstep, voffB);
    PG8_WAIT_V(6); PG8_BAR;
    for (;;) {
        const bool has_next = S.next(ui + 1, nxt);
        const char* nA = has_next ? (const char*)g.A + (size_t)nxt.pm * tstep : cA; const char* nB = has_next ? (const char*)g.Bt + (size_t)nxt.pn * tstep : cB;
        for (int t = 0; t < nt; t += 2) {
            const bool last = (t == nt - 2);
            const char* a1 = cA + (size_t)(t + 1) * kstep;
            const char* a2 = last ? nA : cA + (size_t)(t + 2) * kstep; const char* b2 = last ? nB : cB + (size_t)(t + 2) * kstep;
            const char* a3 = a2 + kstep; const char* b3 = b2 + kstep;
            PG8_LDB(B0, 0, 0); PG8_LDB(B1, 0, 1); PG8_SCHED; PG8_LDA(At, 0, 0); PG8_STAGE(PG8_SA(1, 1), a1 + hstep, voffA);
            PG8_WAIT_V(8); PG8_WAIT_L(0); PG8_BAR; PG8_MMA(0, 0, At, B0); PG8_MMA(0, 1, At, B1); PG8_BAR; PG8_SCHED;
            PG8_LDA(At, 0, 1); PG8_STAGE(PG8_SB(0, 0), b2, voffB); PG8_STAGE(PG8_SB(0, 1), b2 + hstep, voffB); PG8_STAGE(PG8_SA(0, 0), a2, voffA);
            PG8_WAIT_V(8); PG8_WAIT_L(0); PG8_BAR; PG8_MMA(1, 0, At, B0); PG8_MMA(1, 1, At, B1); PG8_BAR; PG8_SCHED;
            PG8_LDB(B0, 1, 0); PG8_LDB(B1, 1, 1); PG8_SCHED; PG8_LDA(At, 1, 0); PG8_STAGE(PG8_SA(0, 1), a2 + hstep, voffA);
            PG8_WAIT_V(8); PG8_WAIT_L(0); PG8_BAR; PG8_MMA(0, 0, At, B0); PG8_MMA(0, 1, At, B1); PG8_BAR; PG8_SCHED;
            PG8_LDA(At, 1, 1); PG8_STAGE(PG8_SB(1, 0), b3, voffB); PG8_STAGE(PG8_SB(1, 1), b3 + hstep, voffB); PG8_STAGE(PG8_SA(1, 0), a3, voffA);
            PG8_WAIT_V(8); PG8_WAIT_L(0); PG8_BAR; PG8_MMA(1, 0, At, B0); PG8_MMA(1, 1, At, B1); PG8_BAR; PG8_SCHED;
        }
        if (wr == 0) PG8_BAR;
        if constexpr (!Epi::AFTER_DRAIN) E(acc, cur, wr, wc, fr, fq);
        if (!has_next) break;
#pragma unroll
        for (int a = 0; a < 2; ++a)
#pragma unroll
            for (int b = 0; b < 2; ++b)
#pragma unroll
                for (int m = 0; m < 4; ++m)
#pragma unroll
                    for (int n = 0; n < 2; ++n) acc[a][b][m][n] = (f32x4){0.f, 0.f, 0.f, 0.f};
        cur = nxt; cA = nA; cB = nB; ++ui;
        if (wr == 1) PG8_BAR;
    }
    PG8_WAIT_V(0);
    PG8_BAR;
    if constexpr (Epi::AFTER_DRAIN) E.fused(acc, cur, wr, wc, fr, fq, lds, wid, lane);
#undef PG8_SA
#undef PG8_SB
#undef PG8_STAGE
#undef PG8_LDA
#undef PG8_LDB
#undef PG8_MMA
#undef PG8_WAIT_V
#undef PG8_WAIT_L
#undef PG8_BAR
#undef PG8_SCHED
}
}

struct Params {
    const float* in[24];
    float* out;
    unsigned char* ws;
    int ph_lo, ph_hi, coop, pad;
};

struct WT { __amdgpu_buffer_rsrc_t rs; const unsigned char* base; };
DI WT mk_wt(const void* base, unsigned bytes) { WT w; w.rs = __builtin_amdgcn_make_buffer_rsrc((void*)base, (short)0, (int)bytes, 0x00020000); w.base = (const unsigned char*)base; return w; }
DI void wt16(const WT& w, const void* p, u32x4 v) { __builtin_amdgcn_raw_buffer_store_b128(v, w.rs, (unsigned)((const unsigned char*)p - w.base), 0, 16); }
DI void st_bf16x8(bf16_t* p, f32x4 a, f32x4 b) {
    u32x4 w; w.x = cvtpk(a[0], a[1]); w.y = cvtpk(a[2], a[3]); w.z = cvtpk(b[0], b[1]); w.w = cvtpk(b[2], b[3]);
    *(u32x4*)p = w;
}

struct EpiEvenIn {
    static constexpr bool AFTER_DRAIN = false;
    bf16_t* P; bf16_t* KT; bf16_t* VT; bf16_t* VbT; float* G; float* out;
    DI void operator()(const f32x4 (&acc)[2][2][4][2], const pg8::Unit& u, int wr, int wc, int fr, int fq) const {
#pragma unroll
        for (int bj = 0; bj < 2; ++bj) {
            const int c8 = u.pn * 256 + bj * 128 + wc * 32 + 8 * fq;
            if (c8 >= C_END) continue;
#pragma unroll
            for (int ai = 0; ai < 2; ++ai)
#pragma unroll
                for (int m = 0; m < 4; ++m) {
                    const int row = u.pm * 256 + ai * 128 + wr * 64 + m * 16 + fr;
                    f32x4 v0 = acc[ai][bj][m][0], v1 = acc[ai][bj][m][1];
                    if (c8 >= C_KA && c8 < C_VA) { v0 = v0 * 0.08838834764831845f; v1 = v1 * 0.08838834764831845f; }
                    if (c8 >= C_Z) {
#pragma unroll
                        for (int j = 0; j < 4; ++j) { v0[j] = siluf(v0[j]); v1[j] = siluf(v1[j]); }
                    }
                    if (c8 >= C_G && c8 < C_QB) {
                        *(f32x4*)(G + (size_t)row * 16 + (c8 - C_G)) = v0; *(f32x4*)(G + (size_t)row * 16 + (c8 - C_G) + 4) = v1;
                    } else {
                        st_bf16x8(P + (size_t)row * NP + c8, v0, v1);
                    }
                    bf16_t* T = nullptr; int tc = 0;
                    if (c8 >= C_KA && c8 < C_VA) { T = KT; tc = c8 - C_KA; }
                    else if (c8 >= C_VA && c8 < C_OA) { T = VT; tc = c8 - C_VA; }
                    else if (c8 >= C_VB && c8 < C_Z) { T = VbT; tc = c8 - C_VB; }
                    if (T) {
#pragma unroll
                        for (int j = 0; j < 4; ++j) { T[(size_t)(tc + j) * MROWS + row] = f2bf(v0[j]); T[(size_t)(tc + 4 + j) * MROWS + row] = f2bf(v1[j]); }
                    }
                    if (c8 >= C_VB && c8 < C_Z && row < MP) {
                        const int c = c8 - C_VB, hk = c >> 6, d = c & 63, b = row >> 8, t = row & 255;
                        float* o = out + O_GV + ((size_t)((b * 2 + hk) * 256 + t)) * 64 + d;
                        *(f32x4*)o = v0; *(f32x4*)(o + 4) = v1;
                    }
                }
        }
    }
};
struct EpiPlain {
    static constexpr bool AFTER_DRAIN = false;
    bf16_t* O; int ldc;
    DI void operator()(const f32x4 (&acc)[2][2][4][2], const pg8::Unit& u, int wr, int wc, int fr, int fq) const {
#pragma unroll
        for (int bj = 0; bj < 2; ++bj) {
            const int c8 = u.pn * 256 + bj * 128 + wc * 32 + 8 * fq;
#pragma unroll
            for (int ai = 0; ai < 2; ++ai)
#pragma unroll
                for (int m = 0; m < 4; ++m) {
                    const int row = u.pm * 256 + ai * 128 + wr * 64 + m * 16 + fr;
                    st_bf16x8(O + (size_t)row * ldc + c8, acc[ai][bj][m][0], acc[ai][bj][m][1]);
                }
        }
    }
};
struct EpiOddIn {
    static constexpr bool AFTER_DRAIN = false;
    bf16_t* P; bf16_t* VcT; float* out;
    DI void operator()(const f32x4 (&acc)[2][2][4][2], const pg8::Unit& u, int wr, int wc, int fr, int fq) const {
#pragma unroll
        for (int bj = 0; bj < 2; ++bj) {
            const int c8 = u.pn * 256 + bj * 128 + wc * 32 + 8 * fq;
            const int seg = c8 >> 10, c = c8 & 1023;
#pragma unroll
            for (int ai = 0; ai < 2; ++ai)
#pragma unroll
                for (int m = 0; m < 4; ++m) {
                    const int row = u.pm * 256 + ai * 128 + wr * 64 + m * 16 + fr;
                    f32x4 v0 = acc[ai][bj][m][0], v1 = acc[ai][bj][m][1];
                    if ((seg == 1 || seg == 2) && row < MP) {
                        const int h = c >> 6, d = c & 63, b = row >> 8, t = row & 255;
                        float* o = out + (seg == 1 ? O_NK : O_NV) + ((size_t)((b * 16 + h) * 256 + t)) * 64 + d;
                        *(f32x4*)o = v0; *(f32x4*)(o + 4) = v1;
                    }
                    if (seg == 2) {
#pragma unroll
                        for (int j = 0; j < 4; ++j) { VcT[(size_t)(c + j) * MROWS + row] = f2bf(v0[j]); VcT[(size_t)(c + 4 + j) * MROWS + row] = f2bf(v1[j]); }
                    } else {
                        if (seg == 0) { v0 = v0 * QSCALE; v1 = v1 * QSCALE; }
                        if (seg == 3) {
#pragma unroll
                            for (int j = 0; j < 4; ++j) { v0[j] = siluf(v0[j]); v1[j] = siluf(v1[j]); }
                        }
                        st_bf16x8(P + (size_t)row * NP + c8, v0, v1);
                    }
                }
        }
    }
};

DI void panel_row_rinv(const f32x4 (&v)[2][2][4][2], const pg8::Unit& u, int wr, int wc, int fr, int fq, LAS float* Pl, LAS float* Sl, int tid, float* slot, unsigned* c) {
#pragma unroll
    for (int ai = 0; ai < 2; ++ai)
#pragma unroll
        for (int m = 0; m < 4; ++m) {
            float sq = 0.f;
#pragma unroll
            for (int bj = 0; bj < 2; ++bj)
#pragma unroll
                for (int n = 0; n < 2; ++n) { const f32x4 x = v[ai][bj][m][n]; sq += (x[0] * x[0] + x[1] * x[1]) + (x[2] * x[2] + x[3] * x[3]); }
            sq += __shfl_xor(sq, 16); sq += __shfl_xor(sq, 32);
            if (fq == 0) Pl[(ai * 128 + wr * 64 + m * 16 + fr) * 4 + wc] = sq;
        }
    __syncthreads();
    if (tid < 256) {
        const float tot = (Pl[tid * 4 + 0] + Pl[tid * 4 + 1]) + (Pl[tid * 4 + 2] + Pl[tid * 4 + 3]);
        __hip_atomic_store(slot + tid * 4 + u.pn, tot, __ATOMIC_RELAXED, __HIP_MEMORY_SCOPE_AGENT);
    }
    asm volatile("s_waitcnt vmcnt(0)" ::: "memory");
    __syncthreads();
    if (tid == 0) {
        __hip_atomic_fetch_add(c, 1u, __ATOMIC_RELAXED, __HIP_MEMORY_SCOPE_AGENT);
        unsigned spins = 0;
        while (__hip_atomic_load(c, __ATOMIC_RELAXED, __HIP_MEMORY_SCOPE_AGENT) < 4u) { __builtin_amdgcn_s_sleep(1); if (++spins > (1u << 22)) break; }
        asm volatile("" ::: "memory");
    }
    __syncthreads();
    if (tid < 256) {
        float t = 0.f;
#pragma unroll
        for (int k = 0; k < 4; ++k) t += __hip_atomic_load(slot + tid * 4 + k, __ATOMIC_RELAXED, __HIP_MEMORY_SCOPE_AGENT);
        Sl[tid] = rsqrtf(t * (1.f / DM) + EPS);
    }
    __syncthreads();
}
struct EpiFinal {
    static constexpr bool AFTER_DRAIN = true;
    const bf16_t* X1P; const bf16_t* X1S; const float* MODl; const float* gpost; float* out; float* xbuf; unsigned* cnt;
    DI void fused(f32x4 (&acc)[2][2][4][2], const pg8::Unit& u, int wr, int wc, int fr, int fq, LAS unsigned char* lds, int wid, int lane) const {
        LAS float* Pl = (LAS float*)lds;
        LAS float* Sl = Pl + 1024;
        const int tid = wid * 64 + lane;
        u32x4 pxr[2][4];
        {
            const int c8 = u.pn * 256 + wc * 32 + 8 * fq;
#pragma unroll
            for (int ai = 0; ai < 2; ++ai)
#pragma unroll
                for (int m = 0; m < 4; ++m) { const int row = u.pm * 256 + ai * 128 + wr * 64 + m * 16 + fr;
                    pxr[ai][m] = *(const u32x4*)((row < MP ? X1P + (size_t)row * DM : X1S + (size_t)(row - MP) * DM) + c8); }
        }
        panel_row_rinv(acc, u, wr, wc, fr, fq, Pl, Sl, tid, xbuf + (size_t)(u.pm * 256) * 4, cnt + 16 * u.pm);
        const int v = u.pm < 16 ? 0 : 1 + ((u.pm - 16) >> 4);
        const float* gate = MODl + (1 * 3 + v) * 3072 + 2048;
#pragma unroll
        for (int bj = 0; bj < 2; ++bj) {
            const int c8 = u.pn * 256 + bj * 128 + wc * 32 + 8 * fq;
            const f32x4 g0 = *(const f32x4*)(gpost + c8), g1 = *(const f32x4*)(gpost + c8 + 4);
            const f32x4 t0 = *(const f32x4*)(gate + c8), t1 = *(const f32x4*)(gate + c8 + 4);
#pragma unroll
            for (int ai = 0; ai < 2; ++ai)
#pragma unroll
                for (int m = 0; m < 4; ++m) {
                    const int rl = ai * 128 + wr * 64 + m * 16 + fr, row = u.pm * 256 + rl;
                    const float rinv = Sl[rl];
                    const u32x4 xr = bj == 0 ? pxr[ai][m] : *(const u32x4*)((row < MP ? X1P + (size_t)row * DM : X1S + (size_t)(row - MP) * DM) + c8);
                    const f32x4 y0 = acc[ai][bj][m][0], y1 = acc[ai][bj][m][1];
                    f32x4 o0, o1;
                    o0[0] = __uint_as_float(xr.x << 16) + t0[0] * (y0[0] * rinv * g0[0]); o0[1] = __uint_as_float(xr.x & 0xffff0000u) + t0[1] * (y0[1] * rinv * g0[1]);
                    o0[2] = __uint_as_float(xr.y << 16) + t0[2] * (y0[2] * rinv * g0[2]); o0[3] = __uint_as_float(xr.y & 0xffff0000u) + t0[3] * (y0[3] * rinv * g0[3]);
                    o1[0] = __uint_as_float(xr.z << 16) + t1[0] * (y1[0] * rinv * g1[0]); o1[1] = __uint_as_float(xr.z & 0xffff0000u) + t1[1] * (y1[1] * rinv * g1[1]);
                    o1[2] = __uint_as_float(xr.w << 16) + t1[2] * (y1[2] * rinv * g1[2]); o1[3] = __uint_as_float(xr.w & 0xffff0000u) + t1[3] * (y1[3] * rinv * g1[3]);
                    float* op = out + (size_t)row * DM + c8;
                    *(f32x4*)op = o0; *(f32x4*)(op + 4) = o1;
                }
        }
    }
};

struct EpiMid {
    static constexpr bool AFTER_DRAIN = true;
    const float* x_prompt; const float* x_sample; const float* MODl; const float* gpost; const float* gpre1; bf16_t* X1P; bf16_t* X1S; bf16_t* Hn; float* xbuf; unsigned* cnt;
    DI void fused(f32x4 (&acc)[2][2][4][2], const pg8::Unit& u, int wr, int wc, int fr, int fq, LAS unsigned char* lds, int wid, int lane) const {
        LAS float* Pl = (LAS float*)lds; LAS float* Sl = Pl + 1024;
        const int tid = wid * 64 + lane;
        panel_row_rinv(acc, u, wr, wc, fr, fq, Pl, Sl, tid, xbuf + (size_t)(12288 + u.pm * 256) * 4, cnt + 16 * (48 + u.pm));
        const int v = u.pm < 16 ? 0 : 1 + ((u.pm - 16) >> 4);
        const float* md0 = MODl + (0 * 3 + v) * 3072; const float* md1 = MODl + (1 * 3 + v) * 3072;
        const float* xbase = u.pm < 16 ? x_prompt + (size_t)(u.pm * 256) * DM : x_sample + (size_t)(u.pm * 256 - MP) * DM;
#pragma unroll
        for (int bj = 0; bj < 2; ++bj) {
            const int c8 = u.pn * 256 + bj * 128 + wc * 32 + 8 * fq;
            const f32x4 g0 = *(const f32x4*)(gpost + c8), g1 = *(const f32x4*)(gpost + c8 + 4);
            const f32x4 t0 = *(const f32x4*)(md0 + 2048 + c8), t1 = *(const f32x4*)(md0 + 2048 + c8 + 4);
#pragma unroll
            for (int ai = 0; ai < 2; ++ai)
#pragma unroll
                for (int m = 0; m < 4; ++m) {
                    const int rl = ai * 128 + wr * 64 + m * 16 + fr, row = u.pm * 256 + rl;
                    const float rinv = Sl[rl];
                    const f32x4 x0 = *(const f32x4*)(xbase + (size_t)rl * DM + c8), x1 = *(const f32x4*)(xbase + (size_t)rl * DM + c8 + 4);
                    f32x4 y0 = acc[ai][bj][m][0], y1 = acc[ai][bj][m][1];
#pragma unroll
                    for (int e = 0; e < 4; ++e) { y0[e] = x0[e] + t0[e] * (y0[e] * rinv * g0[e]); y1[e] = x1[e] + t1[e] * (y1[e] * rinv * g1[e]); }
                    acc[ai][bj][m][0] = y0; acc[ai][bj][m][1] = y1;
                    u32x4 w; w.x = cvtpk(y0[0], y0[1]); w.y = cvtpk(y0[2], y0[3]); w.z = cvtpk(y1[0], y1[1]); w.w = cvtpk(y1[2], y1[3]);
                    *(u32x4*)((row < MP ? X1P + (size_t)row * DM : X1S + (size_t)(row - MP) * DM) + c8) = w;
                }
        }
        panel_row_rinv(acc, u, wr, wc, fr, fq, Pl, Sl, tid, xbuf + (size_t)(2 * 12288 + u.pm * 256) * 4, cnt + 16 * (96 + u.pm));
#pragma unroll
        for (int bj = 0; bj < 2; ++bj) {
            const int c8 = u.pn * 256 + bj * 128 + wc * 32 + 8 * fq;
            const f32x4 g0 = *(const f32x4*)(gpre1 + c8), g1 = *(const f32x4*)(gpre1 + c8 + 4);
            const f32x4 a0 = *(const f32x4*)(md1 + 1024 + c8), a1 = *(const f32x4*)(md1 + 1024 + c8 + 4);
            const f32x4 b0 = *(const f32x4*)(md1 + c8), b1 = *(const f32x4*)(md1 + c8 + 4);
#pragma unroll
            for (int ai = 0; ai < 2; ++ai)
#pragma unroll
                for (int m = 0; m < 4; ++m) {
                    const int rl = ai * 128 + wr * 64 + m * 16 + fr, row = u.pm * 256 + rl;
                    const float r1 = Sl[rl];
                    const f32x4 y0 = acc[ai][bj][m][0], y1 = acc[ai][bj][m][1];
                    float o[8];
#pragma unroll
                    for (int e = 0; e < 4; ++e) { o[e] = y0[e] * r1 * g0[e] * (1.f + a0[e]) + b0[e]; o[4 + e] = y1[e] * r1 * g1[e] * (1.f + a1[e]) + b1[e]; }
                    u32x4 w; w.x = cvtpk(o[0], o[1]); w.y = cvtpk(o[2], o[3]); w.z = cvtpk(o[4], o[5]); w.w = cvtpk(o[6], o[7]);
                    *(u32x4*)(Hn + (size_t)row * DM + c8) = w;
                }
        }
    }
};

constexpr int AT_PITCH = 144, AT_TILE = 64 * AT_PITCH;
DI void attn_tile_load(int it, int nt0, const bf16_t* K0, int k0s, const bf16_t* V0, int v0s, const bf16_t* K1, int k1s, const bf16_t* V1, int v1s, int tid, u32x4& kr, u32x4& vr) {
    const int row = tid >> 3, pc = tid & 7;
    const bf16_t* K; const bf16_t* V; int ks, vs, tt;
    if (it < nt0) { K = K0; V = V0; ks = k0s; vs = v0s; tt = it; } else { K = K1; V = V1; ks = k1s; vs = v1s; tt = it - nt0; }
    kr = *(const u32x4*)(K + (size_t)(tt * 64 + row) * ks + pc * 8);
    vr = *(const u32x4*)(V + (size_t)row * vs + tt * 64 + pc * 8);
}
DI void attn_tile_store(LAS unsigned char* kb, LAS unsigned char* vb, int tid, const u32x4& kr, const u32x4& vr, bool nat) {
    const int row = tid >> 3, pc = tid & 7;
    *(LAS u32x4*)(kb + row * AT_PITCH + pc * 16) = kr;
    if (nat) { *(LAS u32x4*)(vb + row * AT_PITCH + pc * 16) = vr; return; }
    const int grp = pc >> 1, b3 = pc & 1;
    u32x2 lo = {vr.x, vr.y}, hi = {vr.z, vr.w};
    *(LAS u32x2*)(vb + row * AT_PITCH + (16 * grp + 4 * b3) * 2) = lo;
    *(LAS u32x2*)(vb + row * AT_PITCH + (16 * grp + 8 + 4 * b3) * 2) = hi;
}

DI void attn_qk(const LAS unsigned char* kb, const bf16x8 (&qf)[4], int l32, int half, float nm, f32x16& s0, f32x16& s1) {
    bf16x8 a[8];
#pragma unroll
    for (int s = 0; s < 4; ++s) {
        a[2 * s] = *(const LAS bf16x8*)(kb + l32 * AT_PITCH + s * 32 + half * 16);
        a[2 * s + 1] = *(const LAS bf16x8*)(kb + (32 + l32) * AT_PITCH + s * 32 + half * 16);
    }
    f32x16 nmC;
#pragma unroll
    for (int i = 0; i < 16; ++i) nmC[i] = nm;
    s0 = MFMA32(a[0], qf[0], nmC); s1 = MFMA32(a[1], qf[0], nmC);
#pragma unroll
    for (int s = 1; s < 4; ++s) { s0 = MFMA32(a[2 * s], qf[s], s0); s1 = MFMA32(a[2 * s + 1], qf[s], s1); }
}
DI void attn_bias(f32x16& s0, f32x16& s1, const LAS float* bp, int half, int cs) {
#pragma unroll
    for (int i = 0; i < 16; ++i) {
        const int kc0 = 8 * (i >> 2) + (i & 3);
        const int kca = kc0 + 4 * half, kcb = kca + 32;
        const float b0 = bp[kc0], b1 = bp[kc0 + 32];
        s0[i] = ((unsigned)(kca - cs) < 16u) ? s0[i] + b0 : -1e30f;
        s1[i] = ((unsigned)(kcb - cs) < 16u) ? s1[i] + b1 : -1e30f;
    }
}
DI float attn_max(const f32x16& s0, const f32x16& s1) {
    float mx = fmaxf(s0[0], s1[0]);
#pragma unroll
    for (int i = 1; i < 16; ++i) mx = fmaxf(mx, fmaxf(s0[i], s1[i]));
    return mx;
}
DI void attn_pv(const LAS unsigned char* vb, f32x16& s0, f32x16& s1, int l32, int half, const bf16x8& ones, f32x16& o0, f32x16& o1, f32x16& lacc) {
    bf16x8 v[8];
#pragma unroll
    for (int s = 0; s < 4; ++s) {
        v[2 * s] = *(const LAS bf16x8*)(vb + l32 * AT_PITCH + (16 * s + 8 * half) * 2);
        v[2 * s + 1] = *(const LAS bf16x8*)(vb + (32 + l32) * AT_PITCH + (16 * s + 8 * half) * 2);
    }
#pragma unroll
    for (int i = 0; i < 16; ++i) { s0[i] = __builtin_amdgcn_exp2f(s0[i]); s1[i] = __builtin_amdgcn_exp2f(s1[i]); }
    bf16x8 pf[4];
    pf[0] = pack8(s0[0], s0[1], s0[2], s0[3], s0[4], s0[5], s0[6], s0[7]);
    pf[1] = pack8(s0[8], s0[9], s0[10], s0[11], s0[12], s0[13], s0[14], s0[15]);
    pf[2] = pack8(s1[0], s1[1], s1[2], s1[3], s1[4], s1[5], s1[6], s1[7]);
    pf[3] = pack8(s1[8], s1[9], s1[10], s1[11], s1[12], s1[13], s1[14], s1[15]);
#pragma unroll
    for (int s = 0; s < 4; ++s) {
        o0 = MFMA32(v[2 * s], pf[s], o0); o1 = MFMA32(v[2 * s + 1], pf[s], o1);
        lacc = MFMA32(ones, pf[s], lacc);
    }
}

DI void attn_qk32(const LAS unsigned char* kb, const bf16x8 (&qf)[4], int krow, int half, float nm, f32x16& sv) {
    f32x16 nmC;
#pragma unroll
    for (int i = 0; i < 16; ++i) nmC[i] = nm;
    const LAS unsigned char* p = kb + krow * AT_PITCH + half * 16;
    sv = MFMA32(*(const LAS bf16x8*)p, qf[0], nmC);
#pragma unroll
    for (int s = 1; s < 4; ++s) sv = MFMA32(*(const LAS bf16x8*)(p + s * 32), qf[s], sv);
}
DI void attn_bias32(f32x16& sv, const LAS float* bp, int kcb, bool rowvalid) {
#pragma unroll
    for (int i = 0; i < 16; ++i) {
        const int kc0 = 8 * (i >> 2) + (i & 3);
        const float b0 = bp[kc0];
        sv[i] = (rowvalid && (unsigned)(kcb + kc0) < 16u) ? sv[i] + b0 : -1e30f;
    }
}
DI float attn_max16(const f32x16& sv) {
    float mx = sv[0];
#pragma unroll
    for (int i = 1; i < 16; ++i) mx = fmaxf(mx, sv[i]);
    return mx;
}
DI void attn_pv32(const LAS unsigned char* vb, f32x16& sv, int l32, int half, int k0, const bf16x8& ones, f32x16& o0, f32x16& o1, f32x16& lacc) {
#pragma unroll
    for (int i = 0; i < 16; ++i) sv[i] = __builtin_amdgcn_exp2f(sv[i]);
    const bf16x8 pf0 = pack8(sv[0], sv[1], sv[2], sv[3], sv[4], sv[5], sv[6], sv[7]);
    const bf16x8 pf1 = pack8(sv[8], sv[9], sv[10], sv[11], sv[12], sv[13], sv[14], sv[15]);
#pragma unroll
    for (int s2 = 0; s2 < 2; ++s2) {
        const LAS unsigned char* p0 = vb + l32 * AT_PITCH + (k0 + 16 * s2 + 4 * half) * 2;
        const LAS unsigned char* p1 = p0 + 32 * AT_PITCH;
        const s16x4 lo0 = *(const LAS s16x4*)p0, hi0 = *(const LAS s16x4*)(p0 + 16);
        const s16x4 lo1 = *(const LAS s16x4*)p1, hi1 = *(const LAS s16x4*)(p1 + 16);
        const bf16x8 A0 = __builtin_shufflevector(lo0, hi0, 0, 1, 2, 3, 4, 5, 6, 7);
        const bf16x8 A1 = __builtin_shufflevector(lo1, hi1, 0, 1, 2, 3, 4, 5, 6, 7);
        o0 = MFMA32(A0, s2 == 0 ? pf0 : pf1, o0); o1 = MFMA32(A1, s2 == 0 ? pf0 : pf1, o1);
        lacc = MFMA32(ones, s2 == 0 ? pf0 : pf1, lacc);
    }
}

template <int MODE>
DI void attn_item(LAS unsigned char* lds, int tid,
                  const bf16_t* Q, int qstride,
                  const bf16_t* K0, int k0s, const bf16_t* V0, int v0s, int nt0,
                  const bf16_t* K1, int k1s, const bf16_t* V1, int v1s, int nt1,
                  int r0, int rs_lo, const LAS float* rpbL,
                  const bf16_t* Z, int zstride, bf16_t* O, int ostride, const WT& wt, bool usewt, unsigned* pcnt) {
    const int lane = tid & 63, w = tid >> 6, l32 = lane & 31, half = lane >> 5;
    const int np = (nt0 + nt1 + 1) >> 1;
    const int ng = w & 3, nrp = w >> 2;
    const int qc = (MODE == 1) ? 16 * ng + (l32 & 15) : 0;
    const int qrw = (MODE == 1) ? 2 * nrp + (l32 >> 4) : 0;
    const int qr = r0 + qrw;
    const int qrow = (MODE == 1) ? qrw * 64 + qc : w * 32 + l32;
    const int k0 = (ng == 0) ? 0 : (ng == 1) ? 8 : (ng == 2) ? 24 : 32;
    bf16x8 qf[4];
#pragma unroll
    for (int s = 0; s < 4; ++s) qf[s] = *(const bf16x8*)(Q + (size_t)qrow * qstride + 16 * s + 8 * half);
    f32x16 o0, o1, lacc;
#pragma unroll
    for (int i = 0; i < 16; ++i) { o0[i] = 0.f; o1[i] = 0.f; lacc[i] = 0.f; }
    float m_run = 0.f;
    const bf16x8 ones = {0x3F80, 0x3F80, 0x3F80, 0x3F80, 0x3F80, 0x3F80, 0x3F80, 0x3F80};
    const int cs = min(max(qc - 8, 0), 48);
    const int rsq = min(max(qr - 4, 0), 56);
    const int rsw_lo = min(max(r0 + 2 * nrp - 4, 0), 56), rsw_hi = min(max(r0 + 2 * nrp + 1 - 4, 0), 56) + 8;

    u32x4 eka, eva, ekb, evb;
#define AT_LOAD(pair, ka, va, kb_, vb_) do { attn_tile_load(2 * (pair), nt0, K0, k0s, V0, v0s, K1, k1s, V1, v1s, tid, ka, va); \
        attn_tile_load(2 * (pair) + 1, nt0, K0, k0s, V0, v0s, K1, k1s, V1, v1s, tid, kb_, vb_); } while (0)
#define AT_STORE(stage, pair, ka, va, kb_, vb_) do { LAS unsigned char* nb_ = lds + (stage) * 4 * AT_TILE; const bool nat_ = (MODE == 1) && (2 * (pair) >= nt0); \
        attn_tile_store(nb_, nb_ + AT_TILE, tid, ka, va, nat_); attn_tile_store(nb_ + 2 * AT_TILE, nb_ + 3 * AT_TILE, tid, kb_, vb_, nat_); } while (0)
#define AT_SLOWPATH(ip_, EXTRA) \
            mx = fmaxf(mx, __shfl_xor(mx, 32)); \
            const bool need = ((ip_) == 0) || (mx > 8.f); \
            if (__builtin_amdgcn_ballot_w64(need) != 0ull) { \
                const float delta = need ? mx : 0.f; \
                const float alpha = __builtin_amdgcn_exp2f(-delta); \
                m_run += delta; \
                _Pragma("unroll") for (int i = 0; i < 16; ++i) { EXTRA; o0[i] *= alpha; o1[i] *= alpha; lacc[i] *= alpha; } \
            }
#define AT_COMPUTE(ip_) do { \
        LAS unsigned char* base = lds + ((ip_) & 1) * 4 * AT_TILE; \
        const int ita = 2 * (ip_), itb = 2 * (ip_) + 1; \
        if (MODE == 1 && ita >= nt0) { \
            const int kra_ = rs_lo + (ita - nt0), krb_ = kra_ + 1; \
            const bool acta = (kra_ >= rsw_lo) && (kra_ < rsw_hi), actb = (krb_ >= rsw_lo) && (krb_ < rsw_hi); \
            if (acta || actb) { \
                f32x16 sa, sb; \
                _Pragma("unroll") for (int i = 0; i < 16; ++i) { sa[i] = -1e30f; sb[i] = -1e30f; } \
                float mx = -3.0e38f; \
                if (acta) { attn_qk32(base, qf, k0 + l32, half, -m_run, sa); \
                    attn_bias32(sa, rpbL + 64 + (kra_ - qr + 7) * 31 + (k0 - qc + 15) + 4 * half, k0 + 4 * half - cs, (kra_ >= rsq) && (kra_ < rsq + 8)); mx = attn_max16(sa); } \
                if (actb) { attn_qk32(base + 2 * AT_TILE, qf, k0 + l32, half, -m_run, sb); \
                    attn_bias32(sb, rpbL + 64 + (krb_ - qr + 7) * 31 + (k0 - qc + 15) + 4 * half, k0 + 4 * half - cs, (krb_ >= rsq) && (krb_ < rsq + 8)); mx = fmaxf(mx, attn_max16(sb)); } \
                AT_SLOWPATH(ip_, sa[i] -= delta; sb[i] -= delta) \
                if (acta) attn_pv32(base + AT_TILE, sa, l32, half, k0, ones, o0, o1, lacc); \
                if (actb) attn_pv32(base + 3 * AT_TILE, sb, l32, half, k0, ones, o0, o1, lacc); \
            } \
        } else { \
            f32x16 sa0, sa1, sb0, sb1; \
            attn_qk(base, qf, l32, half, -m_run, sa0, sa1); \
            attn_qk(base + 2 * AT_TILE, qf, l32, half, -m_run, sb0, sb1); \
            float mx = fmaxf(attn_max(sa0, sa1), attn_max(sb0, sb1)); \
            AT_SLOWPATH(ip_, sa0[i] -= delta; sa1[i] -= delta; sb0[i] -= delta; sb1[i] -= delta) \
            attn_pv(base + AT_TILE, sa0, sa1, l32, half, ones, o0, o1, lacc); \
            attn_pv(base + 3 * AT_TILE, sb0, sb1, l32, half, ones, o0, o1, lacc); \
        } } while (0)
    AT_LOAD(0, eka, eva, ekb, evb);
    AT_STORE(0, 0, eka, eva, ekb, evb);
    __syncthreads();
    for (int ip = 0; ip < np; ++ip) {
        if (ip + 1 < np) AT_LOAD(ip + 1, eka, eva, ekb, evb);
        AT_COMPUTE(ip);
        if (ip + 1 < np) AT_STORE((ip + 1) & 1, ip + 1, eka, eva, ekb, evb);
        __syncthreads();
    }
#undef AT_LOAD
#undef AT_STORE
#undef AT_COMPUTE
#undef AT_SLOWPATH
    const float inv = 1.f / lacc[0];
    {
        LAS float* ot = (LAS float*)lds;
#pragma unroll
        for (int dt = 0; dt < 2; ++dt)
#pragma unroll
            for (int i = 0; i < 16; ++i) ot[qrow * 65 + dt * 32 + crow(i, half)] = (dt == 0 ? o0[i] : o1[i]) * inv;
        __syncthreads();
#pragma unroll
        for (int j = 0; j < 4; ++j) {
            const int idx = tid + 512 * j, row = idx >> 3, pc = idx & 7;
            const u32x4 zz = *(const u32x4*)(Z + (size_t)row * zstride + pc * 8);
            const LAS float* sp = ot + row * 65 + pc * 8;
            u32x4 ov;
            ov.x = cvtpk(sp[0] * __uint_as_float(zz.x << 16), sp[1] * __uint_as_float(zz.x & 0xffff0000u));
            ov.y = cvtpk(sp[2] * __uint_as_float(zz.y << 16), sp[3] * __uint_as_float(zz.y & 0xffff0000u));
            ov.z = cvtpk(sp[4] * __uint_as_float(zz.z << 16), sp[5] * __uint_as_float(zz.z & 0xffff0000u));
            ov.w = cvtpk(sp[6] * __uint_as_float(zz.w << 16), sp[7] * __uint_as_float(zz.w & 0xffff0000u));
            if (usewt) wt16(wt, O + (size_t)row * ostride + pc * 8, ov); else *(u32x4*)(O + (size_t)row * ostride + pc * 8) = ov;
        }
        if (pcnt) asm volatile("s_waitcnt vmcnt(0)" ::: "memory");
        __syncthreads();
        if (pcnt && tid == 0) __hip_atomic_fetch_add(pcnt, 1u, __ATOMIC_RELAXED, __HIP_MEMORY_SCOPE_AGENT);
    }
}

DI int chain_base(int sid, int h, int dir) { return sid < 16 ? ((sid * 4 + h) * 2 + dir) * 2 : 256 + (((sid - 16) * 4 + h) * 2 + dir) * 32; }
DI int seq_rowbase(int sid) { return sid < 16 ? sid * 256 : MP + (sid - 16) * 4096; }
DI float chain_m0(const float* state_m, int sid, int h, int dir) { return sid < 16 ? 0.f : state_m[((sid - 16) * 2 + dir) * 4 + h]; }
DI float chain_m_at(const float* CH, int base, int js, float m0) {
    float m = m0;
    for (int i = 0; i < js; ++i) { const float bL = CH[(base + i) * 2], rmL = CH[(base + i) * 2 + 1]; m = bL + fmaxf(m, rmL); }
    return m;
}

DI void gate_scan_item(int sid, int h, int dir, int js, int lane, const float* G, const float* bg, float* SC, float* CH) {
    const int nc = sid < 16 ? 2 : 32, T = nc * 128, rb = seq_rowbase(sid);
    const float bi = bg[(dir * 2) * 4 + h], bff = bg[(dir * 2 + 1) * 4 + h];
    float ig[2], lf[2]; int row[2];
#pragma unroll
    for (int e = 0; e < 2; ++e) {
        const int Ppos = js * 128 + 2 * lane + e; const int t = dir ? (T - 1 - Ppos) : Ppos; row[e] = rb + t;
        ig[e] = G[(size_t)row[e] * 16 + (dir * 2) * 4 + h] + bi;
        const float fg = G[(size_t)row[e] * 16 + (dir * 2 + 1) * 4 + h] + bff;
        lf[e] = fminf(fg, 0.f) - log1pf(expf(-fabsf(fg)));
    }
    const float tot = lf[0] + lf[1];
    float x = tot;
#pragma unroll
    for (int o = 1; o < 64; o <<= 1) { const float y = __shfl_up(x, o); if (lane >= o) x += y; }
    const float excl = x - tot;
    const float b0 = excl + lf[0], b1 = excl + tot;
    const float a0 = ig[0] - b0, a1 = ig[1] - b1;
    const float lm = fmaxf(a0, a1);
    float xm = lm;
#pragma unroll
    for (int o = 1; o < 64; o <<= 1) { const float y = __shfl_up(xm, o); if (lane >= o) xm = fmaxf(xm, y); }
    float em = __shfl_up(xm, 1); if (lane == 0) em = -3.0e38f;
    const float rm0 = fmaxf(em, a0), rm1 = fmaxf(em, lm);
    *(f32x4*)(SC + ((size_t)row[0] * 8 + h * 2 + dir) * 4) = (f32x4){a0, b0, rm0, 0.f};
    *(f32x4*)(SC + ((size_t)row[1] * 8 + h * 2 + dir) * 4) = (f32x4){a1, b1, rm1, 0.f};
    if (lane == 63) { const int slot = chain_base(sid, h, dir) + js; CH[slot * 2] = b1; CH[slot * 2 + 1] = rm1; }
}

DI void qknorm_item(int row, int lane, const u32x4 (&rawqk)[2], const float* gq, const float* gk, bf16_t* Qb, bf16_t* Kb, float* out) {
    const bool sample = row >= MP;
    const int t = sample ? ((row - MP) & 4095) : 0;
    const int grow = t >> 6, gcol = t & 63;
    const int sub = lane & 7, d0 = sub * 8;
    const float pos = (float)((sub < 4) ? grow : gcol);
#pragma unroll
    for (int pass = 0; pass < 2; ++pass) {
        const u32x4 raw = rawqk[pass];
        float x[8];
        x[0] = __uint_as_float(raw.x << 16); x[1] = __uint_as_float(raw.x & 0xffff0000u);
        x[2] = __uint_as_float(raw.y << 16); x[3] = __uint_as_float(raw.y & 0xffff0000u);
        x[4] = __uint_as_float(raw.z << 16); x[5] = __uint_as_float(raw.z & 0xffff0000u);
        x[6] = __uint_as_float(raw.w << 16); x[7] = __uint_as_float(raw.w & 0xffff0000u);
        float ss = 0.f;
#pragma unroll
        for (int e = 0; e < 8; ++e) ss += x[e] * x[e];
        ss += __shfl_xor(ss, 1); ss += __shfl_xor(ss, 2); ss += __shfl_xor(ss, 4);
        const float r = rsqrtf(ss * (1.f / 64.f) + EPS);
        const float* gw = pass == 0 ? gq : gk;
        float y[8];
#pragma unroll
        for (int e = 0; e < 8; ++e) y[e] = x[e] * r * gw[d0 + e];
        if (pass == 1 && !sample && lane < 16) {
            const int hk = lane >> 3, b = row >> 8, tt = row & 255;
            float* o = out + O_GK + ((size_t)((b * 2 + hk) * 256 + tt)) * 64 + d0;
            *(f32x4*)o = (f32x4){y[0], y[1], y[2], y[3]}; *(f32x4*)(o + 4) = (f32x4){y[4], y[5], y[6], y[7]};
        }
        float z[8];
#pragma unroll
        for (int e = 0; e < 8; ++e) {
            const float partner = __shfl_xor(y[e], 2);
            if (sample) {
                const int i = (d0 + e) & 15;
                const float freq = __builtin_amdgcn_exp2f(-(float)i * (13.287712379549449f / 16.f));
                float rev = pos * freq * 0.15915494309189535f; rev -= floorf(rev);
                const float sn = __builtin_amdgcn_sinf(rev), cn = __builtin_amdgcn_cosf(rev);
                z[e] = (sub & 2) ? (partner * sn + y[e] * cn) : (y[e] * cn - partner * sn);
            } else z[e] = y[e];
        }
        if (pass == 0) {
#pragma unroll
            for (int e = 0; e < 8; ++e) z[e] *= QSCALE;
            u32x4 w; w.x = cvtpk(z[0], z[1]); w.y = cvtpk(z[2], z[3]); w.z = cvtpk(z[4], z[5]); w.w = cvtpk(z[6], z[7]);
            *(u32x4*)(Qb + (size_t)row * 512 + lane * 8) = w;
        } else if (lane < 16) {
            u32x4 w; w.x = cvtpk(z[0], z[1]); w.y = cvtpk(z[2], z[3]); w.z = cvtpk(z[4], z[5]); w.w = cvtpk(z[6], z[7]);
            *(u32x4*)(Kb + (size_t)row * 128 + lane * 8) = w;
        }
    }
}

DI void mlstm_u_item(LAS unsigned char* lds, int tid, int sid, int h, int dir, int js,
                     const float* SC, const float* CH, const float* state_m, const bf16_t* KT, const bf16_t* VT, bf16_t* U, float* Un, const WT& wtw, unsigned* ucnt) {
    const int lane = tid & 63, w = tid >> 6, l32 = lane & 31, half = lane >> 5;
    const int nc = sid < 16 ? 2 : 32, rb = seq_rowbase(sid);
    const int jt = dir ? nc - 1 - js : js, R0 = rb + jt * 128;
    const int base = chain_base(sid, h, dir), slot = base + js;
    const float Mx = CH[slot * 2 + 1];
    LAS float* wkL = (LAS float*)lds;
    if (tid < 128) wkL[tid] = expf(SC[((size_t)(R0 + tid) * 8 + h * 2 + dir) * 4] - Mx);
    const int vi = w & 3, kh = w >> 2;
    f32x16 acc0, acc1;
#pragma unroll
    for (int i = 0; i < 16; ++i) { acc0[i] = 0.f; acc1[i] = 0.f; }
    LAS unsigned char* VtL = lds + 1024; LAS unsigned char* KtL = lds + 1024 + 34816;
    {
        u32x4 rv[8];
        const int r0 = tid >> 4, pc = tid & 15;
        const bf16_t* gv = VT + (size_t)(h * 128 + r0) * MROWS + R0 + pc * 8;
        const bf16_t* gk = KT + (size_t)(h * 128 + r0) * MROWS + R0 + pc * 8;
#pragma unroll
        for (int i = 0; i < 8; ++i) rv[i] = *(const u32x4*)((i >> 2 ? gk : gv) + (size_t)(32 * (i & 3)) * MROWS);
        LAS unsigned char* lv = VtL + r0 * 272 + pc * 16;
#pragma unroll
        for (int i = 0; i < 8; ++i) *(LAS u32x4*)(lv + (i >> 2) * 34816 + (32 * (i & 3)) * 272) = rv[i];
    }
    __syncthreads();
#pragma unroll
    for (int s = 0; s < 8; ++s) {
        const int so = 16 * s + 8 * half;
        const u32x4 raw = *(const LAS u32x4*)(VtL + (vi * 32 + l32) * 272 + so * 2);
        const bf16x8 B0 = *(const LAS bf16x8*)(KtL + (kh * 64 + l32) * 272 + so * 2);
        const bf16x8 B1 = *(const LAS bf16x8*)(KtL + (kh * 64 + 32 + l32) * 272 + so * 2);
        const f32x4 wa = *(const LAS f32x4*)(wkL + so), wb = *(const LAS f32x4*)(wkL + so + 4);
        const bf16x8 A = pack8(__uint_as_float(raw.x << 16) * wa[0], __uint_as_float(raw.x & 0xffff0000u) * wa[1], __uint_as_float(raw.y << 16) * wa[2], __uint_as_float(raw.y & 0xffff0000u) * wa[3],
                               __uint_as_float(raw.z << 16) * wb[0], __uint_as_float(raw.z & 0xffff0000u) * wb[1], __uint_as_float(raw.w << 16) * wb[2], __uint_as_float(raw.w & 0xffff0000u) * wb[3]);
        acc0 = MFMA32(A, B0, acc0); acc1 = MFMA32(A, B1, acc1);
    }
    bf16_t* Uo = U + (size_t)slot * 16384;
    {
        LAS unsigned char* st = lds + 1024 + 2 * 34816 + w * 4608;
#pragma unroll
        for (int i = 0; i < 16; ++i) {
            const int v = crow(i, half);
            *(LAS bf16_t*)(st + v * 144 + l32 * 2) = f2bf(acc0[i]);
            *(LAS bf16_t*)(st + v * 144 + (32 + l32) * 2) = f2bf(acc1[i]);
        }
        asm volatile("s_waitcnt lgkmcnt(0)" ::: "memory");
#pragma unroll
        for (int j = 0; j < 4; ++j) {
            const int pidx = lane + 64 * j, row = pidx >> 3, pc = pidx & 7;
            const u32x4 val = *(const LAS u32x4*)(st + row * 144 + pc * 16);
            wt16(wtw, Uo + (vi * 32 + row) * 128 + kh * 64 + pc * 8, val);
        }
    }
    if (tid < 128) {
        float s = 0.f;
#pragma unroll
        for (int j = 0; j < 16; ++j) {
            const u32x4 raw = *(const LAS u32x4*)(KtL + tid * 272 + j * 16);
            s += __uint_as_float(raw.x << 16) * wkL[8 * j] + __uint_as_float(raw.x & 0xffff0000u) * wkL[8 * j + 1]
               + __uint_as_float(raw.y << 16) * wkL[8 * j + 2] + __uint_as_float(raw.y & 0xffff0000u) * wkL[8 * j + 3]
               + __uint_as_float(raw.z << 16) * wkL[8 * j + 4] + __uint_as_float(raw.z & 0xffff0000u) * wkL[8 * j + 5]
               + __uint_as_float(raw.w << 16) * wkL[8 * j + 6] + __uint_as_float(raw.w & 0xffff0000u) * wkL[8 * j + 7];
        }
        __hip_atomic_store(Un + slot * 128 + tid, s, __ATOMIC_RELAXED, __HIP_MEMORY_SCOPE_AGENT);
    }
    asm volatile("s_waitcnt vmcnt(0)" ::: "memory");
    __syncthreads();
    if (tid == 0 && ucnt) __hip_atomic_fetch_add(ucnt + 16 * (sid < 16 ? (sid * 4 + h) * 2 + dir : 128 + ((sid - 16) * 4 + h) * 2 + dir), 1u, __ATOMIC_RELAXED, __HIP_MEMORY_SCOPE_AGENT);
}

constexpr int ML_PITCH = 272, ML_ARR = 128 * ML_PITCH;
constexpr int ML_SCAL = 4 * ML_ARR;
DI void mlstm_out_item(LAS unsigned char* lds, int tid, int sid, int h, int jt,
                       const float* SC, const float* MJp, const float* nst, const bf16_t* Cst,
                       const bf16_t* P, const bf16_t* VT, const float* ghn, bf16_t* Yg, const WT& wtd, bool usewt, unsigned* pcnt) {
    const int lane = tid & 63, w = tid >> 6, l32 = lane & 31, half = lane >> 5;
    const int wt = w & 3, vh = w >> 2;
    const int nc = sid < 16 ? 2 : 32, rb = seq_rowbase(sid), R0 = rb + jt * 128;
    LAS unsigned char* KL = lds; LAS unsigned char* VL = lds + ML_ARR; LAS unsigned char* CL = lds + 2 * ML_ARR;
    LAS float* aL = (LAS float*)(lds + ML_SCAL);
    LAS float* nL = aL + 256;
    LAS float* ssqL = nL + 256;
    const int tl = wt * 32 + l32;
    const int qrow = R0 + tl;
    const int slot0 = chain_base(sid, h, 0) + jt, slot1 = chain_base(sid, h, 1) + (nc - 1 - jt);
    bf16x8 qf[8];
#pragma unroll
    for (int s = 0; s < 8; ++s) qf[s] = *(const bf16x8*)(P + (size_t)qrow * NP + C_QA + h * 128 + 16 * s + 8 * half);
    {
        u32x4 rk[4], rv[4], rc0[4], rc1[4];
#pragma unroll
        for (int i = 0; i < 4; ++i) {
            const int idx = tid + 512 * i, row = idx >> 4, pc = idx & 15;
            rk[i] = *(const u32x4*)(P + (size_t)(R0 + row) * NP + C_KA + h * 128 + pc * 8);
            rv[i] = *(const u32x4*)(VT + (size_t)(h * 128 + row) * MROWS + R0 + pc * 8);
            rc0[i] = *(const u32x4*)(Cst + (size_t)slot0 * 16384 + row * 128 + pc * 8);
            rc1[i] = *(const u32x4*)(Cst + (size_t)slot1 * 16384 + row * 128 + pc * 8);
        }
        float av = 0.f, nv = 0.f;
        if (tid < 256) {
            const int dir = tid >> 7, s2 = tid & 127;
            av = SC[((size_t)(R0 + s2) * 8 + h * 2 + dir) * 4];
            nv = nst[(size_t)(dir ? slot1 : slot0) * 128 + s2];
        }
#pragma unroll
        for (int i = 0; i < 4; ++i) {
            const int idx = tid + 512 * i, row = idx >> 4, pc = idx & 15;
            *(LAS u32x4*)(KL + row * ML_PITCH + pc * 16) = rk[i];
            *(LAS u32x4*)(CL + row * ML_PITCH + pc * 16) = rc0[i];
            *(LAS u32x4*)(CL + ML_ARR + row * ML_PITCH + pc * 16) = rc1[i];
            const int grp = pc >> 1, b3 = pc & 1;
            u32x2 lo = {rv[i].x, rv[i].y}, hi = {rv[i].z, rv[i].w};
            *(LAS u32x2*)(VL + row * ML_PITCH + (16 * grp + 4 * b3) * 2) = lo;
            *(LAS u32x2*)(VL + row * ML_PITCH + (16 * grp + 8 + 4 * b3) * 2) = hi;
        }
        if (tid < 256) { aL[tid] = av; nL[tid] = nv; }
    }
    __syncthreads();
    f32x16 hs0, hs1;
#pragma unroll
    for (int i = 0; i < 16; ++i) { hs0[i] = 0.f; hs1[i] = 0.f; }
#pragma unroll 1
    for (int dir = 0; dir < 2; ++dir) {
        const int js = dir ? nc - 1 - jt : jt;
        const float m = MJp[chain_base(sid, h, dir) + js];
        const f32x4 sc = *(const f32x4*)(SC + ((size_t)qrow * 8 + h * 2 + dir) * 4);
        const float mx = fmaxf(m, sc[2]);
        const float u_t = -mx, w_inter = expf(m - mx), flo = expf(-(sc[1] + mx));
        f32x16 a0, a1;
#pragma unroll
        for (int i = 0; i < 16; ++i) { a0[i] = 0.f; a1[i] = 0.f; }
        const LAS unsigned char* Cp = CL + dir * ML_ARR + (vh * 64 + l32) * ML_PITCH + 16 * half;
#pragma unroll
        for (int s = 0; s < 8; ++s) {
            const bf16x8 A0 = *(const LAS bf16x8*)(Cp + 32 * s);
            const bf16x8 A1 = *(const LAS bf16x8*)(Cp + 32 * ML_PITCH + 32 * s);
            a0 = MFMA32(A0, qf[s], a0); a1 = MFMA32(A1, qf[s], a1);
        }
#pragma unroll
        for (int i = 0; i < 16; ++i) { a0[i] *= w_inter; a1[i] *= w_inter; }
        float dq = 0.f;
#pragma unroll
        for (int s = 0; s < 8; ++s)
#pragma unroll
            for (int e = 0; e < 8; ++e) dq += bf2f((unsigned short)qf[s][e]) * nL[dir * 128 + 16 * s + 8 * half + e];
        dq += __shfl_xor(dq, 32);
        float rsum = 0.f;
        const int st_lo = dir ? wt : 0, st_hi = dir ? 3 : wt;
        for (int st = st_lo; st <= st_hi; ++st) {
            f32x16 S;
#pragma unroll
            for (int i = 0; i < 16; ++i) S[i] = 0.f;
            const LAS unsigned char* Kp = KL + (st * 32 + l32) * ML_PITCH + 16 * half;
#pragma unroll
            for (int s = 0; s < 8; ++s) { const bf16x8 A = *(const LAS bf16x8*)(Kp + 32 * s); S = MFMA32(A, qf[s], S); }
#pragma unroll
            for (int i = 0; i < 16; ++i) {
                const int sl = st * 32 + crow(i, half);
                const bool valid = dir ? (sl >= tl) : (sl <= tl);
                const float dcy = __expf(u_t + aL[dir * 128 + sl]);
                const float p = valid ? S[i] * dcy : 0.f;
                S[i] = p; rsum += p;
            }
            const bf16x8 pf0 = pack8(S[0], S[1], S[2], S[3], S[4], S[5], S[6], S[7]);
            const bf16x8 pf1 = pack8(S[8], S[9], S[10], S[11], S[12], S[13], S[14], S[15]);
            const LAS unsigned char* Vp = VL + (vh * 64 + l32) * ML_PITCH + (st * 32 + 8 * half) * 2;
            {
                const bf16x8 A0 = *(const LAS bf16x8*)(Vp), A1 = *(const LAS bf16x8*)(Vp + 32 * ML_PITCH);
                a0 = MFMA32(A0, pf0, a0); a1 = MFMA32(A1, pf0, a1);
                const bf16x8 B0 = *(const LAS bf16x8*)(Vp + 32), B1 = *(const LAS bf16x8*)(Vp + 32 * ML_PITCH + 32);
                a0 = MFMA32(B0, pf1, a0); a1 = MFMA32(B1, pf1, a1);
            }
        }
        rsum += __shfl_xor(rsum, 32);
        const float den = w_inter * dq + rsum;
        const float inv = 1.f / fmaxf(fabsf(den), flo);
#pragma unroll
        for (int i = 0; i < 16; ++i) { hs0[i] += a0[i] * inv; hs1[i] += a1[i] * inv; }
    }
    float ssq = 0.f;
#pragma unroll
    for (int i = 0; i < 16; ++i) ssq += hs0[i] * hs0[i] + hs1[i] * hs1[i];
    ssq += __shfl_xor(ssq, 32);
    if (half == 0) ssqL[w * 32 + l32] = ssq;
    __syncthreads();
    const float tot = ssq + ssqL[(w ^ 4) * 32 + l32];
    const float rn = rsqrtf(tot * (1.f / 128.f) + EPS);
    {
        LAS float* ht = (LAS float*)lds;
#pragma unroll
        for (int vt = 0; vt < 2; ++vt)
#pragma unroll
            for (int i = 0; i < 16; ++i) ht[tl * 129 + vh * 64 + vt * 32 + crow(i, half)] = (vt == 0 ? hs0[i] : hs1[i]) * rn;
        __syncthreads();
#pragma unroll
        for (int j = 0; j < 4; ++j) {
            const int idx = tid + 512 * j, row = idx >> 4, pc = idx & 15, col = h * 128 + pc * 8;
            const bf16_t* prow = P + (size_t)(R0 + row) * NP;
            const u32x4 oa = *(const u32x4*)(prow + C_OA + col), zz = *(const u32x4*)(prow + C_Z + col);
            const f32x4 g0 = *(const f32x4*)(ghn + col), g1 = *(const f32x4*)(ghn + col + 4);
            const LAS float* sp = ht + row * 129 + pc * 8;
            u32x4 ov;
            ov.x = cvtpk(sp[0] * g0[0] * sigmf(__uint_as_float(oa.x << 16)) * __uint_as_float(zz.x << 16), sp[1] * g0[1] * sigmf(__uint_as_float(oa.x & 0xffff0000u)) * __uint_as_float(zz.x & 0xffff0000u));
            ov.y = cvtpk(sp[2] * g0[2] * sigmf(__uint_as_float(oa.y << 16)) * __uint_as_float(zz.y << 16), sp[3] * g0[3] * sigmf(__uint_as_float(oa.y & 0xffff0000u)) * __uint_as_float(zz.y & 0xffff0000u));
            ov.z = cvtpk(sp[4] * g1[0] * sigmf(__uint_as_float(oa.z << 16)) * __uint_as_float(zz.z << 16), sp[5] * g1[1] * sigmf(__uint_as_float(oa.z & 0xffff0000u)) * __uint_as_float(zz.z & 0xffff0000u));
            ov.w = cvtpk(sp[6] * g1[2] * sigmf(__uint_as_float(oa.w << 16)) * __uint_as_float(zz.w << 16), sp[7] * g1[3] * sigmf(__uint_as_float(oa.w & 0xffff0000u)) * __uint_as_float(zz.w & 0xffff0000u));
            if (usewt) wt16(wtd, Yg + (size_t)(R0 + row) * DM + col, ov); else *(u32x4*)(Yg + (size_t)(R0 + row) * DM + col) = ov;
        }
    }
    if (pcnt) asm volatile("s_waitcnt vmcnt(0)" ::: "memory");
    __syncthreads();
    if (pcnt && tid == 0) __hip_atomic_fetch_add(pcnt + 16 * (R0 >> 8), 1u, __ATOMIC_RELAXED, __HIP_MEMORY_SCOPE_AGENT);
}

DI void transpose_item(const float* W, int K, int N, bf16_t* WT, LAS float* scr, int item, int lane) {
    const int nblk = (N + 31) / 32, kb = item / nblk, nb = item % nblk, k0 = 64 * kb, n0 = 32 * nb;
    const int nn = n0 + (lane & 31);
    float tv[32];
#pragma unroll
    for (int i = 0; i < 32; ++i) { const int kk = 2 * i + (lane >> 5); tv[i] = (nn < N) ? W[(size_t)(k0 + kk) * N + nn] : 0.f; }
#pragma unroll
    for (int i = 0; i < 32; ++i) { const int kk = 2 * i + (lane >> 5); scr[kk * 33 + (lane & 31)] = tv[i]; }
    asm volatile("s_waitcnt lgkmcnt(0)" ::: "memory");
    const int c = lane & 7;
#pragma unroll
    for (int j = 0; j < 4; ++j) { const int n = (lane >> 3) + 8 * j; const LAS float* s = scr + (8 * c) * 33 + n;
        u32x4 o; o.x = cvtpk(s[0 * 33], s[1 * 33]); o.y = cvtpk(s[2 * 33], s[3 * 33]); o.z = cvtpk(s[4 * 33], s[5 * 33]); o.w = cvtpk(s[6 * 33], s[7 * 33]);
        *(u32x4*)(WT + (size_t)(n0 + n) * K + k0 + 8 * c) = o; }
    asm volatile("s_waitcnt lgkmcnt(0)" ::: "memory");
}

template <int NR>
DI void prenorm_rows(const float* const (&xrow)[NR], const float* gpre, const float* const (&md)[NR], bf16_t* const (&orow)[NR], int lane) {
    f32x4 v[NR][4];
#pragma unroll
    for (int r = 0; r < NR; ++r)
#pragma unroll
        for (int j = 0; j < 4; ++j) v[r][j] = *(const f32x4*)(xrow[r] + 4 * lane + 256 * j);
#pragma unroll
    for (int r = 0; r < NR; ++r) {
        float s = 0.f;
#pragma unroll
        for (int j = 0; j < 4; ++j) s += (v[r][j].x * v[r][j].x + v[r][j].y * v[r][j].y) + (v[r][j].z * v[r][j].z + v[r][j].w * v[r][j].w);
        const float rr = rsqrtf(wave_sum(s) * (1.f / DM) + EPS);
#pragma unroll
        for (int j = 0; j < 4; ++j) {
            const int c = 4 * lane + 256 * j;
            const f32x4 g = *(const f32x4*)(gpre + c), a = *(const f32x4*)(md[r] + 1024 + c), b = *(const f32x4*)(md[r] + c);
            f32x4 o;
#pragma unroll
            for (int e = 0; e < 4; ++e) o[e] = v[r][j][e] * rr * g[e] * (1.f + a[e]) + b[e];
            u32x2 w; w.x = cvtpk(o[0], o[1]); w.y = cvtpk(o[2], o[3]);
            *(u32x2*)(orow[r] + c) = w;
        }
    }
}
template <bool NEXT, int NR, bool XBF, bool X1BF>
DI void postnorm_rows(const float* const (&xrow)[NR], const bf16_t* const (&yrow)[NR], const float* gpost, const float* const (&md0)[NR], float* const (&x1row)[NR],
                      const float* gpre, const float* const (&md1)[NR], bf16_t* const (&hrow)[NR], int lane) {
    f32x4 y[NR][4], x[NR][4];
#pragma unroll
    for (int r = 0; r < NR; ++r)
#pragma unroll
        for (int j = 0; j < 4; ++j) {
            const u32x2 raw = *(const u32x2*)(yrow[r] + 4 * lane + 256 * j);
            y[r][j] = (f32x4){__uint_as_float(raw.x << 16), __uint_as_float(raw.x & 0xffff0000u), __uint_as_float(raw.y << 16), __uint_as_float(raw.y & 0xffff0000u)};
            if (XBF) {
                const u32x2 rx = *(const u32x2*)((const bf16_t*)xrow[r] + 4 * lane + 256 * j);
                x[r][j] = (f32x4){__uint_as_float(rx.x << 16), __uint_as_float(rx.x & 0xffff0000u), __uint_as_float(rx.y << 16), __uint_as_float(rx.y & 0xffff0000u)};
            } else x[r][j] = *(const f32x4*)(xrow[r] + 4 * lane + 256 * j);
        }
#pragma unroll
    for (int r = 0; r < NR; ++r) {
        float s = 0.f;
#pragma unroll
        for (int j = 0; j < 4; ++j) s += (y[r][j].x * y[r][j].x + y[r][j].y * y[r][j].y) + (y[r][j].z * y[r][j].z + y[r][j].w * y[r][j].w);
        const float rr = rsqrtf(wave_sum(s) * (1.f / DM) + EPS);
        float s1 = 0.f;
#pragma unroll
        for (int j = 0; j < 4; ++j) {
            const int c = 4 * lane + 256 * j;
            const f32x4 g = *(const f32x4*)(gpost + c), gt = *(const f32x4*)(md0[r] + 2048 + c);
#pragma unroll
            for (int e = 0; e < 4; ++e) x[r][j][e] = x[r][j][e] + gt[e] * (y[r][j][e] * rr * g[e]);
            if (X1BF) { u32x2 wx; wx.x = cvtpk(x[r][j][0], x[r][j][1]); wx.y = cvtpk(x[r][j][2], x[r][j][3]); *(u32x2*)((bf16_t*)x1row[r] + c) = wx; }
            else *(f32x4*)(x1row[r] + c) = x[r][j];
            s1 += (x[r][j].x * x[r][j].x + x[r][j].y * x[r][j].y) + (x[r][j].z * x[r][j].z + x[r][j].w * x[r][j].w);
        }
        if (NEXT) {
            const float r1 = rsqrtf(wave_sum(s1) * (1.f / DM) + EPS);
#pragma unroll
            for (int j = 0; j < 4; ++j) {
                const int c = 4 * lane + 256 * j;
                const f32x4 g = *(const f32x4*)(gpre + c), a = *(const f32x4*)(md1[r] + 1024 + c), b = *(const f32x4*)(md1[r] + c);
                f32x4 o;
#pragma unroll
                for (int e = 0; e < 4; ++e) o[e] = x[r][j][e] * r1 * g[e] * (1.f + a[e]) + b[e];
                u32x2 w; w.x = cvtpk(o[0], o[1]); w.y = cvtpk(o[2], o[3]);
                *(u32x2*)(hrow[r] + c) = w;
            }
        }
    }
}

#define XB_TMO      128
#define XB_XCNT(j)  (256  + 64 * (j))
#define XB_XSUB(j)  (1280 + 64 * (j))
#define XB_XGEN(j)  (2304 + 64 * (j))
#define XB_TOP      3328
#define XB_TOPGEN   3392
#define XCD_BAR_WORDS 3456
#define XB_SPIN_CAP (1u << 18)
DI unsigned xb_ld(unsigned* p)              { return __hip_atomic_load(p, __ATOMIC_RELAXED, __HIP_MEMORY_SCOPE_AGENT); }
DI unsigned xb_add(unsigned* p, unsigned v) { return __hip_atomic_fetch_add(p, v, __ATOMIC_RELAXED, __HIP_MEMORY_SCOPE_AGENT); }
DI unsigned xb_xcc_id() { return (unsigned)__builtin_amdgcn_s_getreg((3 << 11) | 20) & 0xFu; }
#define XB_SPIN(cond, bar) do { unsigned _sp = 0; while (cond) { __builtin_amdgcn_s_sleep(1); \
    if ((++_sp & 255u) == 0u) { if (xb_ld(&(bar)[XB_TMO])) break; if (_sp > XB_SPIN_CAP) { atomicAdd(&(bar)[XB_TMO], 1u); break; } } } } while (0)
struct XcdBarrier { unsigned* bar; unsigned x; volatile LAS unsigned* st; };
DI XcdBarrier xcd_barrier_post(unsigned* bar, volatile LAS unsigned* st) {
    XcdBarrier b; b.bar = bar; b.x = xb_xcc_id(); b.st = st;
    if (threadIdx.x == 0) (void)xb_add(&bar[XB_XCNT(b.x)], 1u);
    return b;
}
DI void xcd_barrier_complete(unsigned* bar, unsigned x, unsigned& nloc, unsigned& nx) {
    const unsigned G = gridDim.x * gridDim.y * gridDim.z;
    unsigned sum, cnt, mine, sp = 0u;
    for (;;) {
        sum = 0u; cnt = 0u; mine = 0u;
#pragma unroll
        for (unsigned j = 0; j < 16; ++j) { const unsigned c = xb_ld(&bar[XB_XCNT(j)]); sum += c; cnt += (c > 0u) ? 1u : 0u; mine = (j == x) ? c : mine; }
        if (sum == G) break;
        __builtin_amdgcn_s_sleep(1);
        if ((++sp & 255u) == 0u) { if (xb_ld(&bar[XB_TMO])) break; if (sp > XB_SPIN_CAP) { atomicAdd(&bar[XB_TMO], 1u); break; } }
    }
    nloc = mine > 0u ? mine : 1u; nx = cnt > 0u ? cnt : 1u;
}
DI void xcd_barrier(const XcdBarrier& b) {
    asm volatile("s_waitcnt vmcnt(0)" ::: "memory");
    __syncthreads();
    if (threadIdx.x == 0) {
        unsigned* bar = b.bar;
        __builtin_amdgcn_s_waitcnt(0);
        unsigned nloc = b.st[0], nx = b.st[1];
        if (nloc == 0u) { xcd_barrier_complete(bar, b.x, nloc, nx); b.st[0] = nloc; b.st[1] = nx; }
        const unsigned old = xb_add(&bar[XB_XSUB(b.x)], 1u);
        const unsigned gen = old / nloc;
        if (old + 1u == (gen + 1u) * nloc) {
            __builtin_amdgcn_fence(__ATOMIC_RELEASE, "agent");
            asm volatile("s_waitcnt vmcnt(0)" ::: "memory");
            const unsigned og = xb_add(&bar[XB_TOP], 1u);
            const unsigned tg = og / nx;
            if (og + 1u == (tg + 1u) * nx) xb_add(&bar[XB_TOPGEN], 1u);
            else XB_SPIN(xb_ld(&bar[XB_TOPGEN]) == tg, bar);
            __builtin_amdgcn_fence(__ATOMIC_ACQUIRE, "agent");
            xb_add(&bar[XB_XGEN(b.x)], 1u);
            asm volatile("s_waitcnt vmcnt(0)" ::: "memory");
        } else {
            XB_SPIN(xb_ld(&bar[XB_XGEN(b.x)]) == gen, bar);
            __builtin_amdgcn_fence(__ATOMIC_ACQUIRE, "agent");
            asm volatile("s_waitcnt vmcnt(0)" ::: "memory");
        }
    }
    __syncthreads();
}

__global__ void __launch_bounds__(512, 2) fwd_megakernel(Params p) {
    extern __shared__ __attribute__((aligned(16))) unsigned char lds_raw[];
    LAS unsigned char* lds = (LAS unsigned char*)lds_raw;
    cg::grid_group grid = cg::this_grid();
    const int tid = threadIdx.x;
    const int G = gridDim.x, blk = blockIdx.x;
#define lane ((int)(threadIdx.x & 63u))
#define wave (__builtin_amdgcn_readfirstlane((int)(threadIdx.x >> 6)))
#define gw (blk * 8 + wave)
    const int NGW = G * 8;
    unsigned char* ws = p.ws;
    float* out = p.out;
    const float* x_prompt = p.in[0]; const float* x_sample = p.in[1];
    const float* st_C = p.in[2]; const float* st_n = p.in[3]; const float* st_m = p.in[4];
    const float* gpre = p.in[13]; const float* gpost = p.in[14];
    float* MOD = (float*)(ws + WS_MOD); float* Gt = (float*)(ws + WS_G); float* SC = (float*)(ws + WS_SC); float* CH = (float*)(ws + WS_CH);
    float* UN = (float*)(ws + WS_UN); float* NST = (float*)(ws + WS_NST); float* MJ = (float*)(ws + WS_MJ);
    bf16_t* CK = (bf16_t*)(ws + WS_CK); bf16_t* CVT = (bf16_t*)(ws + WS_CVT); bf16_t* NK = (bf16_t*)(ws + WS_NK); bf16_t* NVT = (bf16_t*)(ws + WS_NVT);
    bf16_t* WINE = (bf16_t*)(ws + WS_WINE); bf16_t* WOUTE = (bf16_t*)(ws + WS_WOUTE); bf16_t* WINO = (bf16_t*)(ws + WS_WINO); bf16_t* WOUTO = (bf16_t*)(ws + WS_WOUTO);
    bf16_t* H = (bf16_t*)(ws + WS_H); bf16_t* KT = (bf16_t*)(ws + WS_KT); bf16_t* VT = (bf16_t*)(ws + WS_VT); bf16_t* Y2 = (bf16_t*)(ws + WS_Y2);
    bf16_t* P = (bf16_t*)(ws + WS_P); bf16_t* CST = (bf16_t*)(ws + WS_CST); bf16_t* QB = (bf16_t*)(ws + WS_QB); bf16_t* KB = (bf16_t*)(ws + WS_KB);
    bf16_t* VBT = (bf16_t*)(ws + WS_VBT); bf16_t* U = (bf16_t*)(ws + WS_U); bf16_t* VCT = (bf16_t*)(ws + WS_VCT);
    bf16_t* X1P = (bf16_t*)(ws + WS_X1P); bf16_t* X1S = (bf16_t*)(ws + WS_X1S);
#define X1ROW(r) ((r) < MP ? X1P + (size_t)(r) * DM : X1S + (size_t)((r) - MP) * DM)
    const int lo = p.ph_lo, hi = p.ph_hi;
    volatile LAS unsigned* bst = (volatile LAS unsigned*)(lds + LDS_BYTES - 64);
    if (tid == 0) { bst[0] = 0u; bst[1] = 0u; }
    __syncthreads();
    XcdBarrier xbar = xcd_barrier_post((unsigned*)(ws + WS_BAR), bst);
    if (p.coop == 2) grid.sync();
#define IN(k) (lo <= (k) && (k) < hi)
#define SEAM(k) do { if (p.coop && IN(k) && IN((k) + 1)) { for (int sr_ = 0; sr_ < SYNC_REP; ++sr_) xcd_barrier(xbar); } } while (0)
#define REPEAT(k) _Pragma("unroll 1") for (int rep_ = 0; rep_ < 1 + ((REP_MASK >> (k)) & 1); ++rep_)

    if (IN(0)) REPEAT(0) {
        for (int mb = blk; mb < 192; mb += G) {
            const int l = mb / 96, j0 = (mb % 96) * 32;
            LAS float* sL = (LAS float*)lds;
            LAS float* red = sL + 3072;
            for (int i = tid; i < 3072; i += 512) { const int v = i >> 10, k = i & 1023; const float cv = (v == 0) ? p.in[10][k] : p.in[9][(v - 1) * 1024 + k]; sL[i] = siluf(cv); }
            __syncthreads();
            const int col = tid & 31, kg = tid >> 5;
            float a0 = 0.f, a1 = 0.f, a2 = 0.f;
            const float* wp = p.in[11] + ((size_t)l * 1024 + kg * 64) * 3072 + j0 + col;
#pragma unroll
            for (int i0 = 0; i0 < 64; i0 += 32) {
                float wv[32];
#pragma unroll
                for (int i = 0; i < 32; ++i) wv[i] = wp[(size_t)(i0 + i) * 3072];
#pragma unroll
                for (int i = 0; i < 32; ++i) { const int k = kg * 64 + i0 + i; a0 += sL[k] * wv[i]; a1 += sL[1024 + k] * wv[i]; a2 += sL[2048 + k] * wv[i]; }
            }
            red[(0 * 16 + kg) * 32 + col] = a0; red[(1 * 16 + kg) * 32 + col] = a1; red[(2 * 16 + kg) * 32 + col] = a2;
            __syncthreads();
            if (tid < 96) { const int v = tid >> 5, c = tid & 31; float s = p.in[12][l * 3072 + j0 + c];
                for (int k2 = 0; k2 < 16; ++k2) s += red[(v * 16 + k2) * 32 + c];
                __hip_atomic_store(MOD + (l * 3 + v) * 3072 + j0 + c, s, __ATOMIC_RELAXED, __HIP_MEMORY_SCOPE_AGENT); }
            asm volatile("s_waitcnt vmcnt(0)" ::: "memory");
            __syncthreads();
            if (tid == 0) __hip_atomic_fetch_add((unsigned*)(ws + 16384) + 16 * 160, 1u, __ATOMIC_RELAXED, __HIP_MEMORY_SCOPE_AGENT);
        }
        {
            LAS float* scr = (LAS float*)(lds + wave * 16384);
            const int I_E = 16 * 121, I_O = 16 * 32;
            for (int it = gw; it < I_E + I_O; it += NGW) {
                if (it < I_E) transpose_item(p.in[15], 1024, 3856, WINE, scr, it, lane);
                else transpose_item(p.in[20], 1024, 1024, WOUTE, scr, it - I_E, lane);
            }
        }
        {
            const int gt = blk * 512 + tid, NT = G * 512;
            for (int i = gt; i < 65536; i += NT) {
                CK[i] = f2bf(p.in[5][i]);
                const int d = i & 63, s = (i >> 6) & 255, bh = i >> 14;
                CVT[(bh * 64 + d) * 256 + s] = f2bf(p.in[6][i]);
            }
        }
        __syncthreads();
        if (tid == 0) {
            unsigned* c = (unsigned*)(ws + 16384) + 16 * 160; unsigned spins = 0;
            while (__hip_atomic_load(c, __ATOMIC_RELAXED, __HIP_MEMORY_SCOPE_AGENT) < 192u) { __builtin_amdgcn_s_sleep(1); if (++spins > (1u << 22)) break; }
            __builtin_amdgcn_fence(__ATOMIC_ACQUIRE, "agent");
            asm volatile("s_waitcnt vmcnt(0)" ::: "memory");
        }
        __syncthreads();
    }
    if (IN(1)) REPEAT(1) {
        for (int row0 = gw; row0 < MROWS; row0 += 2 * NGW) {
            const float* xr[2]; const float* md[2]; bf16_t* orow[2];
#pragma unroll
            for (int r = 0; r < 2; ++r) {
                const int row = min(row0 + r * NGW, MROWS - 1);
                const int v = row < MP ? 0 : 1 + ((row - MP) >> 12);
                xr[r] = row < MP ? x_prompt + (size_t)row * DM : x_sample + (size_t)(row - MP) * DM;
                md[r] = MOD + (0 * 3 + v) * 3072; orow[r] = H + (size_t)row * DM;
            }
            prenorm_rows<2>(xr, gpre, md, orow, lane);
        }
    }
    SEAM(1);
    if (IN(2)) REPEAT(2) {
        pg8::Gemm g{H, WINE, MROWS, 4096, 1024}; pg8::StaticOrder S; S.init(MROWS, 4096, G, blk);
        EpiEvenIn E{P, KT, VT, VBT, Gt, out};
        pg8::gemm_phase(lds, g, S, E);
    }
    SEAM(2);
    if (IN(3)) REPEAT(3) {
        for (int it = gw; it < 768; it += NGW) {
            int sid, h, dir, js;
            if (it < 256) { js = it & 1; dir = (it >> 1) & 1; h = (it >> 2) & 3; sid = it >> 4; }
            else { const int r = it - 256; js = r & 31; dir = (r >> 5) & 1; h = (r >> 6) & 3; sid = 16 + (r >> 8); }
            gate_scan_item(sid, h, dir, js, lane, Gt, p.in[16], SC, CH);
        }
        for (int row0 = gw; row0 < MROWS; row0 += 2 * NGW) {
            const int row1 = row0 + NGW; const bool two = row1 < MROWS;
            u32x4 ra[2], rb[2];
            ra[0] = *(const u32x4*)(P + (size_t)row0 * NP + C_QB + lane * 8); ra[1] = *(const u32x4*)(P + (size_t)row0 * NP + C_KB + lane * 8);
            if (two) { rb[0] = *(const u32x4*)(P + (size_t)row1 * NP + C_QB + lane * 8); rb[1] = *(const u32x4*)(P + (size_t)row1 * NP + C_KB + lane * 8); }
            qknorm_item(row0, lane, ra, p.in[18], p.in[19], QB, KB, out);
            if (two) qknorm_item(row1, lane, rb, p.in[18], p.in[19], QB, KB, out);
        }
    }
    SEAM(3);
    const bool gate67 = (G >= (MROWS / 256) * (DM / 256)) && p.coop && IN(4) && IN(5) && IN(6) && IN(7);
    unsigned* pcntA = (unsigned*)(ws + 65536);
    const bool gate45 = (G == 256) && p.coop && IN(4) && IN(5) && IN(6);
    unsigned* ucnt = (unsigned*)(ws + 49152);
    if (IN(4)) REPEAT(4) {
        const WT wtw4 = mk_wt(ws, (unsigned)WS_END);
        const int NIT = 256 + 768 + 128;
        for (int it = blk; it < NIT; it += G) {
            if (it < 256) {
                const int xcd = it & 7, jj = it >> 3, b = xcd >> 2, kv = (xcd >> 1) & 1, idx = (xcd & 1) * 32 + jj, qh = kv * 4 + (idx & 3), qblk = idx >> 2;
                const int rowq = MP + b * 4096 + qblk * 256;
                attn_item<0>(lds, tid, QB + (size_t)rowq * 512 + qh * 64, 512,
                             CK + (size_t)((b * 2 + kv) * 256) * 64, 64, CVT + (size_t)((b * 2 + kv) * 64) * 256, 256, 4,
                             KB + (size_t)(MP + b * 4096) * 128 + kv * 64, 128, VBT + (size_t)(kv * 64) * MROWS + MP + b * 4096, MROWS, 64,
                             0, 0, nullptr,
                             P + (size_t)rowq * NP + C_Z + 512 + qh * 64, NP, H + (size_t)rowq * DM + 512 + qh * 64, DM, wtw4, gate67, gate67 ? pcntA + 16 * (rowq >> 8) : nullptr);
            } else if (it < 256 + 768) {
                const int r0 = it - 256; int sid, h, dir, js;
                if (r0 < 256) { js = r0 & 1; dir = (r0 >> 1) & 1; h = (r0 >> 2) & 3; sid = r0 >> 4; }
                else { const int r = r0 - 256; js = r & 31; dir = (r >> 5) & 1; h = (r >> 6) & 3; sid = 16 + (r >> 8); }
                mlstm_u_item(lds, tid, sid, h, dir, js, SC, CH, st_m, KT, VT, U, UN, wtw4, gate45 ? ucnt : nullptr);
            } else {
                const int r = it - 1024, qh = r & 7, b = r >> 3, kv = qh >> 2;
                const int rowq = b * 256;
                attn_item<0>(lds, tid, QB + (size_t)rowq * 512 + qh * 64, 512,
                             KB, 128, VBT, MROWS, 0,
                             KB + (size_t)rowq * 128 + kv * 64, 128, VBT + (size_t)(kv * 64) * MROWS + rowq, MROWS, 4,
                             0, 0, nullptr,
                             P + (size_t)rowq * NP + C_Z + 512 + qh * 64, NP, H + (size_t)rowq * DM + 512 + qh * 64, DM, wtw4, gate67, gate67 ? pcntA + 16 * (rowq >> 8) : nullptr);
            }
        }
    }
    if (!gate45) SEAM(4);
    const bool gate56 = (G == 256) && p.coop && IN(5) && IN(6);
    unsigned* chcnt = (unsigned*)(ws + 32768);
    if (IN(5)) REPEAT(5) {
        const WT wtw = mk_wt(ws, (unsigned)WS_END);
        const int NT = G * 512;
        const int nS = 16 * 2048, nP = 128 * 2048;
        const int perS = (nS + G - 1) / G;
        const int nvb = gate56 ? 2 : 1;
        const int sblk = gate56 ? blk - 128 : blk;
        if (!gate56 || blk >= 128) {
            for (int ps = 0; ps < 2; ++ps) {
                const int pass = 1 - ps;
                if (gate45) {
                    if (tid == 0) {
                        unsigned spins = 0; bool ok = false;
                        while (!ok) {
                            ok = true;
                            for (int vbi = 0; vbi < 2; ++vbi) {
                                const int vb = sblk + 128 * vbi;
                                if (pass == 1) {
                                    ok = ok && __hip_atomic_load(ucnt + 16 * (vb >> 2), __ATOMIC_RELAXED, __HIP_MEMORY_SCOPE_AGENT) >= 2u
                                            && __hip_atomic_load(ucnt + 16 * ((vb >> 2) + 64), __ATOMIC_RELAXED, __HIP_MEMORY_SCOPE_AGENT) >= 2u;
                                    if (vb < 36) for (int q = 0; q < 4; ++q) { const int c = vb * 4 + q; ok = ok && __hip_atomic_load(ucnt + 16 * c, __ATOMIC_RELAXED, __HIP_MEMORY_SCOPE_AGENT) >= (c < 128 ? 2u : 32u); }
                                } else ok = ok && __hip_atomic_load(ucnt + 16 * (128 + (vb >> 4)), __ATOMIC_RELAXED, __HIP_MEMORY_SCOPE_AGENT) >= 32u;
                            }
                            if (!ok) { __builtin_amdgcn_s_sleep(1); if (++spins > (1u << 22)) break; }
                        }
                        __builtin_amdgcn_fence(__ATOMIC_ACQUIRE, "agent");
                        asm volatile("s_waitcnt vmcnt(0)" ::: "memory");
                    }
                    __syncthreads();
                }
                for (int vbi = 0; vbi < nvb; ++vbi) {
                    const int vb = sblk + 128 * vbi;
                    int i0, i1, st;
                    if (pass == 1) { i0 = vb * 512 + tid; i1 = nP; st = NT; }
                    else if (gate56) { const bool on = (vbi == 0) && (tid < 256); i0 = on ? (sblk + 128 * (tid >> 7)) * 128 + (tid & 127) : 0; i1 = on ? i0 + 1 : 0; st = 1; }
                    else { i0 = vb * perS + tid; i1 = min((vb + 1) * perS, nS); st = 512; }
                    for (int idx0 = i0; idx0 < i1; idx0 += st) {
            const int idx = pass == 0 ? nP + idx0 : idx0;
            const int chain = idx >> 11, e8 = (idx & 2047) * 8;
            int sid, h, dir;
            if (chain < 128) { dir = chain & 1; h = (chain >> 1) & 3; sid = chain >> 3; } else { const int r = chain - 128; dir = r & 1; h = (r >> 1) & 3; sid = 16 + (r >> 3); }
            const int nc = sid < 16 ? 2 : 32, base = chain_base(sid, h, dir);
            float cur[8];
            if (sid < 16) {
#pragma unroll
                for (int e = 0; e < 8; ++e) cur[e] = 0.f;
            } else {
                const float* c0 = st_C + ((size_t)(((sid - 16) * 2 + dir) * 4 + h)) * 16384 + e8;
                const f32x4 a = *(const f32x4*)c0, b = *(const f32x4*)(c0 + 4);
                cur[0] = a[0]; cur[1] = a[1]; cur[2] = a[2]; cur[3] = a[3]; cur[4] = b[0]; cur[5] = b[1]; cur[6] = b[2]; cur[7] = b[3];
            }
            float m = chain_m0(st_m, sid, h, dir);
            const bf16_t* __restrict__ Ub = U + (size_t)base * 16384 + e8;
            bf16_t* __restrict__ Cb = CST + (size_t)base * 16384 + e8;
            for (int js0 = 0; js0 < nc; js0 += 8) {
                u32x4 raw[8];
#pragma unroll
                for (int j = 0; j < 8; ++j) if (js0 + j < nc) raw[j] = *(const u32x4*)(Ub + (size_t)(js0 + j) * 16384);
#pragma unroll
                for (int j = 0; j < 8; ++j) if (js0 + j < nc) {
                    const int js = js0 + j;
                    const float bL = CH[(base + js) * 2], rmL = CH[(base + js) * 2 + 1];
                    const float Mx = fmaxf(m, rmL), a = expf(m - Mx), f = expf(rmL - Mx);
                    if (e8 == 0) __hip_atomic_store(MJ + base + js, m, __ATOMIC_RELAXED, __HIP_MEMORY_SCOPE_AGENT);
                    u32x4 wv; wv.x = cvtpk(cur[0], cur[1]); wv.y = cvtpk(cur[2], cur[3]); wv.z = cvtpk(cur[4], cur[5]); wv.w = cvtpk(cur[6], cur[7]);
                    wt16(wtw, Cb + (size_t)js * 16384, wv);
                    cur[0] = a * cur[0] + f * __uint_as_float(raw[j].x << 16); cur[1] = a * cur[1] + f * __uint_as_float(raw[j].x & 0xffff0000u);
                    cur[2] = a * cur[2] + f * __uint_as_float(raw[j].y << 16); cur[3] = a * cur[3] + f * __uint_as_float(raw[j].y & 0xffff0000u);
                    cur[4] = a * cur[4] + f * __uint_as_float(raw[j].z << 16); cur[5] = a * cur[5] + f * __uint_as_float(raw[j].z & 0xffff0000u);
                    cur[6] = a * cur[6] + f * __uint_as_float(raw[j].w << 16); cur[7] = a * cur[7] + f * __uint_as_float(raw[j].w & 0xffff0000u);
                    m = bL + Mx;
                }
            }
            if (sid < 16) {
                float* o = out + O_C + ((size_t)((sid * 2 + dir) * 4 + h)) * 16384 + e8;
                *(f32x4*)o = (f32x4){cur[0], cur[1], cur[2], cur[3]}; *(f32x4*)(o + 4) = (f32x4){cur[4], cur[5], cur[6], cur[7]};
            }
                            }
                }
                if (pass == 1) {
                    for (int vbi = 0; vbi < nvb; ++vbi)
                    for (int idx = (sblk + 128 * vbi) * 512 + tid; idx < 144 * 128; idx += NT) {
            const int chain = idx >> 7, k = idx & 127;
            int sid, h, dir;
            if (chain < 128) { dir = chain & 1; h = (chain >> 1) & 3; sid = chain >> 3; } else { const int r = chain - 128; dir = r & 1; h = (r >> 1) & 3; sid = 16 + (r >> 3); }
            const int nc = sid < 16 ? 2 : 32, base = chain_base(sid, h, dir);
            float cur = sid < 16 ? 0.f : st_n[(((sid - 16) * 2 + dir) * 4 + h) * 128 + k];
            float m = chain_m0(st_m, sid, h, dir);
            for (int js0 = 0; js0 < nc; js0 += 8) {
                float un[8];
#pragma unroll
                for (int j = 0; j < 8; ++j) if (js0 + j < nc) un[j] = UN[(size_t)(base + js0 + j) * 128 + k];
#pragma unroll
                for (int j = 0; j < 8; ++j) if (js0 + j < nc) {
                    const int js = js0 + j;
                    const float bL = CH[(base + js) * 2], rmL = CH[(base + js) * 2 + 1];
                    const float Mx = fmaxf(m, rmL), a = expf(m - Mx), f = expf(rmL - Mx);
                    __hip_atomic_store(NST + (size_t)(base + js) * 128 + k, cur, __ATOMIC_RELAXED, __HIP_MEMORY_SCOPE_AGENT);
                    cur = a * cur + f * un[j];
                    m = bL + Mx;
                }
            }
            if (sid < 16) {
                out[O_N + ((size_t)((sid * 2 + dir) * 4 + h)) * 128 + k] = cur;
                if (k == 0) out[O_M + (sid * 2 + dir) * 4 + h] = m;
            }
                            }
                }
                if (gate56) {
                    asm volatile("s_waitcnt vmcnt(0)" ::: "memory");
                    __syncthreads();
                    if (tid == 0) {
                        for (int vbi = 0; vbi < 2; ++vbi) {
                            const int vb = sblk + 128 * vbi;
                            if (pass == 1) {
                                __hip_atomic_fetch_add(chcnt + 16 * (vb >> 2), 1u, __ATOMIC_RELAXED, __HIP_MEMORY_SCOPE_AGENT);
                                __hip_atomic_fetch_add(chcnt + 16 * ((vb >> 2) + 64), 1u, __ATOMIC_RELAXED, __HIP_MEMORY_SCOPE_AGENT);
                                if (vb < 36) for (int q = 0; q < 4; ++q) __hip_atomic_fetch_add(chcnt + 16 * (vb * 4 + q), 1u, __ATOMIC_RELAXED, __HIP_MEMORY_SCOPE_AGENT);
                            } else {
                                __hip_atomic_fetch_add(chcnt + 16 * (128 + (vb >> 4)), 1u, __ATOMIC_RELAXED, __HIP_MEMORY_SCOPE_AGENT);
                            }
                        }
                    }
                }
            }
        } else {
            const int r = blk, jt = r & 1, h = (r >> 1) & 3, sid = r >> 3;
            if (tid == 0) {
                const int c0 = (sid * 4 + h) * 2; unsigned spins = 0;
                while (__hip_atomic_load(chcnt + 16 * c0, __ATOMIC_RELAXED, __HIP_MEMORY_SCOPE_AGENT) < 5u ||
                       __hip_atomic_load(chcnt + 16 * (c0 + 1), __ATOMIC_RELAXED, __HIP_MEMORY_SCOPE_AGENT) < 5u) { __builtin_amdgcn_s_sleep(1); if (++spins > (1u << 22)) break; }
                __builtin_amdgcn_fence(__ATOMIC_ACQUIRE, "agent");
                asm volatile("s_waitcnt vmcnt(0)" ::: "memory");
            }
            __syncthreads();
            mlstm_out_item(lds, tid, sid, h, jt, SC, MJ, NST, CST, P, VT, p.in[17], H, wtw, gate67, gate67 ? pcntA : nullptr);
        }
    }
    if (!gate56) SEAM(5);
    if (IN(6)) REPEAT(6) {
        const WT wtw = mk_wt(ws, (unsigned)WS_END);
        for (int it = blk; it < (gate56 ? 256 : 384); it += G) {
            int sid, h, jt;
            if (it < 256) { jt = it & 31; h = (it >> 5) & 3; sid = 16 + (it >> 7); }
            else { const int r = it - 256; jt = r & 1; h = (r >> 1) & 3; sid = r >> 3; }
            if (gate56) {
                if (tid == 0) {
                    const int c0 = 128 + ((sid - 16) * 4 + h) * 2; unsigned spins = 0;
                    while (__hip_atomic_load(chcnt + 16 * c0, __ATOMIC_RELAXED, __HIP_MEMORY_SCOPE_AGENT) < 17u ||
                           __hip_atomic_load(chcnt + 16 * (c0 + 1), __ATOMIC_RELAXED, __HIP_MEMORY_SCOPE_AGENT) < 17u) { __builtin_amdgcn_s_sleep(1); if (++spins > (1u << 22)) break; }
                    __builtin_amdgcn_fence(__ATOMIC_ACQUIRE, "agent");
                    asm volatile("s_waitcnt vmcnt(0)" ::: "memory");
                }
                __syncthreads();
            }
            mlstm_out_item(lds, tid, sid, h, jt, SC, MJ, NST, CST, P, VT, p.in[17], H, wtw, gate67, gate67 ? pcntA : nullptr);
        }
    }
    if (!gate67) SEAM(6);
    const bool fuse_mid = (G >= (MROWS / 256) * (DM / 256));
    if (IN(7)) REPEAT(7) {
        pg8::Gemm g{H, WOUTE, MROWS, 1024, 1024}; pg8::StaticOrder S; S.init(MROWS, 1024, G, blk);
        if (fuse_mid) {
            if (gate67) {
                pg8::Unit u0;
                if (S.next(0, u0)) {
                    if (tid == 0) {
                        unsigned spins = 0;
                        while (__hip_atomic_load(pcntA + 16 * u0.pm, __ATOMIC_RELAXED, __HIP_MEMORY_SCOPE_AGENT) < 16u) { __builtin_amdgcn_s_sleep(1); if (++spins > (1u << 22)) break; }
                        __builtin_amdgcn_fence(__ATOMIC_ACQUIRE, "agent");
                        asm volatile("s_waitcnt vmcnt(0)" ::: "memory");
                    }
                }
                __syncthreads();
            }
            EpiMid E{x_prompt, x_sample, MOD, gpost, gpre + DM, X1P, X1S, H, (float*)(ws + WS_G), (unsigned*)(ws + 16384)};
            pg8::gemm_phase(lds, g, S, E);
        } else {
            EpiPlain E{Y2, DM};
            pg8::gemm_phase(lds, g, S, E);
        }
        {
            const int nunits = (MROWS / 256) * (DM / 256);
            const bool some_idle = G > nunits;
            if (!some_idle || blk >= nunits) {
                const int nw = some_idle ? G - nunits : G, ib = some_idle ? blk - nunits : blk;
                LAS float* scr = (LAS float*)(lds + wave * 16384);
                const int I_C = 16 * 128, I_O = 16 * 32;
                for (int it = ib * 8 + wave; it < I_C + I_O; it += nw * 8) {
                    if (it < I_C) transpose_item(p.in[21], 1024, 4096, WINO, scr, it, lane);
                    else transpose_item(p.in[23], 1024, 1024, WOUTO, scr, it - I_C, lane);
                }
                const int NT = nw * 512;
                for (int i0 = ib * 512 + tid; i0 < 524288; i0 += 4 * NT) {
                    float ka[4], va[4];
#pragma unroll
                    for (int k = 0; k < 4; ++k) { const int i = i0 + k * NT; if (i < 524288) { ka[k] = p.in[7][i]; va[k] = p.in[8][i]; } }
#pragma unroll
                    for (int k = 0; k < 4; ++k) { const int i = i0 + k * NT; if (i < 524288) {
                        NK[i] = f2bf(ka[k]);
                        const int d = i & 63, s2 = (i >> 6) & 255, bh = i >> 14;
                        NVT[(bh * 64 + d) * 256 + s2] = f2bf(va[k]); } }
                }
            }
        }
    }
    SEAM(7);
    if (!fuse_mid) {
    if (IN(8)) REPEAT(8) {
        for (int row0 = gw; row0 < MROWS; row0 += 2 * NGW) {
            const float* xr[2]; const bf16_t* yr[2]; const float* md0[2]; const float* md1[2]; float* x1r[2]; bf16_t* hr[2];
#pragma unroll
            for (int r = 0; r < 2; ++r) {
                const int row = min(row0 + r * NGW, MROWS - 1);
                const int v = row < MP ? 0 : 1 + ((row - MP) >> 12);
                xr[r] = row < MP ? x_prompt + (size_t)row * DM : x_sample + (size_t)(row - MP) * DM;
                yr[r] = Y2 + (size_t)row * DM; md0[r] = MOD + (0 * 3 + v) * 3072; md1[r] = MOD + (1 * 3 + v) * 3072;
                x1r[r] = (float*)X1ROW(row); hr[r] = H + (size_t)row * DM;
            }
            postnorm_rows<true, 2, false, true>(xr, yr, gpost, md0, x1r, gpre + DM, md1, hr, lane);
        }
    }
    SEAM(8);
    }
    if (IN(9)) REPEAT(9) {
        pg8::Gemm g{H, WINO, MROWS, 4096, 1024}; pg8::StaticOrder S; S.init(MROWS, 4096, G, blk);
        EpiOddIn E{P, VCT, out};
        pg8::gemm_phase(lds, g, S, E);
    }
    SEAM(9);
    const bool gate1011 = (G >= (MROWS / 256) * (DM / 256)) && p.coop && IN(10) && IN(11);
    unsigned* pcntB = (unsigned*)(ws + 62464);
    if (IN(10)) REPEAT(10) {
        const WT wtw10 = mk_wt(ws, (unsigned)WS_END);
        LAS float* rpbL = (LAS float*)(lds + 8 * AT_TILE);
        for (int it = blk; it < 512 + 256; it += G) {
            if (it < 512) {
                const int xcd = it & 7, jj = (it >> 3) & 31, b = it >> 8, h = 2 * xcd + (jj >> 4), rblk = jj & 15;
                for (int i = tid; i < 640; i += 512) { const int j = i - 64; rpbL[i] = (j >= 0 && j < 465) ? p.in[22][h * 465 + j] * LOG2E : 0.f; }
                const int r0 = rblk * 4;
                const int rs_lo = min(max(r0 - 4, 0), 56), rs_hi = min(max(r0 + 3 - 4, 0), 56) + 7;
                const int rowq = MP + b * 4096 + r0 * 64, rowk = MP + b * 4096 + rs_lo * 64;
                attn_item<1>(lds, tid, P + (size_t)rowq * NP + h * 64, NP,
                             NK + (size_t)((b * 16 + h) * 256) * 64, 64, NVT + (size_t)((b * 16 + h) * 64) * 256, 256, 4,
                             P + (size_t)rowk * NP + 1024 + h * 64, NP, VCT + (size_t)(h * 64) * MROWS + rowk, MROWS, rs_hi - rs_lo + 1,
                             r0, rs_lo, rpbL,
                             P + (size_t)rowq * NP + 3072 + h * 64, NP, H + (size_t)rowq * DM + h * 64, DM, wtw10, gate1011, gate1011 ? pcntB + 16 * (rowq >> 8) : nullptr);
            } else {
                const int r = it - 512, h = r & 15, b = r >> 4;
                const int rowq = b * 256;
                attn_item<0>(lds, tid, P + (size_t)rowq * NP + h * 64, NP,
                             P, NP, VCT, MROWS, 0,
                             P + (size_t)rowq * NP + 1024 + h * 64, NP, VCT + (size_t)(h * 64) * MROWS + rowq, MROWS, 4,
                             0, 0, nullptr,
                             P + (size_t)rowq * NP + 3072 + h * 64, NP, H + (size_t)rowq * DM + h * 64, DM, wtw10, gate1011, gate1011 ? pcntB + 16 * (rowq >> 8) : nullptr);
            }
        }
    }
    if (!gate1011) SEAM(10);
    const bool fuse_last = (G >= (MROWS / 256) * (DM / 256));
    if (IN(11)) REPEAT(11) {
        pg8::Gemm g{H, WOUTO, MROWS, 1024, 1024}; pg8::StaticOrder S; S.init(MROWS, 1024, G, blk);
        if (fuse_last) {
            if (gate1011) {
                pg8::Unit u0;
                if (S.next(0, u0)) {
                    if (tid == 0) {
                        unsigned spins = 0;
                        while (__hip_atomic_load(pcntB + 16 * u0.pm, __ATOMIC_RELAXED, __HIP_MEMORY_SCOPE_AGENT) < 16u) { __builtin_amdgcn_s_sleep(1); if (++spins > (1u << 22)) break; }
                        __builtin_amdgcn_fence(__ATOMIC_ACQUIRE, "agent");
                        asm volatile("s_waitcnt vmcnt(0)" ::: "memory");
                    }
                }
                __syncthreads();
            }
            EpiFinal E{X1P, X1S, MOD, gpost + DM, out, (float*)(ws + WS_G), (unsigned*)(ws + 16384)};
            pg8::gemm_phase(lds, g, S, E);
        } else {
            EpiPlain E{Y2, DM};
            pg8::gemm_phase(lds, g, S, E);
        }
    }
    if (!fuse_last) {
    SEAM(11);
    if (IN(12)) {
        for (int row0 = gw; row0 < MROWS; row0 += 2 * NGW) {
            const float* xr[2]; const bf16_t* yr[2]; const float* md1[2]; float* x1r[2]; bf16_t* hr[2];
#pragma unroll
            for (int r = 0; r < 2; ++r) {
                const int row = min(row0 + r * NGW, MROWS - 1);
                const int v = row < MP ? 0 : 1 + ((row - MP) >> 12);
                xr[r] = (const float*)X1ROW(row); yr[r] = Y2 + (size_t)row * DM; md1[r] = MOD + (1 * 3 + v) * 3072; x1r[r] = out + (size_t)row * DM; hr[r] = nullptr;
            }
            postnorm_rows<false, 2, true, false>(xr, yr, gpost + DM, md1, x1r, nullptr, md1, hr, lane);
        }
    }
    }
#undef IN
#undef SEAM
#undef REPEAT
#undef lane
#undef wave
#undef gw
#undef X1ROW
}

#ifndef MK_COOP
#define MK_COOP 1
#endif
extern "C" void kernel_launch(void* const* d_in, const int* in_sizes, int n_in, void* d_out, int out_size, void* d_ws, size_t ws_size, hipStream_t stream) {
    static int grid = 0;
    if (grid == 0) {
        int dev = 0, cus = 0, per_cu = 0;
        (void)hipGetDevice(&dev);
        (void)hipDeviceGetAttribute(&cus, hipDeviceAttributeMultiprocessorCount, dev);
        (void)hipFuncSetAttribute((const void*)fwd_megakernel, hipFuncAttributeMaxDynamicSharedMemorySize, LDS_BYTES);
        (void)hipOccupancyMaxActiveBlocksPerMultiprocessor(&per_cu, (const void*)fwd_megakernel, 512, LDS_BYTES);
        if (per_cu < 1) { fprintf(stderr, "kernel_launch: occupancy query returned %d\n", per_cu); per_cu = 1; }
        grid = cus * per_cu;
        if (ws_size < WS_END) fprintf(stderr, "kernel_launch: workspace too small (%zu < %zu)\n", ws_size, (size_t)WS_END);
    }
    Params p{};
    for (int i = 0; i < 24; ++i) p.in[i] = (const float*)d_in[i];
    p.out = (float*)d_out; p.ws = (unsigned char*)d_ws;
#if MK_COOP
    p.ph_lo = 0; p.ph_hi = 13; p.coop = 1; p.pad = 0;
    void* args[] = {&p};
    (void)hipMemsetAsync((char*)d_ws + WS_BAR, 0, 131072, stream);
    hipError_t e = hipLaunchCooperativeKernel((const void*)fwd_megakernel, dim3(grid), dim3(512), args, LDS_BYTES, stream);
    if (e != hipSuccess) fprintf(stderr, "cooperative launch failed: %s (grid %d)\n", hipGetErrorString(e), grid);
#else
    for (int ph = 0; ph < 13; ++ph) {
        p.ph_lo = ph; p.ph_hi = ph + 1; p.coop = 0; p.pad = 0;
        hipLaunchKernelGGL(fwd_megakernel, dim3(grid), dim3(512), LDS_BYTES, stream, p);
    }
#endif
}
```

```cpp
#include <hip/hip_runtime.h>
#include <hip/hip_cooperative_groups.h>
#include <cstdio>
#include <cstdint>
namespace cg = cooperative_groups;

#define LAS __attribute__((address_space(3)))
#define DI __device__ __forceinline__
typedef unsigned short bf16_t;
typedef short bf16x8 __attribute__((ext_vector_type(8)));
typedef short s16x4 __attribute__((ext_vector_type(4)));
typedef float f32x4 __attribute__((ext_vector_type(4)));
typedef float f32x2 __attribute__((ext_vector_type(2)));
typedef float f32x16 __attribute__((ext_vector_type(16)));
typedef unsigned u32x4 __attribute__((ext_vector_type(4)));
typedef unsigned u32x2 __attribute__((ext_vector_type(2)));
typedef __bf16 bf16x2_t __attribute__((ext_vector_type(2)));

constexpr int DM = 1024, MP = 4096, MS = 8192, MROWS = 12288, NP = 4096;
constexpr float EPS = 1e-6f;
constexpr float LOG2E = 1.4426950408889634f;
constexpr float QSCALE = 0.125f * LOG2E;
constexpr int C_QA = 0, C_KA = 512, C_VA = 1024, C_OA = 1536, C_G = 2048, C_QB = 2064, C_KB = 2576, C_VB = 2704, C_Z = 2832, C_END = 3856;
constexpr size_t O_YP = 0, O_YS = 4194304, O_C = 12582912, O_N = 14680064, O_M = 14696448, O_GK = 14696576, O_GV = 15220864, O_NK = 15745152, O_NV = 19939456;
constexpr size_t MiB = 1u << 20;
constexpr size_t WS_BAR = 0;
constexpr size_t WS_MOD = 1 * MiB;
constexpr size_t WS_G = 2 * MiB;
constexpr size_t WS_SC = 3 * MiB;
constexpr size_t WS_CH = 5 * MiB;
constexpr size_t WS_UN = 5 * MiB + 65536;
constexpr size_t WS_NST = 5 * MiB + 65536 + 393216;
constexpr size_t WS_MJ = 5 * MiB + 65536 + 786432;
constexpr size_t WS_CK = 6 * MiB;
constexpr size_t WS_CVT = 6 * MiB + 131072;
constexpr size_t WS_NK = 7 * MiB;
constexpr size_t WS_NVT = 8 * MiB;
constexpr size_t WS_WINE = 10 * MiB;
constexpr size_t WS_WOUTE = 18 * MiB;
constexpr size_t WS_WINO = 20 * MiB;
constexpr size_t WS_WOUTO = 28 * MiB;
constexpr size_t WS_H = 30 * MiB;
constexpr size_t WS_KT = 54 * MiB;
constexpr size_t WS_VT = 66 * MiB;
constexpr size_t WS_Y2 = 54 * MiB;
constexpr size_t WS_P = 78 * MiB;
constexpr size_t WS_CST = 174 * MiB;
constexpr size_t WS_QB = 198 * MiB;
constexpr size_t WS_KB = 210 * MiB;
constexpr size_t WS_VBT = 213 * MiB;
constexpr size_t WS_U = 216 * MiB;
constexpr size_t WS_VCT = 216 * MiB;
constexpr size_t WS_X1P = 10 * MiB;
constexpr size_t WS_X1S = 240 * MiB;
constexpr size_t WS_END = 256 * MiB;

constexpr int REP_MASK = 0, SYNC_REP = 1;
constexpr int LDS_BYTES = 147456;

DI float bf2f(unsigned short b) { return __uint_as_float(((unsigned)b) << 16); }
DI unsigned cvtpk(float lo, float hi) { f32x2 v = {lo, hi}; bf16x2_t b = __builtin_convertvector(v, bf16x2_t); return __builtin_bit_cast(unsigned, b); }
DI unsigned short f2bf(float x) { return (unsigned short)(cvtpk(x, 0.f) & 0xffffu); }
DI float siluf(float x) { return x / (1.f + __expf(-x)); }
DI float sigmf(float x) { return 1.f / (1.f + __expf(-x)); }
DI float wave_sum(float v) {
#pragma unroll
    for (int o = 1; o < 64; o <<= 1) v += __shfl_xor(v, o);
    return v;
}
DI int crow(int i, int h) { return (i & 3) + 8 * (i >> 2) + 4 * h; }
DI bf16x8 pack8(float a0, float a1, float a2, float a3, float a4, float a5, float a6, float a7) {
    u32x4 p; p.x = cvtpk(a0, a1); p.y = cvtpk(a2, a3); p.z = cvtpk(a4, a5); p.w = cvtpk(a6, a7);
    return __builtin_bit_cast(bf16x8, p);
}
#define MFMA32(a, b, c) __builtin_amdgcn_mfma_f32_32x32x16_bf16((a), (b), (c), 0, 0, 0)

namespace pg8 {
constexpr int BM = 256, BK = 64, HALF = 128, HTB = HALF * BK * 2, NXCD = 8, WGM = 8;
DI int lds_byte(int r, int c) { const int st = (r >> 4) * 2 + (c >> 5), rr = r & 15, cc = c & 31, ob = rr * 64 + cc * 2; return st * 1024 + (ob ^ (((ob >> 9) & 1) << 5)); }
DI void stage_rc(int b, int& R, int& C) { const int st = b / 1024, sb = b % 1024, swz = sb ^ (((sb >> 9) & 1) << 5); R = (st >> 1) * 16 + swz / 64; C = (st & 1) * 32 + (swz % 64) / 2; }
DI int perm32(int rho) { const int n = rho >> 4, i = rho & 15; return 8 * (i >> 2) + 4 * n + (i & 3); }
struct Unit { int pm, pn; };
struct Gemm { const bf16_t* A; const bf16_t* Bt; int M, N, K; };
struct StaticOrder {
    int nM, nN, nwg, G, c;
    DI void init(int M, int N, int G_, int c_) { nM = M / BM; nN = N / BM; nwg = nM * nN; G = G_; c = c_; }
    DI bool next(int i, Unit& u) const {
        const long L = (long)i * G + c; if (L >= nwg) return false;
        int wgid = (int)L; { const int q = nwg / NXCD, r = nwg % NXCD, xcd = wgid % NXCD, off = wgid / NXCD; wgid = (xcd < r ? xcd * (q + 1) : r * (q + 1) + (xcd - r) * q) + off; }
        const int nig = WGM * nN, gid = wgid / nig, fm = gid * WGM, gsz = (nM - fm) < WGM ? (nM - fm) : WGM;
        u.pm = fm + ((wgid % nig) % gsz); u.pn = (wgid % nig) / gsz; return true;
    }
};
template <class Epi>
DI void gemm_phase(LAS unsigned char* lds, const Gemm g, const StaticOrder& S, const Epi& E) {
    const int tid = threadIdx.x, wid = __builtin_amdgcn_readfirstlane(tid >> 6), lane = tid & 63, wr = wid >> 2, wc = wid & 3, fr = lane & 15, fq = lane >> 4;
    const int K = g.K, nt = K / BK;
    unsigned voffA[2], voffB[2];
#pragma unroll
    for (int i = 0; i < 2; ++i) { int R, C; stage_rc(tid * 16 + i * 8192, R, C); const int Rb = (R & ~31) + perm32(R & 31);
        voffA[i] = (unsigned)(R * K + C) * 2u; voffB[i] = (unsigned)(Rb * K + C) * 2u; }
    const size_t kstep = (size_t)(BK * 2);
    const size_t hstep = (size_t)HALF * K * 2;
    const size_t tstep = 2 * hstep;
    const unsigned ldsw = (unsigned)wid * 1024u;
    const int aoff = lds_byte(wr * 64 + fr, fq * 8), boff = lds_byte(wc * 32 + fr, fq * 8);
#define PG8_SA(b, h) (((b) * 2 + (h)) * HTB)
#define PG8_SB(b, h) ((4 + (b) * 2 + (h)) * HTB)
#define PG8_STAGE(bufoff, gbase, voff) do { _Pragma("unroll") for (int _i = 0; _i < 2; ++_i) \
        __builtin_amdgcn_global_load_lds((const unsigned*)((const char*)(gbase) + (voff)[_i]), (LAS unsigned*)(lds + (bufoff) + ldsw + _i * 8192), 16, 0, 0); } while (0)
#define PG8_LDA(dst, b, h) do { _Pragma("unroll") for (int m = 0; m < 4; ++m) _Pragma("unroll") for (int k = 0; k < 2; ++k) dst[m][k] = *(const LAS bf16x8*)(lds + PG8_SA(b, h) + aoff + m * 2048 + k * 1024); } while (0)
#define PG8_LDB(dst, b, h) do { _Pragma("unroll") for (int n = 0; n < 2; ++n) _Pragma("unroll") for (int k = 0; k < 2; ++k) dst[n][k] = *(const LAS bf16x8*)(lds + PG8_SB(b, h) + boff + n * 2048 + k * 1024); } while (0)
#define PG8_MMA(ai, bj, At, Bt) do { __builtin_amdgcn_s_setprio(1); _Pragma("unroll") for (int m = 0; m < 4; ++m) _Pragma("unroll") for (int n = 0; n < 2; ++n) _Pragma("unroll") for (int k = 0; k < 2; ++k) \
        acc[ai][bj][m][n] = __builtin_amdgcn_mfma_f32_16x16x32_bf16(Bt[n][k], At[m][k], acc[ai][bj][m][n], 0, 0, 0); __builtin_amdgcn_s_setprio(0); } while (0)
#define PG8_WAIT_V(n) asm volatile("s_waitcnt vmcnt(" #n ")" ::: "memory")
#define PG8_WAIT_L(n) asm volatile("s_waitcnt lgkmcnt(" #n ")" ::: "memory")
#define PG8_BAR __builtin_amdgcn_s_barrier()
#define PG8_SCHED __builtin_amdgcn_sched_barrier(0)
    Unit cur, nxt; int ui = 0;
    if (!S.next(0, cur)) return;
    f32x4 acc[2][2][4][2];
#pragma unroll
    for (int a = 0; a < 2; ++a)
#pragma unroll
        for (int b = 0; b < 2; ++b)
#pragma unroll
            for (int m = 0; m < 4; ++m)
#pragma unroll
                for (int n = 0; n < 2; ++n) acc[a][b][m][n] = (f32x4){0.f, 0.f, 0.f, 0.f};
    bf16x8 At[4][2], B0[2][2], B1[2][2];
    const char* cA = (const char*)g.A + (size_t)cur.pm * tstep; const char* cB = (const char*)g.Bt + (size_t)cur.pn * tstep;
    PG8_STAGE(PG8_SB(0, 0), cB, voffB); PG8_STAGE(PG8_SB(0, 1), cB + hstep, voffB); PG8_STAGE(PG8_SA(0, 0), cA, voffA); PG8_STAGE(PG8_SA(0, 1), cA + hstep, voffA);
    if (wr == 1) PG8_BAR;
    PG8_WAIT_V(2); PG8_BAR;
    PG8_STAGE(PG8_SB(1, 0), cB + kstep, voffB); PG8_STAGE(PG8_SA(1, 0), cA + kstep, voffA); PG8_STAGE(PG8_SB(1, 1), cB + hstep + kstep, voffB);
    PG8_WAIT_V(6); PG8_BAR;
    for (;;) {
        const bool has_next = S.next(ui + 1, nxt);
        const char* nA = has_next ? (const char*)g.A + (size_t)nxt.pm * tstep : cA; const char* nB = has_next ? (const char*)g.Bt + (size_t)nxt.pn * tstep : cB;
        for (int t = 0; t < nt; t += 2) {
            const bool last = (t == nt - 2);
            const char* a1 = cA + (size_t)(t + 1) * kstep;
            const char* a2 = last ? nA : cA + (size_t)(t + 2) * kstep; const char* b2 = last ? nB : cB + (size_t)(t + 2) * kstep;
            const char* a3 = a2 + kstep; const char* b3 = b2 + kstep;
            PG8_LDB(B0, 0, 0); PG8_LDB(B1, 0, 1); PG8_SCHED; PG8_LDA(At, 0, 0); PG8_STAGE(PG8_SA(1, 1), a1 + hstep, voffA);
            PG8_WAIT_V(8); PG8_WAIT_L(0); PG8_BAR; PG8_MMA(0, 0, At, B0); PG8_MMA(0, 1, At, B1); PG8_BAR; PG8_SCHED;
            PG8_LDA(At, 0, 1); PG8_STAGE(PG8_SB(0, 0), b2, voffB); PG8_STAGE(PG8_SB(0, 1), b2 + hstep, voffB); PG8_STAGE(PG8_SA(0, 0), a2, voffA);
            PG8_WAIT_V(8); PG8_WAIT_L(0); PG8_BAR; PG8_MMA(1, 0, At, B0); PG8_MMA(1, 1, At, B1); PG8_BAR; PG8_SCHED;
            PG8_LDB(B0, 1, 0); PG8_LDB(B1, 1, 1); PG8_SCHED; PG8_LDA(At, 1, 0); PG8_STAGE(PG8_SA(0, 1), a2 + hstep, voffA);
            PG8_WAIT_V(8); PG8_WAIT_L(0); PG8_BAR; PG8_MMA(0, 0, At, B0); PG8_MMA(0, 1, At, B1); PG8_BAR; PG8_SCHED;
            PG8_LDA(At, 1, 1); PG8_STAGE(PG8_SB(1, 0), b3, voffB); PG8_STAGE(PG8_SB(1, 1), b3 + hstep, voffB); PG8_STAGE(PG8_SA(1, 0), a3, voffA);
            PG8_WAIT_V(8); PG8_WAIT_L(0); PG8_BAR; PG8_MMA(1, 0, At, B0); PG8_MMA(1, 1, At, B1); PG8_BAR; PG8_SCHED;
        }
        if (wr == 0) PG8_BAR;
        if constexpr (!Epi::AFTER_DRAIN) E(acc, cur, wr, wc, fr, fq);
        if (!has_next) break;
#pragma unroll
        for (int a = 0; a < 2; ++a)
#pragma unroll
            for (int b = 0; b < 2; ++b)
#pragma unroll
                for (int m = 0; m < 4; ++m)
#pragma unroll
                    for (int n = 0; n < 2; ++n) acc[a][b][m][n] = (f32x4){0.f, 0.f, 0.f, 0.f};
        cur = nxt; cA = nA; cB = nB; ++ui;
        if (wr == 1) PG8_BAR;
    }
    PG8_WAIT_V(0);
    PG8_BAR;
    if constexpr (Epi::AFTER_DRAIN) E.fused(acc, cur, wr, wc, fr, fq, lds, wid, lane);
#undef PG8_SA
#undef PG8_SB
#undef PG8_STAGE
#undef PG8_LDA
#undef PG8_LDB
#undef PG8_MMA
#undef PG8_WAIT_V
#undef PG8_WAIT_L
#undef PG8_BAR
#undef PG8_SCHED
}
}

struct Params {
    const float* in[24];
    float* out;
    unsigned char* ws;
    int ph_lo, ph_hi, coop, pad;
};

struct WT { __amdgpu_buffer_rsrc_t rs; const unsigned char* base; };
DI WT mk_wt(const void* base, unsigned bytes) { WT w; w.rs = __builtin_amdgcn_make_buffer_rsrc((void*)base, (short)0, (int)bytes, 0x00020000); w.base = (const unsigned char*)base; return w; }
DI void wt16(const WT& w, const void* p, u32x4 v) { __builtin_amdgcn_raw_buffer_store_b128(v, w.rs, (unsigned)((const unsigned char*)p - w.base), 0, 16); }
DI void st_bf16x8(bf16_t* p, f32x4 a, f32x4 b) {
    u32x4 w; w.x = cvtpk(a[0], a[1]); w.y = cvtpk(a[2], a[3]); w.z = cvtpk(b[0], b[1]); w.w = cvtpk(b[2], b[3]);
    *(u32x4*)p = w;
}

struct EpiEvenIn {
    static constexpr bool AFTER_DRAIN = false;
    bf16_t* P; bf16_t* KT; bf16_t* VT; bf16_t* VbT; float* G; float* out;
    DI void operator()(const f32x4 (&acc)[2][2][4][2], const pg8::Unit& u, int wr, int wc, int fr, int fq) const {
#pragma unroll
        for (int bj = 0; bj < 2; ++bj) {
            const int c8 = u.pn * 256 + bj * 128 + wc * 32 + 8 * fq;
            if (c8 >= C_END) continue;
#pragma unroll
            for (int ai = 0; ai < 2; ++ai)
#pragma unroll
                for (int m = 0; m < 4; ++m) {
                    const int row = u.pm * 256 + ai * 128 + wr * 64 + m * 16 + fr;
                    f32x4 v0 = acc[ai][bj][m][0], v1 = acc[ai][bj][m][1];
                    if (c8 >= C_KA && c8 < C_VA) { v0 = v0 * 0.08838834764831845f; v1 = v1 * 0.08838834764831845f; }
                    if (c8 >= C_Z) {
#pragma unroll
                        for (int j = 0; j < 4; ++j) { v0[j] = siluf(v0[j]); v1[j] = siluf(v1[j]); }
                    }
                    if (c8 >= C_G && c8 < C_QB) {
                        *(f32x4*)(G + (size_t)row * 16 + (c8 - C_G)) = v0; *(f32x4*)(G + (size_t)row * 16 + (c8 - C_G) + 4) = v1;
                    } else {
                        st_bf16x8(P + (size_t)row * NP + c8, v0, v1);
                    }
                    bf16_t* T = nullptr; int tc = 0;
                    if (c8 >= C_KA && c8 < C_VA) { T = KT; tc = c8 - C_KA; }
                    else if (c8 >= C_VA && c8 < C_OA) { T = VT; tc = c8 - C_VA; }
                    else if (c8 >= C_VB && c8 < C_Z) { T = VbT; tc = c8 - C_VB; }
                    if (T) {
#pragma unroll
                        for (int j = 0; j < 4; ++j) { T[(size_t)(tc + j) * MROWS + row] = f2bf(v0[j]); T[(size_t)(tc + 4 + j) * MROWS + row] = f2bf(v1[j]); }
                    }
                    if (c8 >= C_VB && c8 < C_Z && row < MP) {
                        const int c = c8 - C_VB, hk = c >> 6, d = c & 63, b = row >> 8, t = row & 255;
                        float* o = out + O_GV + ((size_t)((b * 2 + hk) * 256 + t)) * 64 + d;
                        *(f32x4*)o = v0; *(f32x4*)(o + 4) = v1;
                    }
                }
        }
    }
};
struct EpiPlain {
    static constexpr bool AFTER_DRAIN = false;
    bf16_t* O; int ldc;
    DI void operator()(const f32x4 (&acc)[2][2][4][2], const pg8::Unit& u, int wr, int wc, int fr, int fq) const {
#pragma unroll
        for (int bj = 0; bj < 2; ++bj) {
            const int c8 = u.pn * 256 + bj * 128 + wc * 32 + 8 * fq;
#pragma unroll
            for (int ai = 0; ai < 2; ++ai)
#pragma unroll
                for (int m = 0; m < 4; ++m) {
                    const int row = u.pm * 256 + ai * 128 + wr * 64 + m * 16 + fr;
                    st_bf16x8(O + (size_t)row * ldc + c8, acc[ai][bj][m][0], acc[ai][bj][m][1]);
                }
        }
    }
};
struct EpiOddIn {
    static constexpr bool AFTER_DRAIN = false;
    bf16_t* P; bf16_t* VcT; float* out;
    DI void operator()(const f32x4 (&acc)[2][2][4][2], const pg8::Unit& u, int wr, int wc, int fr, int fq) const {
#pragma unroll
        for (int bj = 0; bj < 2; ++bj) {
            const int c8 = u.pn * 256 + bj * 128 + wc * 32 + 8 * fq;
            const int seg = c8 >> 10, c = c8 & 1023;
#pragma unroll
            for (int ai = 0; ai < 2; ++ai)
#pragma unroll
                for (int m = 0; m < 4; ++m) {
                    const int row = u.pm * 256 + ai * 128 + wr * 64 + m * 16 + fr;
                    f32x4 v0 = acc[ai][bj][m][0], v1 = acc[ai][bj][m][1];
                    if ((seg == 1 || seg == 2) && row < MP) {
                        const int h = c >> 6, d = c & 63, b = row >> 8, t = row & 255;
                        float* o = out + (seg == 1 ? O_NK : O_NV) + ((size_t)((b * 16 + h) * 256 + t)) * 64 + d;
                        *(f32x4*)o = v0; *(f32x4*)(o + 4) = v1;
                    }
                    if (seg == 2) {
#pragma unroll
                        for (int j = 0; j < 4; ++j) { VcT[(size_t)(c + j) * MROWS + row] = f2bf(v0[j]); VcT[(size_t)(c + 4 + j) * MROWS + row] = f2bf(v1[j]); }
                    } else {
                        if (seg == 0) { v0 = v0 * QSCALE; v1 = v1 * QSCALE; }
                        if (seg == 3) {
#pragma unroll
                            for (int j = 0; j < 4; ++j) { v0[j] = siluf(v0[j]); v1[j] = siluf(v1[j]); }
                        }
                        st_bf16x8(P + (size_t)row * NP + c8, v0, v1);
                    }
                }
        }
    }
};

DI void panel_row_rinv(const f32x4 (&v)[2][2][4][2], const pg8::Unit& u, int wr, int wc, int fr, int fq, LAS float* Pl, LAS float* Sl, int tid, float* slot, unsigned* c) {
#pragma unroll
    for (int ai = 0; ai < 2; ++ai)
#pragma unroll
        for (int m = 0; m < 4; ++m) {
            float sq = 0.f;
#pragma unroll
            for (int bj = 0; bj < 2; ++bj)
#pragma unroll
                for (int n = 0; n < 2; ++n) { const f32x4 x = v[ai][bj][m][n]; sq += (x[0] * x[0] + x[1] * x[1]) + (x[2] * x[2] + x[3] * x[3]); }
            sq += __shfl_xor(sq, 16); sq += __shfl_xor(sq, 32);
            if (fq == 0) Pl[(ai * 128 + wr * 64 + m * 16 + fr) * 4 + wc] = sq;
        }
    __syncthreads();
    if (tid < 256) {
        const float tot = (Pl[tid * 4 + 0] + Pl[tid * 4 + 1]) + (Pl[tid * 4 + 2] + Pl[tid * 4 + 3]);
        __hip_atomic_store(slot + tid * 4 + u.pn, tot, __ATOMIC_RELAXED, __HIP_MEMORY_SCOPE_AGENT);
    }
    asm volatile("s_waitcnt vmcnt(0)" ::: "memory");
    __syncthreads();
    if (tid == 0) {
        __hip_atomic_fetch_add(c, 1u, __ATOMIC_RELAXED, __HIP_MEMORY_SCOPE_AGENT);
        unsigned spins = 0;
        while (__hip_atomic_load(c, __ATOMIC_RELAXED, __HIP_MEMORY_SCOPE_AGENT) < 4u) { __builtin_amdgcn_s_sleep(1); if (++spins > (1u << 22)) break; }
        asm volatile("" ::: "memory");
    }
    __syncthreads();
    if (tid < 256) {
        float t = 0.f;
#pragma unroll
        for (int k = 0; k < 4; ++k) t += __hip_atomic_load(slot + tid * 4 + k, __ATOMIC_RELAXED, __HIP_MEMORY_SCOPE_AGENT);
        Sl[tid] = rsqrtf(t * (1.f / DM) + EPS);
    }
    __syncthreads();
}
struct EpiFinal {
    static constexpr bool AFTER_DRAIN = true;
    const bf16_t* X1P; const bf16_t* X1S; const float* MODl; const float* gpost; float* out; float* xbuf; unsigned* cnt;
    DI void fused(f32x4 (&acc)[2][2][4][2], const pg8::Unit& u, int wr, int wc, int fr, int fq, LAS unsigned char* lds, int wid, int lane) const {
        LAS float* Pl = (LAS float*)lds;
        LAS float* Sl = Pl + 1024;
        const int tid = wid * 64 + lane;
        u32x4 pxr[2][2][4];
#pragma unroll
        for (int bj = 0; bj < 2; ++bj) {
            const int c8 = u.pn * 256 + bj * 128 + wc * 32 + 8 * fq;
#pragma unroll
            for (int ai = 0; ai < 2; ++ai)
#pragma unroll
                for (int m = 0; m < 4; ++m) { const int row = u.pm * 256 + ai * 128 + wr * 64 + m * 16 + fr;
                    pxr[bj][ai][m] = *(const u32x4*)((row < MP ? X1P + (size_t)row * DM : X1S + (size_t)(row - MP) * DM) + c8); }
        }
        panel_row_rinv(acc, u, wr, wc, fr, fq, Pl, Sl, tid, xbuf + (size_t)(u.pm * 256) * 4, cnt + 16 * u.pm);
        const int v = u.pm < 16 ? 0 : 1 + ((u.pm - 16) >> 4);
        const float* gate = MODl + (1 * 3 + v) * 3072 + 2048;
#pragma unroll
        for (int bj = 0; bj < 2; ++bj) {
            const int c8 = u.pn * 256 + bj * 128 + wc * 32 + 8 * fq;
            const f32x4 g0 = *(const f32x4*)(gpost + c8), g1 = *(const f32x4*)(gpost + c8 + 4);
            const f32x4 t0 = *(const f32x4*)(gate + c8), t1 = *(const f32x4*)(gate + c8 + 4);
#pragma unroll
            for (int ai = 0; ai < 2; ++ai)
#pragma unroll
                for (int m = 0; m < 4; ++m) {
                    const int rl = ai * 128 + wr * 64 + m * 16 + fr, row = u.pm * 256 + rl;
                    const float rinv = Sl[rl];
                    const u32x4 xr = pxr[bj][ai][m];
                    const f32x4 y0 = acc[ai][bj][m][0], y1 = acc[ai][bj][m][1];
                    f32x4 o0, o1;
                    o0[0] = __uint_as_float(xr.x << 16) + t0[0] * (y0[0] * rinv * g0[0]); o0[1] = __uint_as_float(xr.x & 0xffff0000u) + t0[1] * (y0[1] * rinv * g0[1]);
                    o0[2] = __uint_as_float(xr.y << 16) + t0[2] * (y0[2] * rinv * g0[2]); o0[3] = __uint_as_float(xr.y & 0xffff0000u) + t0[3] * (y0[3] * rinv * g0[3]);
                    o1[0] = __uint_as_float(xr.z << 16) + t1[0] * (y1[0] * rinv * g1[0]); o1[1] = __uint_as_float(xr.z & 0xffff0000u) + t1[1] * (y1[1] * rinv * g1[1]);
                    o1[2] = __uint_as_float(xr.w << 16) + t1[2] * (y1[2] * rinv * g1[2]); o1[3] = __uint_as_float(xr.w & 0xffff0000u) + t1[3] * (y1[3] * rinv * g1[3]);
                    float* op = out + (size_t)row * DM + c8;
                    *(f32x4*)op = o0; *(f32x4*)(op + 4) = o1;
                }
        }
    }
};

struct EpiMid {
    static constexpr bool AFTER_DRAIN = true;
    const float* x_prompt; const float* x_sample; const float* MODl; const float* gpost; const float* gpre1; bf16_t* X1P; bf16_t* X1S; bf16_t* Hn; float* xbuf; unsigned* cnt;
    DI void fused(f32x4 (&acc)[2][2][4][2], const pg8::Unit& u, int wr, int wc, int fr, int fq, LAS unsigned char* lds, int wid, int lane) const {
        LAS float* Pl = (LAS float*)lds; LAS float* Sl = Pl + 1024;
        const int tid = wid * 64 + lane;
        panel_row_rinv(acc, u, wr, wc, fr, fq, Pl, Sl, tid, xbuf + (size_t)(12288 + u.pm * 256) * 4, cnt + 16 * (48 + u.pm));
        const int v = u.pm < 16 ? 0 : 1 + ((u.pm - 16) >> 4);
        const float* md0 = MODl + (0 * 3 + v) * 3072; const float* md1 = MODl + (1 * 3 + v) * 3072;
        const float* xbase = u.pm < 16 ? x_prompt + (size_t)(u.pm * 256) * DM : x_sample + (size_t)(u.pm * 256 - MP) * DM;
#pragma unroll
        for (int bj = 0; bj < 2; ++bj) {
            const int c8 = u.pn * 256 + bj * 128 + wc * 32 + 8 * fq;
            const f32x4 g0 = *(const f32x4*)(gpost + c8), g1 = *(const f32x4*)(gpost + c8 + 4);
            const f32x4 t0 = *(const f32x4*)(md0 + 2048 + c8), t1 = *(const f32x4*)(md0 + 2048 + c8 + 4);
#pragma unroll
            for (int ai = 0; ai < 2; ++ai)
#pragma unroll
                for (int m = 0; m < 4; ++m) {
                    const int rl = ai * 128 + wr * 64 + m * 16 + fr, row = u.pm * 256 + rl;
                    const float rinv = Sl[rl];
                    const f32x4 x0 = *(const f32x4*)(xbase + (size_t)rl * DM + c8), x1 = *(const f32x4*)(xbase + (size_t)rl * DM + c8 + 4);
                    f32x4 y0 = acc[ai][bj][m][0], y1 = acc[ai][bj][m][1];
#pragma unroll
                    for (int e = 0; e < 4; ++e) { y0[e] = x0[e] + t0[e] * (y0[e] * rinv * g0[e]); y1[e] = x1[e] + t1[e] * (y1[e] * rinv * g1[e]); }
                    acc[ai][bj][m][0] = y0; acc[ai][bj][m][1] = y1;
                    u32x4 w; w.x = cvtpk(y0[0], y0[1]); w.y = cvtpk(y0[2], y0[3]); w.z = cvtpk(y1[0], y1[1]); w.w = cvtpk(y1[2], y1[3]);
                    *(u32x4*)((row < MP ? X1P + (size_t)row * DM : X1S + (size_t)(row - MP) * DM) + c8) = w;
                }
        }
        panel_row_rinv(acc, u, wr, wc, fr, fq, Pl, Sl, tid, xbuf + (size_t)(2 * 12288 + u.pm * 256) * 4, cnt + 16 * (96 + u.pm));
#pragma unroll
        for (int bj = 0; bj < 2; ++bj) {
            const int c8 = u.pn * 256 + bj * 128 + wc * 32 + 8 * fq;
            const f32x4 g0 = *(const f32x4*)(gpre1 + c8), g1 = *(const f32x4*)(gpre1 + c8 + 4);
            const f32x4 a0 = *(const f32x4*)(md1 + 1024 + c8), a1 = *(const f32x4*)(md1 + 1024 + c8 + 4);
            const f32x4 b0 = *(const f32x4*)(md1 + c8), b1 = *(const f32x4*)(md1 + c8 + 4);
#pragma unroll
            for (int ai = 0; ai < 2; ++ai)
#pragma unroll
                for (int m = 0; m < 4; ++m) {
                    const int rl = ai * 128 + wr * 64 + m * 16 + fr, row = u.pm * 256 + rl;
                    const float r1 = Sl[rl];
                    const f32x4 y0 = acc[ai][bj][m][0], y1 = acc[ai][bj][m][1];
                    float o[8];
#pragma unroll
                    for (int e = 0; e < 4; ++e) { o[e] = y0[e] * r1 * g0[e] * (1.f + a0[e]) + b0[e]; o[4 + e] = y1[e] * r1 * g1[e] * (1.f + a1[e]) + b1[e]; }
                    u32x4 w; w.x = cvtpk(o[0], o[1]); w.y = cvtpk(o[2], o[3]); w.z = cvtpk(o[4], o[5]); w.w = cvtpk(o[6], o[7]);
                    *(u32x4*)(Hn + (size_t)row * DM + c8) = w;
                }
        }
    }
};

constexpr int AT_PITCH = 144, AT_TILE = 64 * AT_PITCH;
DI void attn_tile_load(int it, int nt0, const bf16_t* K0, int k0s, const bf16_t* V0, int v0s, const bf16_t* K1, int k1s, const bf16_t* V1, int v1s, int tid, u32x4& kr, u32x4& vr) {
    const int row = tid >> 3, pc = tid & 7;
    const bf16_t* K; const bf16_t* V; int ks, vs, tt;
    if (it < nt0) { K = K0; V = V0; ks = k0s; vs = v0s; tt = it; } else { K = K1; V = V1; ks = k1s; vs = v1s; tt = it - nt0; }
    kr = *(const u32x4*)(K + (size_t)(tt * 64 + row) * ks + pc * 8);
    vr = *(const u32x4*)(V + (size_t)row * vs + tt * 64 + pc * 8);
}
DI void attn_tile_store(LAS unsigned char* kb, LAS unsigned char* vb, int tid, const u32x4& kr, const u32x4& vr, bool nat) {
    const int row = tid >> 3, pc = tid & 7;
    *(LAS u32x4*)(kb + row * AT_PITCH + pc * 16) = kr;
    if (nat) { *(LAS u32x4*)(vb + row * AT_PITCH + pc * 16) = vr; return; }
    const int grp = pc >> 1, b3 = pc & 1;
    u32x2 lo = {vr.x, vr.y}, hi = {vr.z, vr.w};
    *(LAS u32x2*)(vb + row * AT_PITCH + (16 * grp + 4 * b3) * 2) = lo;
    *(LAS u32x2*)(vb + row * AT_PITCH + (16 * grp + 8 + 4 * b3) * 2) = hi;
}

DI void attn_qk(const LAS unsigned char* kb, const bf16x8 (&qf)[4], int l32, int half, float nm, f32x16& s0, f32x16& s1) {
    bf16x8 a[8];
#pragma unroll
    for (int s = 0; s < 4; ++s) {
        a[2 * s] = *(const LAS bf16x8*)(kb + l32 * AT_PITCH + s * 32 + half * 16);
        a[2 * s + 1] = *(const LAS bf16x8*)(kb + (32 + l32) * AT_PITCH + s * 32 + half * 16);
    }
    f32x16 nmC;
#pragma unroll
    for (int i = 0; i < 16; ++i) nmC[i] = nm;
    s0 = MFMA32(a[0], qf[0], nmC); s1 = MFMA32(a[1], qf[0], nmC);
#pragma unroll
    for (int s = 1; s < 4; ++s) { s0 = MFMA32(a[2 * s], qf[s], s0); s1 = MFMA32(a[2 * s + 1], qf[s], s1); }
}
DI void attn_bias(f32x16& s0, f32x16& s1, const LAS float* bp, int half, int cs) {
#pragma unroll
    for (int i = 0; i < 16; ++i) {
        const int kc0 = 8 * (i >> 2) + (i & 3);
        const int kca = kc0 + 4 * half, kcb = kca + 32;
        const float b0 = bp[kc0], b1 = bp[kc0 + 32];
        s0[i] = ((unsigned)(kca - cs) < 16u) ? s0[i] + b0 : -1e30f;
        s1[i] = ((unsigned)(kcb - cs) < 16u) ? s1[i] + b1 : -1e30f;
    }
}
DI float attn_max(const f32x16& s0, const f32x16& s1) {
    float mx = fmaxf(s0[0], s1[0]);
#pragma unroll
    for (int i = 1; i < 16; ++i) mx = fmaxf(mx, fmaxf(s0[i], s1[i]));
    return mx;
}
DI void attn_pv(const LAS unsigned char* vb, f32x16& s0, f32x16& s1, int l32, int half, const bf16x8& ones, f32x16& o0, f32x16& o1, f32x16& lacc) {
    bf16x8 v[8];
#pragma unroll
    for (int s = 0; s < 4; ++s) {
        v[2 * s] = *(const LAS bf16x8*)(vb + l32 * AT_PITCH + (16 * s + 8 * half) * 2);
        v[2 * s + 1] = *(const LAS bf16x8*)(vb + (32 + l32) * AT_PITCH + (16 * s + 8 * half) * 2);
    }
#pragma unroll
    for (int i = 0; i < 16; ++i) { s0[i] = __builtin_amdgcn_exp2f(s0[i]); s1[i] = __builtin_amdgcn_exp2f(s1[i]); }
    bf16x8 pf[4];
    pf[0] = pack8(s0[0], s0[1], s0[2], s0[3], s0[4], s0[5], s0[6], s0[7]);
    pf[1] = pack8(s0[8], s0[9], s0[10], s0[11], s0[12], s0[13], s0[14], s0[15]);
    pf[2] = pack8(s1[0], s1[1], s1[2], s1[3], s1[4], s1[5], s1[6], s1[7]);
    pf[3] = pack8(s1[8], s1[9], s1[10], s1[11], s1[12], s1[13], s1[14], s1[15]);
#pragma unroll
    for (int s = 0; s < 4; ++s) {
        o0 = MFMA32(v[2 * s], pf[s], o0); o1 = MFMA32(v[2 * s + 1], pf[s], o1);
        lacc = MFMA32(ones, pf[s], lacc);
    }
}

DI void attn_qk32(const LAS unsigned char* kb, const bf16x8 (&qf)[4], int krow, int half, float nm, f32x16& sv) {
    f32x16 nmC;
#pragma unroll
    for (int i = 0; i < 16; ++i) nmC[i] = nm;
    const LAS unsigned char* p = kb + krow * AT_PITCH + half * 16;
    sv = MFMA32(*(const LAS bf16x8*)p, qf[0], nmC);
#pragma unroll
    for (int s = 1; s < 4; ++s) sv = MFMA32(*(const LAS bf16x8*)(p + s * 32), qf[s], sv);
}
DI void attn_bias32(f32x16& sv, const LAS float* bp, int kcb, bool rowvalid) {
#pragma unroll
    for (int i = 0; i < 16; ++i) {
        const int kc0 = 8 * (i >> 2) + (i & 3);
        const float b0 = bp[kc0];
        sv[i] = (rowvalid && (unsigned)(kcb + kc0) < 16u) ? sv[i] + b0 : -1e30f;
    }
}
DI float attn_max16(const f32x16& sv) {
    float mx = sv[0];
#pragma unroll
    for (int i = 1; i < 16; ++i) mx = fmaxf(mx, sv[i]);
    return mx;
}
DI void attn_pv32(const LAS unsigned char* vb, f32x16& sv, int l32, int half, int k0, const bf16x8& ones, f32x16& o0, f32x16& o1, f32x16& lacc) {
#pragma unroll
    for (int i = 0; i < 16; ++i) sv[i] = __builtin_amdgcn_exp2f(sv[i]);
    const bf16x8 pf0 = pack8(sv[0], sv[1], sv[2], sv[3], sv[4], sv[5], sv[6], sv[7]);
    const bf16x8 pf1 = pack8(sv[8], sv[9], sv[10], sv[11], sv[12], sv[13], sv[14], sv[15]);
#pragma unroll
    for (int s2 = 0; s2 < 2; ++s2) {
        const LAS unsigned char* p0 = vb + l32 * AT_PITCH + (k0 + 16 * s2 + 4 * half) * 2;
        const LAS unsigned char* p1 = p0 + 32 * AT_PITCH;
        const s16x4 lo0 = *(const LAS s16x4*)p0, hi0 = *(const LAS s16x4*)(p0 + 16);
        const s16x4 lo1 = *(const LAS s16x4*)p1, hi1 = *(const LAS s16x4*)(p1 + 16);
        const bf16x8 A0 = __builtin_shufflevector(lo0, hi0, 0, 1, 2, 3, 4, 5, 6, 7);
        const bf16x8 A1 = __builtin_shufflevector(lo1, hi1, 0, 1, 2, 3, 4, 5, 6, 7);
        o0 = MFMA32(A0, s2 == 0 ? pf0 : pf1, o0); o1 = MFMA32(A1, s2 == 0 ? pf0 : pf1, o1);
        lacc = MFMA32(ones, s2 == 0 ? pf0 : pf1, lacc);
    }
}

template <int MODE>
DI void attn_item(LAS unsigned char* lds, int tid,
                  const bf16_t* Q, int qstride,
                  const bf16_t* K0, int k0s, const bf16_t* V0, int v0s, int nt0,
                  const bf16_t* K1, int k1s, const bf16_t* V1, int v1s, int nt1,
                  int r0, int rs_lo, const LAS float* rpbL,
                  const bf16_t* Z, int zstride, bf16_t* O, int ostride, const WT& wt, bool usewt, unsigned* pcnt) {
    const int lane = tid & 63, w = tid >> 6, l32 = lane & 31, half = lane >> 5;
    const int np = (nt0 + nt1 + 1) >> 1;
    const int ng = w & 3, nrp = w >> 2;
    const int qc = (MODE == 1) ? 16 * ng + (l32 & 15) : 0;
    const int qrw = (MODE == 1) ? 2 * nrp + (l32 >> 4) : 0;
    const int qr = r0 + qrw;
    const int qrow = (MODE == 1) ? qrw * 64 + qc : w * 32 + l32;
    const int k0 = (ng == 0) ? 0 : (ng == 1) ? 8 : (ng == 2) ? 24 : 32;
    bf16x8 qf[4];
#pragma unroll
    for (int s = 0; s < 4; ++s) qf[s] = *(const bf16x8*)(Q + (size_t)qrow * qstride + 16 * s + 8 * half);
    f32x16 o0, o1, lacc;
#pragma unroll
    for (int i = 0; i < 16; ++i) { o0[i] = 0.f; o1[i] = 0.f; lacc[i] = 0.f; }
    float m_run = 0.f;
    const bf16x8 ones = {0x3F80, 0x3F80, 0x3F80, 0x3F80, 0x3F80, 0x3F80, 0x3F80, 0x3F80};
    const int cs = min(max(qc - 8, 0), 48);
    const int rsq = min(max(qr - 4, 0), 56);
    const int rsw_lo = min(max(r0 + 2 * nrp - 4, 0), 56), rsw_hi = min(max(r0 + 2 * nrp + 1 - 4, 0), 56) + 8;

    u32x4 eka, eva, ekb, evb;
#define AT_LOAD(pair, ka, va, kb_, vb_) do { attn_tile_load(2 * (pair), nt0, K0, k0s, V0, v0s, K1, k1s, V1, v1s, tid, ka, va); \
        attn_tile_load(2 * (pair) + 1, nt0, K0, k0s, V0, v0s, K1, k1s, V1, v1s, tid, kb_, vb_); } while (0)
#define AT_STORE(stage, pair, ka, va, kb_, vb_) do { LAS unsigned char* nb_ = lds + (stage) * 4 * AT_TILE; const bool nat_ = (MODE == 1) && (2 * (pair) >= nt0); \
        attn_tile_store(nb_, nb_ + AT_TILE, tid, ka, va, nat_); attn_tile_store(nb_ + 2 * AT_TILE, nb_ + 3 * AT_TILE, tid, kb_, vb_, nat_); } while (0)
#define AT_SLOWPATH(ip_, EXTRA) \
            mx = fmaxf(mx, __shfl_xor(mx, 32)); \
            const bool need = ((ip_) == 0) || (mx > 8.f); \
            if (__builtin_amdgcn_ballot_w64(need) != 0ull) { \
                const float delta = need ? mx : 0.f; \
                const float alpha = __builtin_amdgcn_exp2f(-delta); \
                m_run += delta; \
                _Pragma("unroll") for (int i = 0; i < 16; ++i) { EXTRA; o0[i] *= alpha; o1[i] *= alpha; lacc[i] *= alpha; } \
            }
#define AT_COMPUTE(ip_) do { \
        LAS unsigned char* base = lds + ((ip_) & 1) * 4 * AT_TILE; \
        const int ita = 2 * (ip_), itb = 2 * (ip_) + 1; \
        if (MODE == 1 && ita >= nt0) { \
            const int kra_ = rs_lo + (ita - nt0), krb_ = kra_ + 1; \
            const bool acta = (kra_ >= rsw_lo) && (kra_ < rsw_hi), actb = (krb_ >= rsw_lo) && (krb_ < rsw_hi); \
            if (acta || actb) { \
                f32x16 sa, sb; \
                _Pragma("unroll") for (int i = 0; i < 16; ++i) { sa[i] = -1e30f; sb[i] = -1e30f; } \
                float mx = -3.0e38f; \
                if (acta) { attn_qk32(base, qf, k0 + l32, half, -m_run, sa); \
                    attn_bias32(sa, rpbL + 64 + (kra_ - qr + 7) * 31 + (k0 - qc + 15) + 4 * half, k0 + 4 * half - cs, (kra_ >= rsq) && (kra_ < rsq + 8)); mx = attn_max16(sa); } \
                if (actb) { attn_qk32(base + 2 * AT_TILE, qf, k0 + l32, half, -m_run, sb); \
                    attn_bias32(sb, rpbL + 64 + (krb_ - qr + 7) * 31 + (k0 - qc + 15) + 4 * half, k0 + 4 * half - cs, (krb_ >= rsq) && (krb_ < rsq + 8)); mx = fmaxf(mx, attn_max16(sb)); } \
                AT_SLOWPATH(ip_, sa[i] -= delta; sb[i] -= delta) \
                if (acta) attn_pv32(base + AT_TILE, sa, l32, half, k0, ones, o0, o1, lacc); \
                if (actb) attn_pv32(base + 3 * AT_TILE, sb, l32, half, k0, ones, o0, o1, lacc); \
            } \
        } else { \
            f32x16 sa0, sa1, sb0, sb1; \
            attn_qk(base, qf, l32, half, -m_run, sa0, sa1); \
            attn_qk(base + 2 * AT_TILE, qf, l32, half, -m_run, sb0, sb1); \
            float mx = fmaxf(attn_max(sa0, sa1), attn_max(sb0, sb1)); \
            AT_SLOWPATH(ip_, sa0[i] -= delta; sa1[i] -= delta; sb0[i] -= delta; sb1[i] -= delta) \
            attn_pv(base + AT_TILE, sa0, sa1, l32, half, ones, o0, o1, lacc); \
            attn_pv(base + 3 * AT_TILE, sb0, sb1, l32, half, ones, o0, o1, lacc); \
        } } while (0)
    AT_LOAD(0, eka, eva, ekb, evb);
    AT_STORE(0, 0, eka, eva, ekb, evb);
    __syncthreads();
    for (int ip = 0; ip < np; ++ip) {
        if (ip + 1 < np) AT_LOAD(ip + 1, eka, eva, ekb, evb);
        AT_COMPUTE(ip);
        if (ip + 1 < np) AT_STORE((ip + 1) & 1, ip + 1, eka, eva, ekb, evb);
        __syncthreads();
    }
#undef AT_LOAD
#undef AT_STORE
#undef AT_COMPUTE
#undef AT_SLOWPATH
    const float inv = 1.f / lacc[0];
    {
        LAS float* ot = (LAS float*)lds;
#pragma unroll
        for (int dt = 0; dt < 2; ++dt)
#pragma unroll
            for (int i = 0; i < 16; ++i) ot[qrow * 65 + dt * 32 + crow(i, half)] = (dt == 0 ? o0[i] : o1[i]) * inv;
        __syncthreads();
#pragma unroll
        for (int j = 0; j < 4; ++j) {
            const int idx = tid + 512 * j, row = idx >> 3, pc = idx & 7;
            const u32x4 zz = *(const u32x4*)(Z + (size_t)row * zstride + pc * 8);
            const LAS float* sp = ot + row * 65 + pc * 8;
            u32x4 ov;
            ov.x = cvtpk(sp[0] * __uint_as_float(zz.x << 16), sp[1] * __uint_as_float(zz.x & 0xffff0000u));
            ov.y = cvtpk(sp[2] * __uint_as_float(zz.y << 16), sp[3] * __uint_as_float(zz.y & 0xffff0000u));
            ov.z = cvtpk(sp[4] * __uint_as_float(zz.z << 16), sp[5] * __uint_as_float(zz.z & 0xffff0000u));
            ov.w = cvtpk(sp[6] * __uint_as_float(zz.w << 16), sp[7] * __uint_as_float(zz.w & 0xffff0000u));
            if (usewt) wt16(wt, O + (size_t)row * ostride + pc * 8, ov); else *(u32x4*)(O + (size_t)row * ostride + pc * 8) = ov;
        }
        if (pcnt) asm volatile("s_waitcnt vmcnt(0)" ::: "memory");
        __syncthreads();
        if (pcnt && tid == 0) __hip_atomic_fetch_add(pcnt, 1u, __ATOMIC_RELAXED, __HIP_MEMORY_SCOPE_AGENT);
    }
}

DI int chain_base(int sid, int h, int dir) { return sid < 16 ? ((sid * 4 + h) * 2 + dir) * 2 : 256 + (((sid - 16) * 4 + h) * 2 + dir) * 32; }
DI int seq_rowbase(int sid) { return sid < 16 ? sid * 256 : MP + (sid - 16) * 4096; }
DI float chain_m0(const float* state_m, int sid, int h, int dir) { return sid < 16 ? 0.f : state_m[((sid - 16) * 2 + dir) * 4 + h]; }
DI float chain_m_at(const float* CH, int base, int js, float m0) {
    float m = m0;
    for (int i = 0; i < js; ++i) { const float bL = CH[(base + i) * 2], rmL = CH[(base + i) * 2 + 1]; m = bL + fmaxf(m, rmL); }
    return m;
}

DI void gate_scan_item(int sid, int h, int dir, int js, int lane, const float* G, const float* bg, float* SC, float* CH) {
    const int nc = sid < 16 ? 2 : 32, T = nc * 128, rb = seq_rowbase(sid);
    const float bi = bg[(dir * 2) * 4 + h], bff = bg[(dir * 2 + 1) * 4 + h];
    float ig[2], lf[2]; int row[2];
#pragma unroll
    for (int e = 0; e < 2; ++e) {
        const int Ppos = js * 128 + 2 * lane + e; const int t = dir ? (T - 1 - Ppos) : Ppos; row[e] = rb + t;
        ig[e] = G[(size_t)row[e] * 16 + (dir * 2) * 4 + h] + bi;
        const float fg = G[(size_t)row[e] * 16 + (dir * 2 + 1) * 4 + h] + bff;
        lf[e] = fminf(fg, 0.f) - log1pf(expf(-fabsf(fg)));
    }
    const float tot = lf[0] + lf[1];
    float x = tot;
#pragma unroll
    for (int o = 1; o < 64; o <<= 1) { const float y = __shfl_up(x, o); if (lane >= o) x += y; }
    const float excl = x - tot;
    const float b0 = excl + lf[0], b1 = excl + tot;
    const float a0 = ig[0] - b0, a1 = ig[1] - b1;
    const float lm = fmaxf(a0, a1);
    float xm = lm;
#pragma unroll
    for (int o = 1; o < 64; o <<= 1) { const float y = __shfl_up(xm, o); if (lane >= o) xm = fmaxf(xm, y); }
    float em = __shfl_up(xm, 1); if (lane == 0) em = -3.0e38f;
    const float rm0 = fmaxf(em, a0), rm1 = fmaxf(em, lm);
    *(f32x4*)(SC + ((size_t)row[0] * 8 + h * 2 + dir) * 4) = (f32x4){a0, b0, rm0, 0.f};
    *(f32x4*)(SC + ((size_t)row[1] * 8 + h * 2 + dir) * 4) = (f32x4){a1, b1, rm1, 0.f};
    if (lane == 63) { const int slot = chain_base(sid, h, dir) + js; CH[slot * 2] = b1; CH[slot * 2 + 1] = rm1; }
}

DI void qknorm_item(int row, int lane, const u32x4 (&rawqk)[2], const float* gq, const float* gk, bf16_t* Qb, bf16_t* Kb, float* out) {
    const bool sample = row >= MP;
    const int t = sample ? ((row - MP) & 4095) : 0;
    const int grow = t >> 6, gcol = t & 63;
    const int sub = lane & 7, d0 = sub * 8;
    const float pos = (float)((sub < 4) ? grow : gcol);
#pragma unroll
    for (int pass = 0; pass < 2; ++pass) {
        const u32x4 raw = rawqk[pass];
        float x[8];
        x[0] = __uint_as_float(raw.x << 16); x[1] = __uint_as_float(raw.x & 0xffff0000u);
        x[2] = __uint_as_float(raw.y << 16); x[3] = __uint_as_float(raw.y & 0xffff0000u);
        x[4] = __uint_as_float(raw.z << 16); x[5] = __uint_as_float(raw.z & 0xffff0000u);
        x[6] = __uint_as_float(raw.w << 16); x[7] = __uint_as_float(raw.w & 0xffff0000u);
        float ss = 0.f;
#pragma unroll
        for (int e = 0; e < 8; ++e) ss += x[e] * x[e];
        ss += __shfl_xor(ss, 1); ss += __shfl_xor(ss, 2); ss += __shfl_xor(ss, 4);
        const float r = rsqrtf(ss * (1.f / 64.f) + EPS);
        const float* gw = pass == 0 ? gq : gk;
        float y[8];
#pragma unroll
        for (int e = 0; e < 8; ++e) y[e] = x[e] * r * gw[d0 + e];
        if (pass == 1 && !sample && lane < 16) {
            const int hk = lane >> 3, b = row >> 8, tt = row & 255;
            float* o = out + O_GK + ((size_t)((b * 2 + hk) * 256 + tt)) * 64 + d0;
            *(f32x4*)o = (f32x4){y[0], y[1], y[2], y[3]}; *(f32x4*)(o + 4) = (f32x4){y[4], y[5], y[6], y[7]};
        }
        float z[8];
#pragma unroll
        for (int e = 0; e < 8; ++e) {
            const float partner = __shfl_xor(y[e], 2);
            if (sample) {
                const int i = (d0 + e) & 15;
                const float freq = __builtin_amdgcn_exp2f(-(float)i * (13.287712379549449f / 16.f));
                float rev = pos * freq * 0.15915494309189535f; rev -= floorf(rev);
                const float sn = __builtin_amdgcn_sinf(rev), cn = __builtin_amdgcn_cosf(rev);
                z[e] = (sub & 2) ? (partner * sn + y[e] * cn) : (y[e] * cn - partner * sn);
            } else z[e] = y[e];
        }
        if (pass == 0) {
#pragma unroll
            for (int e = 0; e < 8; ++e) z[e] *= QSCALE;
            u32x4 w; w.x = cvtpk(z[0], z[1]); w.y = cvtpk(z[2], z[3]); w.z = cvtpk(z[4], z[5]); w.w = cvtpk(z[6], z[7]);
            *(u32x4*)(Qb + (size_t)row * 512 + lane * 8) = w;
        } else if (lane < 16) {
            u32x4 w; w.x = cvtpk(z[0], z[1]); w.y = cvtpk(z[2], z[3]); w.z = cvtpk(z[4], z[5]); w.w = cvtpk(z[6], z[7]);
            *(u32x4*)(Kb + (size_t)row * 128 + lane * 8) = w;
        }
    }
}

DI void mlstm_u_item(LAS unsigned char* lds, int tid, int sid, int h, int dir, int js,
                     const float* SC, const float* CH, const float* state_m, const bf16_t* KT, const bf16_t* VT, bf16_t* U, float* Un, const WT& wtw, unsigned* ucnt) {
    const int lane = tid & 63, w = tid >> 6, l32 = lane & 31, half = lane >> 5;
    const int nc = sid < 16 ? 2 : 32, rb = seq_rowbase(sid);
    const int jt = dir ? nc - 1 - js : js, R0 = rb + jt * 128;
    const int base = chain_base(sid, h, dir), slot = base + js;
    const float Mx = CH[slot * 2 + 1];
    LAS float* wkL = (LAS float*)lds;
    if (tid < 128) wkL[tid] = expf(SC[((size_t)(R0 + tid) * 8 + h * 2 + dir) * 4] - Mx);
    const int vi = w & 3, kh = w >> 2;
    f32x16 acc0, acc1;
#pragma unroll
    for (int i = 0; i < 16; ++i) { acc0[i] = 0.f; acc1[i] = 0.f; }
    LAS unsigned char* VtL = lds + 1024; LAS unsigned char* KtL = lds + 1024 + 34816;
    {
        u32x4 rv[8];
        const int r0 = tid >> 4, pc = tid & 15;
        const bf16_t* gv = VT + (size_t)(h * 128 + r0) * MROWS + R0 + pc * 8;
        const bf16_t* gk = KT + (size_t)(h * 128 + r0) * MROWS + R0 + pc * 8;
#pragma unroll
        for (int i = 0; i < 8; ++i) rv[i] = *(const u32x4*)((i >> 2 ? gk : gv) + (size_t)(32 * (i & 3)) * MROWS);
        LAS unsigned char* lv = VtL + r0 * 272 + pc * 16;
#pragma unroll
        for (int i = 0; i < 8; ++i) *(LAS u32x4*)(lv + (i >> 2) * 34816 + (32 * (i & 3)) * 272) = rv[i];
    }
    __syncthreads();
#pragma unroll
    for (int s = 0; s < 8; ++s) {
        const int so = 16 * s + 8 * half;
        const u32x4 raw = *(const LAS u32x4*)(VtL + (vi * 32 + l32) * 272 + so * 2);
        const bf16x8 B0 = *(const LAS bf16x8*)(KtL + (kh * 64 + l32) * 272 + so * 2);
        const bf16x8 B1 = *(const LAS bf16x8*)(KtL + (kh * 64 + 32 + l32) * 272 + so * 2);
        const f32x4 wa = *(const LAS f32x4*)(wkL + so), wb = *(const LAS f32x4*)(wkL + so + 4);
        const bf16x8 A = pack8(__uint_as_float(raw.x << 16) * wa[0], __uint_as_float(raw.x & 0xffff0000u) * wa[1], __uint_as_float(raw.y << 16) * wa[2], __uint_as_float(raw.y & 0xffff0000u) * wa[3],
                               __uint_as_float(raw.z << 16) * wb[0], __uint_as_float(raw.z & 0xffff0000u) * wb[1], __uint_as_float(raw.w << 16) * wb[2], __uint_as_float(raw.w & 0xffff0000u) * wb[3]);
        acc0 = MFMA32(A, B0, acc0); acc1 = MFMA32(A, B1, acc1);
    }
    bf16_t* Uo = U + (size_t)slot * 16384;
    {
        LAS unsigned char* st = lds + 1024 + 2 * 34816 + w * 4608;
#pragma unroll
        for (int i = 0; i < 16; ++i) {
            const int v = crow(i, half);
            *(LAS bf16_t*)(st + v * 144 + l32 * 2) = f2bf(acc0[i]);
            *(LAS bf16_t*)(st + v * 144 + (32 + l32) * 2) = f2bf(acc1[i]);
        }
        asm volatile("s_waitcnt lgkmcnt(0)" ::: "memory");
#pragma unroll
        for (int j = 0; j < 4; ++j) {
            const int pidx = lane + 64 * j, row = pidx >> 3, pc = pidx & 7;
            const u32x4 val = *(const LAS u32x4*)(st + row * 144 + pc * 16);
            wt16(wtw, Uo + (vi * 32 + row) * 128 + kh * 64 + pc * 8, val);
        }
    }
    if (tid < 128) {
        float s = 0.f;
#pragma unroll
        for (int j = 0; j < 16; ++j) {
            const u32x4 raw = *(const LAS u32x4*)(KtL + tid * 272 + j * 16);
            s += __uint_as_float(raw.x << 16) * wkL[8 * j] + __uint_as_float(raw.x & 0xffff0000u) * wkL[8 * j + 1]
               + __uint_as_float(raw.y << 16) * wkL[8 * j + 2] + __uint_as_float(raw.y & 0xffff0000u) * wkL[8 * j + 3]
               + __uint_as_float(raw.z << 16) * wkL[8 * j + 4] + __uint_as_float(raw.z & 0xffff0000u) * wkL[8 * j + 5]
               + __uint_as_float(raw.w << 16) * wkL[8 * j + 6] + __uint_as_float(raw.w & 0xffff0000u) * wkL[8 * j + 7];
        }
        __hip_atomic_store(Un + slot * 128 + tid, s, __ATOMIC_RELAXED, __HIP_MEMORY_SCOPE_AGENT);
    }
    asm volatile("s_waitcnt vmcnt(0)" ::: "memory");
    __syncthreads();
    if (tid == 0 && ucnt) __hip_atomic_fetch_add(ucnt + 16 * (sid < 16 ? (sid * 4 + h) * 2 + dir : 128 + ((sid - 16) * 4 + h) * 2 + dir), 1u, __ATOMIC_RELAXED, __HIP_MEMORY_SCOPE_AGENT);
}

constexpr int ML_PITCH = 272, ML_ARR = 128 * ML_PITCH;
constexpr int ML_SCAL = 4 * ML_ARR;
DI void mlstm_out_item(LAS unsigned char* lds, int tid, int sid, int h, int jt,
                       const float* SC, const float* MJp, const float* nst, const bf16_t* Cst,
                       const bf16_t* P, const bf16_t* VT, const float* ghn, bf16_t* Yg, const WT& wtd, bool usewt, unsigned* pcnt) {
    const int lane = tid & 63, w = tid >> 6, l32 = lane & 31, half = lane >> 5;
    const int wt = w & 3, vh = w >> 2;
    const int nc = sid < 16 ? 2 : 32, rb = seq_rowbase(sid), R0 = rb + jt * 128;
    LAS unsigned char* KL = lds; LAS unsigned char* VL = lds + ML_ARR; LAS unsigned char* CL = lds + 2 * ML_ARR;
    LAS float* aL = (LAS float*)(lds + ML_SCAL);
    LAS float* nL = aL + 256;
    LAS float* ssqL = nL + 256;
    const int tl = wt * 32 + l32;
    const int qrow = R0 + tl;
    const int slot0 = chain_base(sid, h, 0) + jt, slot1 = chain_base(sid, h, 1) + (nc - 1 - jt);
    bf16x8 qf[8];
#pragma unroll
    for (int s = 0; s < 8; ++s) qf[s] = *(const bf16x8*)(P + (size_t)qrow * NP + C_QA + h * 128 + 16 * s + 8 * half);
    {
        u32x4 rk[4], rv[4], rc0[4], rc1[4];
#pragma unroll
        for (int i = 0; i < 4; ++i) {
            const int idx = tid + 512 * i, row = idx >> 4, pc = idx & 15;
            rk[i] = *(const u32x4*)(P + (size_t)(R0 + row) * NP + C_KA + h * 128 + pc * 8);
            rv[i] = *(const u32x4*)(VT + (size_t)(h * 128 + row) * MROWS + R0 + pc * 8);
            rc0[i] = *(const u32x4*)(Cst + (size_t)slot0 * 16384 + row * 128 + pc * 8);
            rc1[i] = *(const u32x4*)(Cst + (size_t)slot1 * 16384 + row * 128 + pc * 8);
        }
        float av = 0.f, nv = 0.f;
        if (tid < 256) {
            const int dir = tid >> 7, s2 = tid & 127;
            av = SC[((size_t)(R0 + s2) * 8 + h * 2 + dir) * 4];
            nv = nst[(size_t)(dir ? slot1 : slot0) * 128 + s2];
        }
#pragma unroll
        for (int i = 0; i < 4; ++i) {
            const int idx = tid + 512 * i, row = idx >> 4, pc = idx & 15;
            *(LAS u32x4*)(KL + row * ML_PITCH + pc * 16) = rk[i];
            *(LAS u32x4*)(CL + row * ML_PITCH + pc * 16) = rc0[i];
            *(LAS u32x4*)(CL + ML_ARR + row * ML_PITCH + pc * 16) = rc1[i];
            const int grp = pc >> 1, b3 = pc & 1;
            u32x2 lo = {rv[i].x, rv[i].y}, hi = {rv[i].z, rv[i].w};
            *(LAS u32x2*)(VL + row * ML_PITCH + (16 * grp + 4 * b3) * 2) = lo;
            *(LAS u32x2*)(VL + row * ML_PITCH + (16 * grp + 8 + 4 * b3) * 2) = hi;
        }
        if (tid < 256) { aL[tid] = av; nL[tid] = nv; }
    }
    __syncthreads();
    f32x16 hs0, hs1;
#pragma unroll
    for (int i = 0; i < 16; ++i) { hs0[i] = 0.f; hs1[i] = 0.f; }
#pragma unroll 1
    for (int dir = 0; dir < 2; ++dir) {
        const int js = dir ? nc - 1 - jt : jt;
        const float m = MJp[chain_base(sid, h, dir) + js];
        const f32x4 sc = *(const f32x4*)(SC + ((size_t)qrow * 8 + h * 2 + dir) * 4);
        const float mx = fmaxf(m, sc[2]);
        const float u_t = -mx, w_inter = expf(m - mx), flo = expf(-(sc[1] + mx));
        f32x16 a0, a1;
#pragma unroll
        for (int i = 0; i < 16; ++i) { a0[i] = 0.f; a1[i] = 0.f; }
        const LAS unsigned char* Cp = CL + dir * ML_ARR + (vh * 64 + l32) * ML_PITCH + 16 * half;
#pragma unroll
        for (int s = 0; s < 8; ++s) {
            const bf16x8 A0 = *(const LAS bf16x8*)(Cp + 32 * s);
            const bf16x8 A1 = *(const LAS bf16x8*)(Cp + 32 * ML_PITCH + 32 * s);
            a0 = MFMA32(A0, qf[s], a0); a1 = MFMA32(A1, qf[s], a1);
        }
#pragma unroll
        for (int i = 0; i < 16; ++i) { a0[i] *= w_inter; a1[i] *= w_inter; }
        float dq = 0.f;
#pragma unroll
        for (int s = 0; s < 8; ++s)
#pragma unroll
            for (int e = 0; e < 8; ++e) dq += bf2f((unsigned short)qf[s][e]) * nL[dir * 128 + 16 * s + 8 * half + e];
        dq += __shfl_xor(dq, 32);
        float rsum = 0.f;
        const int st_lo = dir ? wt : 0, st_hi = dir ? 3 : wt;
        for (int st = st_lo; st <= st_hi; ++st) {
            f32x16 S;
#pragma unroll
            for (int i = 0; i < 16; ++i) S[i] = 0.f;
            const LAS unsigned char* Kp = KL + (st * 32 + l32) * ML_PITCH + 16 * half;
#pragma unroll
            for (int s = 0; s < 8; ++s) { const bf16x8 A = *(const LAS bf16x8*)(Kp + 32 * s); S = MFMA32(A, qf[s], S); }
#pragma unroll
            for (int i = 0; i < 16; ++i) {
                const int sl = st * 32 + crow(i, half);
                const bool valid = dir ? (sl >= tl) : (sl <= tl);
                const float dcy = __expf(u_t + aL[dir * 128 + sl]);
                const float p = valid ? S[i] * dcy : 0.f;
                S[i] = p; rsum += p;
            }
            const bf16x8 pf0 = pack8(S[0], S[1], S[2], S[3], S[4], S[5], S[6], S[7]);
            const bf16x8 pf1 = pack8(S[8], S[9], S[10], S[11], S[12], S[13], S[14], S[15]);
            const LAS unsigned char* Vp = VL + (vh * 64 + l32) * ML_PITCH + (st * 32 + 8 * half) * 2;
            {
                const bf16x8 A0 = *(const LAS bf16x8*)(Vp), A1 = *(const LAS bf16x8*)(Vp + 32 * ML_PITCH);
                a0 = MFMA32(A0, pf0, a0); a1 = MFMA32(A1, pf0, a1);
                const bf16x8 B0 = *(const LAS bf16x8*)(Vp + 32), B1 = *(const LAS bf16x8*)(Vp + 32 * ML_PITCH + 32);
                a0 = MFMA32(B0, pf1, a0); a1 = MFMA32(B1, pf1, a1);
            }
        }
        rsum += __shfl_xor(rsum, 32);
        const float den = w_inter * dq + rsum;
        const float inv = 1.f / fmaxf(fabsf(den), flo);
#pragma unroll
        for (int i = 0; i < 16; ++i) { hs0[i] += a0[i] * inv; hs1[i] += a1[i] * inv; }
    }
    float ssq = 0.f;
#pragma unroll
    for (int i = 0; i < 16; ++i) ssq += hs0[i] * hs0[i] + hs1[i] * hs1[i];
    ssq += __shfl_xor(ssq, 32);
    if (half == 0) ssqL[w * 32 + l32] = ssq;
    __syncthreads();
    const float tot = ssq + ssqL[(w ^ 4) * 32 + l32];
    const float rn = rsqrtf(tot * (1.f / 128.f) + EPS);
    {
        LAS float* ht = (LAS float*)lds;
#pragma unroll
        for (int vt = 0; vt < 2; ++vt)
#pragma unroll
            for (int i = 0; i < 16; ++i) ht[tl * 129 + vh * 64 + vt * 32 + crow(i, half)] = (vt == 0 ? hs0[i] : hs1[i]) * rn;
        __syncthreads();
#pragma unroll
        for (int j = 0; j < 4; ++j) {
            const int idx = tid + 512 * j, row = idx >> 4, pc = idx & 15, col = h * 128 + pc * 8;
            const bf16_t* prow = P + (size_t)(R0 + row) * NP;
            const u32x4 oa = *(const u32x4*)(prow + C_OA + col), zz = *(const u32x4*)(prow + C_Z + col);
            const f32x4 g0 = *(const f32x4*)(ghn + col), g1 = *(const f32x4*)(ghn + col + 4);
            const LAS float* sp = ht + row * 129 + pc * 8;
            u32x4 ov;
            ov.x = cvtpk(sp[0] * g0[0] * sigmf(__uint_as_float(oa.x << 16)) * __uint_as_float(zz.x << 16), sp[1] * g0[1] * sigmf(__uint_as_float(oa.x & 0xffff0000u)) * __uint_as_float(zz.x & 0xffff0000u));
            ov.y = cvtpk(sp[2] * g0[2] * sigmf(__uint_as_float(oa.y << 16)) * __uint_as_float(zz.y << 16), sp[3] * g0[3] * sigmf(__uint_as_float(oa.y & 0xffff0000u)) * __uint_as_float(zz.y & 0xffff0000u));
            ov.z = cvtpk(sp[4] * g1[0] * sigmf(__uint_as_float(oa.z << 16)) * __uint_as_float(zz.z << 16), sp[5] * g1[1] * sigmf(__uint_as_float(oa.z & 0xffff0000u)) * __uint_as_float(zz.z & 0xffff0000u));
            ov.w = cvtpk(sp[6] * g1[2] * sigmf(__uint_as_float(oa.w << 16)) * __uint_as_float(zz.w << 16), sp[7] * g1[3] * sigmf(__uint_as_float(oa.w & 0xffff0000u)) * __uint_as_float(zz.w & 0xffff0000u));
            if (usewt) wt16(wtd, Yg + (size_t)(R0 + row) * DM + col, ov); else *(u32x4*)(Yg + (size_t)(R0 + row) * DM + col) = ov;
        }
    }
    if (pcnt) asm volatile("s_waitcnt vmcnt(0)" ::: "memory");
    __syncthreads();
    if (pcnt && tid == 0) __hip_atomic_fetch_add(pcnt + 16 * (R0 >> 8), 1u, __ATOMIC_RELAXED, __HIP_MEMORY_SCOPE_AGENT);
}

DI void transpose_item(const float* W, int K, int N, bf16_t* WT, LAS float* scr, int item, int lane) {
    const int nblk = (N + 31) / 32, kb = item / nblk, nb = item % nblk, k0 = 64 * kb, n0 = 32 * nb;
    const int nn = n0 + (lane & 31);
    float tv[32];
#pragma unroll
    for (int i = 0; i < 32; ++i) { const int kk = 2 * i + (lane >> 5); tv[i] = (nn < N) ? W[(size_t)(k0 + kk) * N + nn] : 0.f; }
#pragma unroll
    for (int i = 0; i < 32; ++i) { const int kk = 2 * i + (lane >> 5); scr[kk * 33 + (lane & 31)] = tv[i]; }
    asm volatile("s_waitcnt lgkmcnt(0)" ::: "memory");
    const int c = lane & 7;
#pragma unroll
    for (int j = 0; j < 4; ++j) { const int n = (lane >> 3) + 8 * j; const LAS float* s = scr + (8 * c) * 33 + n;
        u32x4 o; o.x = cvtpk(s[0 * 33], s[1 * 33]); o.y = cvtpk(s[2 * 33], s[3 * 33]); o.z = cvtpk(s[4 * 33], s[5 * 33]); o.w = cvtpk(s[6 * 33], s[7 * 33]);
        *(u32x4*)(WT + (size_t)(n0 + n) * K + k0 + 8 * c) = o; }
    asm volatile("s_waitcnt lgkmcnt(0)" ::: "memory");
}

template <int NR>
DI void prenorm_rows(const float* const (&xrow)[NR], const float* gpre, const float* const (&md)[NR], bf16_t* const (&orow)[NR], int lane) {
    f32x4 v[NR][4];
#pragma unroll
    for (int r = 0; r < NR; ++r)
#pragma unroll
        for (int j = 0; j < 4; ++j) v[r][j] = *(const f32x4*)(xrow[r] + 4 * lane + 256 * j);
#pragma unroll
    for (int r = 0; r < NR; ++r) {
        float s = 0.f;
#pragma unroll
        for (int j = 0; j < 4; ++j) s += (v[r][j].x * v[r][j].x + v[r][j].y * v[r][j].y) + (v[r][j].z * v[r][j].z + v[r][j].w * v[r][j].w);
        const float rr = rsqrtf(wave_sum(s) * (1.f / DM) + EPS);
#pragma unroll
        for (int j = 0; j < 4; ++j) {
            const int c = 4 * lane + 256 * j;
            const f32x4 g = *(const f32x4*)(gpre + c), a = *(const f32x4*)(md[r] + 1024 + c), b = *(const f32x4*)(md[r] + c);
            f32x4 o;
#pragma unroll
            for (int e = 0; e < 4; ++e) o[e] = v[r][j][e] * rr * g[e] * (1.f + a[e]) + b[e];
            u32x2 w; w.x = cvtpk(o[0], o[1]); w.y = cvtpk(o[2], o[3]);
            *(u32x2*)(orow[r] + c) = w;
        }
    }
}
template <bool NEXT, int NR, bool XBF, bool X1BF>
DI void postnorm_rows(const float* const (&xrow)[NR], const bf16_t* const (&yrow)[NR], const float* gpost, const float* const (&md0)[NR], float* const (&x1row)[NR],
                      const float* gpre, const float* const (&md1)[NR], bf16_t* const (&hrow)[NR], int lane) {
    f32x4 y[NR][4], x[NR][4];
#pragma unroll
    for (int r = 0; r < NR; ++r)
#pragma unroll
        for (int j = 0; j < 4; ++j) {
            const u32x2 raw = *(const u32x2*)(yrow[r] + 4 * lane + 256 * j);
            y[r][j] = (f32x4){__uint_as_float(raw.x << 16), __uint_as_float(raw.x & 0xffff0000u), __uint_as_float(raw.y << 16), __uint_as_float(raw.y & 0xffff0000u)};
            if (XBF) {
                const u32x2 rx = *(const u32x2*)((const bf16_t*)xrow[r] + 4 * lane + 256 * j);
                x[r][j] = (f32x4){__uint_as_float(rx.x << 16), __uint_as_float(rx.x & 0xffff0000u), __uint_as_float(rx.y << 16), __uint_as_float(rx.y & 0xffff0000u)};
            } else x[r][j] = *(const f32x4*)(xrow[r] + 4 * lane + 256 * j);
        }
#pragma unroll
    for (int r = 0; r < NR; ++r) {
        float s = 0.f;
#pragma unroll
        for (int j = 0; j < 4; ++j) s += (y[r][j].x * y[r][j].x + y[r][j].y * y[r][j].y) + (y[r][j].z * y[r][j].z + y[r][j].w * y[r][j].w);
        const float rr = rsqrtf(wave_sum(s) * (1.f / DM) + EPS);
        float s1 = 0.f;
#pragma unroll
        for (int j = 0; j < 4; ++j) {
            const int c = 4 * lane + 256 * j;
            const f32x4 g = *(const f32x4*)(gpost + c), gt = *(const f32x4*)(md0[r] + 2048 + c);
#pragma unroll
            for (int e = 0; e < 4; ++e) x[r][j][e] = x[r][j][e] + gt[e] * (y[r][j][e] * rr * g[e]);
            if (X1BF) { u32x2 wx; wx.x = cvtpk(x[r][j][0], x[r][j][1]); wx.y = cvtpk(x[r][j][2], x[r][j][3]); *(u32x2*)((bf16_t*)x1row[r] + c) = wx; }
            else *(f32x4*)(x1row[r] + c) = x[r][j];
            s1 += (x[r][j].x * x[r][j].x + x[r][j].y * x[r][j].y) + (x[r][j].z * x[r][j].z + x[r][j].w * x[r][j].w);
        }
        if (NEXT) {
            const float r1 = rsqrtf(wave_sum(s1) * (1.f / DM) + EPS);
#pragma unroll
            for (int j = 0; j < 4; ++j) {
                const int c = 4 * lane + 256 * j;
                const f32x4 g = *(const f32x4*)(gpre + c), a = *(const f32x4*)(md1[r] + 1024 + c), b = *(const f32x4*)(md1[r] + c);
                f32x4 o;
#pragma unroll
                for (int e = 0; e < 4; ++e) o[e] = x[r][j][e] * r1 * g[e] * (1.f + a[e]) + b[e];
                u32x2 w; w.x = cvtpk(o[0], o[1]); w.y = cvtpk(o[2], o[3]);
                *(u32x2*)(hrow[r] + c) = w;
            }
        }
    }
}

#define XB_TMO      128
#define XB_XCNT(j)  (256  + 64 * (j))
#define XB_XSUB(j)  (1280 + 64 * (j))
#define XB_XGEN(j)  (2304 + 64 * (j))
#define XB_TOP      3328
#define XB_TOPGEN   3392
#define XCD_BAR_WORDS 3456
#define XB_SPIN_CAP (1u << 18)
DI unsigned xb_ld(unsigned* p)              { return __hip_atomic_load(p, __ATOMIC_RELAXED, __HIP_MEMORY_SCOPE_AGENT); }
DI unsigned xb_add(unsigned* p, unsigned v) { return __hip_atomic_fetch_add(p, v, __ATOMIC_RELAXED, __HIP_MEMORY_SCOPE_AGENT); }
DI unsigned xb_xcc_id() { return (unsigned)__builtin_amdgcn_s_getreg((3 << 11) | 20) & 0xFu; }
#define XB_SPIN(cond, bar) do { unsigned _sp = 0; while (cond) { __builtin_amdgcn_s_sleep(1); \
    if ((++_sp & 255u) == 0u) { if (xb_ld(&(bar)[XB_TMO])) break; if (_sp > XB_SPIN_CAP) { atomicAdd(&(bar)[XB_TMO], 1u); break; } } } } while (0)
struct XcdBarrier { unsigned* bar; unsigned x; volatile LAS unsigned* st; };
DI XcdBarrier xcd_barrier_post(unsigned* bar, volatile LAS unsigned* st) {
    XcdBarrier b; b.bar = bar; b.x = xb_xcc_id(); b.st = st;
    if (threadIdx.x == 0) (void)xb_add(&bar[XB_XCNT(b.x)], 1u);
    return b;
}
DI void xcd_barrier_complete(unsigned* bar, unsigned x, unsigned& nloc, unsigned& nx) {
    const unsigned G = gridDim.x * gridDim.y * gridDim.z;
    unsigned sum, cnt, mine, sp = 0u;
    for (;;) {
        sum = 0u; cnt = 0u; mine = 0u;
#pragma unroll
        for (unsigned j = 0; j < 16; ++j) { const unsigned c = xb_ld(&bar[XB_XCNT(j)]); sum += c; cnt += (c > 0u) ? 1u : 0u; mine = (j == x) ? c : mine; }
        if (sum == G) break;
        __builtin_amdgcn_s_sleep(1);
        if ((++sp & 255u) == 0u) { if (xb_ld(&bar[XB_TMO])) break; if (sp > XB_SPIN_CAP) { atomicAdd(&bar[XB_TMO], 1u); break; } }
    }
    nloc = mine > 0u ? mine : 1u; nx = cnt > 0u ? cnt : 1u;
}
DI void xcd_barrier(const XcdBarrier& b) {
    asm volatile("s_waitcnt vmcnt(0)" ::: "memory");
    __syncthreads();
    if (threadIdx.x == 0) {
        unsigned* bar = b.bar;
        __builtin_amdgcn_s_waitcnt(0);
        unsigned nloc = b.st[0], nx = b.st[1];
        if (nloc == 0u) { xcd_barrier_complete(bar, b.x, nloc, nx); b.st[0] = nloc; b.st[1] = nx; }
        const unsigned old = xb_add(&bar[XB_XSUB(b.x)], 1u);
        const unsigned gen = old / nloc;
        if (old + 1u == (gen + 1u) * nloc) {
            __builtin_amdgcn_fence(__ATOMIC_RELEASE, "agent");
            asm volatile("s_waitcnt vmcnt(0)" ::: "memory");
            const unsigned og = xb_add(&bar[XB_TOP], 1u);
            const unsigned tg = og / nx;
            if (og + 1u == (tg + 1u) * nx) xb_add(&bar[XB_TOPGEN], 1u);
            else XB_SPIN(xb_ld(&bar[XB_TOPGEN]) == tg, bar);
            __builtin_amdgcn_fence(__ATOMIC_ACQUIRE, "agent");
            xb_add(&bar[XB_XGEN(b.x)], 1u);
            asm volatile("s_waitcnt vmcnt(0)" ::: "memory");
        } else {
            XB_SPIN(xb_ld(&bar[XB_XGEN(b.x)]) == gen, bar);
            __builtin_amdgcn_fence(__ATOMIC_ACQUIRE, "agent");
            asm volatile("s_waitcnt vmcnt(0)" ::: "memory");
        }
    }
    __syncthreads();
}

__global__ void __launch_bounds__(512, 2) fwd_megakernel(Params p) {
    extern __shared__ __attribute__((aligned(16))) unsigned char lds_raw[];
    LAS unsigned char* lds = (LAS unsigned char*)lds_raw;
    cg::grid_group grid = cg::this_grid();
    const int tid = threadIdx.x;
    const int G = gridDim.x, blk = blockIdx.x;
#define lane ((int)(threadIdx.x & 63u))
#define wave (__builtin_amdgcn_readfirstlane((int)(threadIdx.x >> 6)))
#define gw (blk * 8 + wave)
    const int NGW = G * 8;
    unsigned char* ws = p.ws;
    float* out = p.out;
    const float* x_prompt = p.in[0]; const float* x_sample = p.in[1];
    const float* st_C = p.in[2]; const float* st_n = p.in[3]; const float* st_m = p.in[4];
    const float* gpre = p.in[13]; const float* gpost = p.in[14];
    float* MOD = (float*)(ws + WS_MOD); float* Gt = (float*)(ws + WS_G); float* SC = (float*)(ws + WS_SC); float* CH = (float*)(ws + WS_CH);
    float* UN = (float*)(ws + WS_UN); float* NST = (float*)(ws + WS_NST); float* MJ = (float*)(ws + WS_MJ);
    bf16_t* CK = (bf16_t*)(ws + WS_CK); bf16_t* CVT = (bf16_t*)(ws + WS_CVT); bf16_t* NK = (bf16_t*)(ws + WS_NK); bf16_t* NVT = (bf16_t*)(ws + WS_NVT);
    bf16_t* WINE = (bf16_t*)(ws + WS_WINE); bf16_t* WOUTE = (bf16_t*)(ws + WS_WOUTE); bf16_t* WINO = (bf16_t*)(ws + WS_WINO); bf16_t* WOUTO = (bf16_t*)(ws + WS_WOUTO);
    bf16_t* H = (bf16_t*)(ws + WS_H); bf16_t* KT = (bf16_t*)(ws + WS_KT); bf16_t* VT = (bf16_t*)(ws + WS_VT); bf16_t* Y2 = (bf16_t*)(ws + WS_Y2);
    bf16_t* P = (bf16_t*)(ws + WS_P); bf16_t* CST = (bf16_t*)(ws + WS_CST); bf16_t* QB = (bf16_t*)(ws + WS_QB); bf16_t* KB = (bf16_t*)(ws + WS_KB);
    bf16_t* VBT = (bf16_t*)(ws + WS_VBT); bf16_t* U = (bf16_t*)(ws + WS_U); bf16_t* VCT = (bf16_t*)(ws + WS_VCT);
    bf16_t* X1P = (bf16_t*)(ws + WS_X1P); bf16_t* X1S = (bf16_t*)(ws + WS_X1S);
#define X1ROW(r) ((r) < MP ? X1P + (size_t)(r) * DM : X1S + (size_t)((r) - MP) * DM)
    const int lo = p.ph_lo, hi = p.ph_hi;
    volatile LAS unsigned* bst = (volatile LAS unsigned*)(lds + LDS_BYTES - 64);
    if (tid == 0) { bst[0] = 0u; bst[1] = 0u; }
    __syncthreads();
    XcdBarrier xbar = xcd_barrier_post((unsigned*)(ws + WS_BAR), bst);
    if (p.coop == 2) grid.sync();
#define IN(k) (lo <= (k) && (k) < hi)
#define SEAM(k) do { if (p.coop && IN(k) && IN((k) + 1)) { for (int sr_ = 0; sr_ < SYNC_REP; ++sr_) xcd_barrier(xbar); } } while (0)
#define REPEAT(k) _Pragma("unroll 1") for (int rep_ = 0; rep_ < 1 + ((REP_MASK >> (k)) & 1); ++rep_)

    if (IN(0)) REPEAT(0) {
        for (int mb = blk; mb < 192; mb += G) {
            const int l = mb / 96, j0 = (mb % 96) * 32;
            LAS float* sL = (LAS float*)lds;
            LAS float* red = sL + 3072;
            for (int i = tid; i < 3072; i += 512) { const int v = i >> 10, k = i & 1023; const float cv = (v == 0) ? p.in[10][k] : p.in[9][(v - 1) * 1024 + k]; sL[i] = siluf(cv); }
            __syncthreads();
            const int col = tid & 31, kg = tid >> 5;
            float a0 = 0.f, a1 = 0.f, a2 = 0.f;
            const float* wp = p.in[11] + ((size_t)l * 1024 + kg * 64) * 3072 + j0 + col;
#pragma unroll
            for (int i0 = 0; i0 < 64; i0 += 32) {
                float wv[32];
#pragma unroll
                for (int i = 0; i < 32; ++i) wv[i] = wp[(size_t)(i0 + i) * 3072];
#pragma unroll
                for (int i = 0; i < 32; ++i) { const int k = kg * 64 + i0 + i; a0 += sL[k] * wv[i]; a1 += sL[1024 + k] * wv[i]; a2 += sL[2048 + k] * wv[i]; }
            }
            red[(0 * 16 + kg) * 32 + col] = a0; red[(1 * 16 + kg) * 32 + col] = a1; red[(2 * 16 + kg) * 32 + col] = a2;
            __syncthreads();
            if (tid < 96) { const int v = tid >> 5, c = tid & 31; float s = p.in[12][l * 3072 + j0 + c];
                for (int k2 = 0; k2 < 16; ++k2) s += red[(v * 16 + k2) * 32 + c];
                __hip_atomic_store(MOD + (l * 3 + v) * 3072 + j0 + c, s, __ATOMIC_RELAXED, __HIP_MEMORY_SCOPE_AGENT); }
            asm volatile("s_waitcnt vmcnt(0)" ::: "memory");
            __syncthreads();
            if (tid == 0) __hip_atomic_fetch_add((unsigned*)(ws + 16384) + 16 * 160, 1u, __ATOMIC_RELAXED, __HIP_MEMORY_SCOPE_AGENT);
        }
        {
            LAS float* scr = (LAS float*)(lds + wave * 16384);
            const int I_E = 16 * 121, I_O = 16 * 32;
            for (int it = gw; it < I_E + I_O; it += NGW) {
                if (it < I_E) transpose_item(p.in[15], 1024, 3856, WINE, scr, it, lane);
                else transpose_item(p.in[20], 1024, 1024, WOUTE, scr, it - I_E, lane);
            }
        }
        {
            const int gt = blk * 512 + tid, NT = G * 512;
            for (int i = gt; i < 65536; i += NT) {
                CK[i] = f2bf(p.in[5][i]);
                const int d = i & 63, s = (i >> 6) & 255, bh = i >> 14;
                CVT[(bh * 64 + d) * 256 + s] = f2bf(p.in[6][i]);
            }
        }
        __syncthreads();
        if (tid == 0) {
            unsigned* c = (unsigned*)(ws + 16384) + 16 * 160; unsigned spins = 0;
            while (__hip_atomic_load(c, __ATOMIC_RELAXED, __HIP_MEMORY_SCOPE_AGENT) < 192u) { __builtin_amdgcn_s_sleep(1); if (++spins > (1u << 22)) break; }
            __builtin_amdgcn_fence(__ATOMIC_ACQUIRE, "agent");
            asm volatile("s_waitcnt vmcnt(0)" ::: "memory");
        }
        __syncthreads();
    }
    if (IN(1)) REPEAT(1) {
        for (int row0 = gw; row0 < MROWS; row0 += 2 * NGW) {
            const float* xr[2]; const float* md[2]; bf16_t* orow[2];
#pragma unroll
            for (int r = 0; r < 2; ++r) {
                const int row = min(row0 + r * NGW, MROWS - 1);
                const int v = row < MP ? 0 : 1 + ((row - MP) >> 12);
                xr[r] = row < MP ? x_prompt + (size_t)row * DM : x_sample + (size_t)(row - MP) * DM;
                md[r] = MOD + (0 * 3 + v) * 3072; orow[r] = H + (size_t)row * DM;
            }
            prenorm_rows<2>(xr, gpre, md, orow, lane);
        }
    }
    SEAM(1);
    if (IN(2)) REPEAT(2) {
        pg8::Gemm g{H, WINE, MROWS, 4096, 1024}; pg8::StaticOrder S; S.init(MROWS, 4096, G, blk);
        EpiEvenIn E{P, KT, VT, VBT, Gt, out};
        pg8::gemm_phase(lds, g, S, E);
    }
    SEAM(2);
    if (IN(3)) REPEAT(3) {
        for (int it = gw; it < 768; it += NGW) {
            int sid, h, dir, js;
            if (it < 256) { js = it & 1; dir = (it >> 1) & 1; h = (it >> 2) & 3; sid = it >> 4; }
            else { const int r = it - 256; js = r & 31; dir = (r >> 5) & 1; h = (r >> 6) & 3; sid = 16 + (r >> 8); }
            gate_scan_item(sid, h, dir, js, lane, Gt, p.in[16], SC, CH);
        }
        for (int row0 = gw; row0 < MROWS; row0 += 2 * NGW) {
            const int row1 = row0 + NGW; const bool two = row1 < MROWS;
            u32x4 ra[2], rb[2];
            ra[0] = *(const u32x4*)(P + (size_t)row0 * NP + C_QB + lane * 8); ra[1] = *(const u32x4*)(P + (size_t)row0 * NP + C_KB + lane * 8);
            if (two) { rb[0] = *(const u32x4*)(P + (size_t)row1 * NP + C_QB + lane * 8); rb[1] = *(const u32x4*)(P + (size_t)row1 * NP + C_KB + lane * 8); }
            qknorm_item(row0, lane, ra, p.in[18], p.in[19], QB, KB, out);
            if (two) qknorm_item(row1, lane, rb, p.in[18], p.in[19], QB, KB, out);
        }
    }
    SEAM(3);
    const bool gate67 = (G >= (MROWS / 256) * (DM / 256)) && p.coop && IN(4) && IN(5) && IN(6) && IN(7);
    unsigned* pcntA = (unsigned*)(ws + 65536);
    const bool gate45 = (G == 256) && p.coop && IN(4) && IN(5) && IN(6);
    unsigned* ucnt = (unsigned*)(ws + 49152);
    if (IN(4)) REPEAT(4) {
        const WT wtw4 = mk_wt(ws, (unsigned)WS_END);
        const int NIT = 256 + 768 + 128;
        for (int it = blk; it < NIT; it += G) {
            if (it < 256) {
                const int xcd = it & 7, jj = it >> 3, b = xcd >> 2, kv = (xcd >> 1) & 1, idx = (xcd & 1) * 32 + jj, qh = kv * 4 + (idx & 3), qblk = idx >> 2;
                const int rowq = MP + b * 4096 + qblk * 256;
                attn_item<0>(lds, tid, QB + (size_t)rowq * 512 + qh * 64, 512,
                             CK + (size_t)((b * 2 + kv) * 256) * 64, 64, CVT + (size_t)((b * 2 + kv) * 64) * 256, 256, 4,
                             KB + (size_t)(MP + b * 4096) * 128 + kv * 64, 128, VBT + (size_t)(kv * 64) * MROWS + MP + b * 4096, MROWS, 64,
                             0, 0, nullptr,
                             P + (size_t)rowq * NP + C_Z + 512 + qh * 64, NP, H + (size_t)rowq * DM + 512 + qh * 64, DM, wtw4, gate67, gate67 ? pcntA + 16 * (rowq >> 8) : nullptr);
            } else if (it < 256 + 768) {
                const int r0 = it - 256; int sid, h, dir, js;
                if (r0 < 256) { js = r0 & 1; dir = (r0 >> 1) & 1; h = (r0 >> 2) & 3; sid = r0 >> 4; }
                else { const int r = r0 - 256; js = r & 31; dir = (r >> 5) & 1; h = (r >> 6) & 3; sid = 16 + (r >> 8); }
                mlstm_u_item(lds, tid, sid, h, dir, js, SC, CH, st_m, KT, VT, U, UN, wtw4, gate45 ? ucnt : nullptr);
            } else {
                const int r = it - 1024, qh = r & 7, b = r >> 3, kv = qh >> 2;
                const int rowq = b * 256;
                attn_item<0>(lds, tid, QB + (size_t)rowq * 512 + qh * 64, 512,
                             KB, 128, VBT, MROWS, 0,
                             KB + (size_t)rowq * 128 + kv * 64, 128, VBT + (size_t)(kv * 64) * MROWS + rowq, MROWS, 4,
                             0, 0, nullptr,
                             P + (size_t)rowq * NP + C_Z + 512 + qh * 64, NP, H + (size_t)rowq * DM + 512 + qh * 64, DM, wtw4, gate67, gate67 ? pcntA + 16 * (rowq >> 8) : nullptr);
            }
        }
    }
    if (!gate45) SEAM(4);
    const bool gate56 = (G == 256) && p.coop && IN(5) && IN(6);
    unsigned* chcnt = (unsigned*)(ws + 32768);
    if (IN(5)) REPEAT(5) {
        const WT wtw = mk_wt(ws, (unsigned)WS_END);
        const int NT = G * 512;
        const int nS = 16 * 2048, nP = 128 * 2048;
        const int perS = (nS + G - 1) / G;
        const int nvb = gate56 ? 2 : 1;
        const int sblk = gate56 ? blk - 128 : blk;
        if (!gate56 || blk >= 128) {
            for (int ps = 0; ps < 2; ++ps) {
                const int pass = 1 - ps;
                if (gate45) {
                    if (tid == 0) {
                        unsigned spins = 0; bool ok = false;
                        while (!ok) {
                            ok = true;
                            for (int vbi = 0; vbi < 2; ++vbi) {
                                const int vb = sblk + 128 * vbi;
                                if (pass == 1) {
                                    ok = ok && __hip_atomic_load(ucnt + 16 * (vb >> 2), __ATOMIC_RELAXED, __HIP_MEMORY_SCOPE_AGENT) >= 2u
                                            && __hip_atomic_load(ucnt + 16 * ((vb >> 2) + 64), __ATOMIC_RELAXED, __HIP_MEMORY_SCOPE_AGENT) >= 2u;
                                    if (vb < 36) for (int q = 0; q < 4; ++q) { const int c = vb * 4 + q; ok = ok && __hip_atomic_load(ucnt + 16 * c, __ATOMIC_RELAXED, __HIP_MEMORY_SCOPE_AGENT) >= (c < 128 ? 2u : 32u); }
                                } else ok = ok && __hip_atomic_load(ucnt + 16 * (128 + (vb >> 4)), __ATOMIC_RELAXED, __HIP_MEMORY_SCOPE_AGENT) >= 32u;
                            }
                            if (!ok) { __builtin_amdgcn_s_sleep(1); if (++spins > (1u << 22)) break; }
                        }
                        __builtin_amdgcn_fence(__ATOMIC_ACQUIRE, "agent");
                        asm volatile("s_waitcnt vmcnt(0)" ::: "memory");
                    }
                    __syncthreads();
                }
                for (int vbi = 0; vbi < nvb; ++vbi) {
                    const int vb = sblk + 128 * vbi;
                    int i0, i1, st;
                    if (pass == 1) { i0 = vb * 512 + tid; i1 = nP; st = NT; }
                    else if (gate56) { const bool on = (vbi == 0) && (tid < 256); i0 = on ? (sblk + 128 * (tid >> 7)) * 128 + (tid & 127) : 0; i1 = on ? i0 + 1 : 0; st = 1; }
                    else { i0 = vb * perS + tid; i1 = min((vb + 1) * perS, nS); st = 512; }
                    for (int idx0 = i0; idx0 < i1; idx0 += st) {
            const int idx = pass == 0 ? nP + idx0 : idx0;
            const int chain = idx >> 11, e8 = (idx & 2047) * 8;
            int sid, h, dir;
            if (chain < 128) { dir = chain & 1; h = (chain >> 1) & 3; sid = chain >> 3; } else { const int r = chain - 128; dir = r & 1; h = (r >> 1) & 3; sid = 16 + (r >> 3); }
            const int nc = sid < 16 ? 2 : 32, base = chain_base(sid, h, dir);
            float cur[8];
            if (sid < 16) {
#pragma unroll
                for (int e = 0; e < 8; ++e) cur[e] = 0.f;
            } else {
                const float* c0 = st_C + ((size_t)(((sid - 16) * 2 + dir) * 4 + h)) * 16384 + e8;
                const f32x4 a = *(const f32x4*)c0, b = *(const f32x4*)(c0 + 4);
                cur[0] = a[0]; cur[1] = a[1]; cur[2] = a[2]; cur[3] = a[3]; cur[4] = b[0]; cur[5] = b[1]; cur[6] = b[2]; cur[7] = b[3];
            }
            float m = chain_m0(st_m, sid, h, dir);
            const bf16_t* __restrict__ Ub = U + (size_t)base * 16384 + e8;
            bf16_t* __restrict__ Cb = CST + (size_t)base * 16384 + e8;
            for (int js0 = 0; js0 < nc; js0 += 8) {
                u32x4 raw[8];
#pragma unroll
                for (int j = 0; j < 8; ++j) if (js0 + j < nc) raw[j] = *(const u32x4*)(Ub + (size_t)(js0 + j) * 16384);
#pragma unroll
                for (int j = 0; j < 8; ++j) if (js0 + j < nc) {
                    const int js = js0 + j;
                    const float bL = CH[(base + js) * 2], rmL = CH[(base + js) * 2 + 1];
                    const float Mx = fmaxf(m, rmL), a = expf(m - Mx), f = expf(rmL - Mx);
                    if (e8 == 0) __hip_atomic_store(MJ + base + js, m, __ATOMIC_RELAXED, __HIP_MEMORY_SCOPE_AGENT);
                    u32x4 wv; wv.x = cvtpk(cur[0], cur[1]); wv.y = cvtpk(cur[2], cur[3]); wv.z = cvtpk(cur[4], cur[5]); wv.w = cvtpk(cur[6], cur[7]);
                    wt16(wtw, Cb + (size_t)js * 16384, wv);
                    cur[0] = a * cur[0] + f * __uint_as_float(raw[j].x << 16); cur[1] = a * cur[1] + f * __uint_as_float(raw[j].x & 0xffff0000u);
                    cur[2] = a * cur[2] + f * __uint_as_float(raw[j].y << 16); cur[3] = a * cur[3] + f * __uint_as_float(raw[j].y & 0xffff0000u);
                    cur[4] = a * cur[4] + f * __uint_as_float(raw[j].z << 16); cur[5] = a * cur[5] + f * __uint_as_float(raw[j].z & 0xffff0000u);
                    cur[6] = a * cur[6] + f * __uint_as_float(raw[j].w << 16); cur[7] = a * cur[7] + f * __uint_as_float(raw[j].w & 0xffff0000u);
                    m = bL + Mx;
                }
            }
            if (sid < 16) {
                float* o = out + O_C + ((size_t)((sid * 2 + dir) * 4 + h)) * 16384 + e8;
                *(f32x4*)o = (f32x4){cur[0], cur[1], cur[2], cur[3]}; *(f32x4*)(o + 4) = (f32x4){cur[4], cur[5], cur[6], cur[7]};
            }
                            }
                }
                if (pass == 1) {
                    for (int vbi = 0; vbi < nvb; ++vbi)
                    for (int idx = (sblk + 128 * vbi) * 512 + tid; idx < 144 * 128; idx += NT) {
            const int chain = idx >> 7, k = idx & 127;
            int sid, h, dir;
            if (chain < 128) { dir = chain & 1; h = (chain >> 1) & 3; sid = chain >> 3; } else { const int r = chain - 128; dir = r & 1; h = (r >> 1) & 3; sid = 16 + (r >> 3); }
            const int nc = sid < 16 ? 2 : 32, base = chain_base(sid, h, dir);
            float cur = sid < 16 ? 0.f : st_n[(((sid - 16) * 2 + dir) * 4 + h) * 128 + k];
            float m = chain_m0(st_m, sid, h, dir);
            for (int js0 = 0; js0 < nc; js0 += 8) {
                float un[8];
#pragma unroll
                for (int j = 0; j < 8; ++j) if (js0 + j < nc) un[j] = UN[(size_t)(base + js0 + j) * 128 + k];
#pragma unroll
                for (int j = 0; j < 8; ++j) if (js0 + j < nc) {
                    const int js = js0 + j;
                    const float bL = CH[(base + js) * 2], rmL = CH[(base + js) * 2 + 1];
                    const float Mx = fmaxf(m, rmL), a = expf(m - Mx), f = expf(rmL - Mx);
                    __hip_atomic_store(NST + (size_t)(base + js) * 128 + k, cur, __ATOMIC_RELAXED, __HIP_MEMORY_SCOPE_AGENT);
                    cur = a * cur + f * un[j];
                    m = bL + Mx;
                }
            }
            if (sid < 16) {
                out[O_N + ((size_t)((sid * 2 + dir) * 4 + h)) * 128 + k] = cur;
                if (k == 0) out[O_M + (sid * 2 + dir) * 4 + h] = m;
            }
                            }
                }
                if (gate56) {
                    asm volatile("s_waitcnt vmcnt(0)" ::: "memory");
                    __syncthreads();
                    if (tid == 0) {
                        for (int vbi = 0; vbi < 2; ++vbi) {
                            const int vb = sblk + 128 * vbi;
                            if (pass == 1) {
                                __hip_atomic_fetch_add(chcnt + 16 * (vb >> 2), 1u, __ATOMIC_RELAXED, __HIP_MEMORY_SCOPE_AGENT);
                                __hip_atomic_fetch_add(chcnt + 16 * ((vb >> 2) + 64), 1u, __ATOMIC_RELAXED, __HIP_MEMORY_SCOPE_AGENT);
                                if (vb < 36) for (int q = 0; q < 4; ++q) __hip_atomic_fetch_add(chcnt + 16 * (vb * 4 + q), 1u, __ATOMIC_RELAXED, __HIP_MEMORY_SCOPE_AGENT);
                            } else {
                                __hip_atomic_fetch_add(chcnt + 16 * (128 + (vb >> 4)), 1u, __ATOMIC_RELAXED, __HIP_MEMORY_SCOPE_AGENT);
                            }
                        }
                    }
                }
            }
        } else {
            const int r = blk, jt = r & 1, h = (r >> 1) & 3, sid = r >> 3;
            if (tid == 0) {
                const int c0 = (sid * 4 + h) * 2; unsigned spins = 0;
                while (__hip_atomic_load(chcnt + 16 * c0, __ATOMIC_RELAXED, __HIP_MEMORY_SCOPE_AGENT) < 5u ||
                       __hip_atomic_load(chcnt + 16 * (c0 + 1), __ATOMIC_RELAXED, __HIP_MEMORY_SCOPE_AGENT) < 5u) { __builtin_amdgcn_s_sleep(1); if (++spins > (1u << 22)) break; }
                __builtin_amdgcn_fence(__ATOMIC_ACQUIRE, "agent");
                asm volatile("s_waitcnt vmcnt(0)" ::: "memory");
            }
            __syncthreads();
            mlstm_out_item(lds, tid, sid, h, jt, SC, MJ, NST, CST, P, VT, p.in[17], H, wtw, gate67, gate67 ? pcntA : nullptr);
        }
    }
    if (!gate56) SEAM(5);
    if (IN(6)) REPEAT(6) {
        const WT wtw = mk_wt(ws, (unsigned)WS_END);
        for (int it = blk; it < (gate56 ? 256 : 384); it += G) {
            int sid, h, jt;
            if (it < 256) { jt = it & 31; h = (it >> 5) & 3; sid = 16 + (it >> 7); }
            else { const int r = it - 256; jt = r & 1; h = (r >> 1) & 3; sid = r >> 3; }
            if (gate56) {
                if (tid == 0) {
                    const int c0 = 128 + ((sid - 16) * 4 + h) * 2; unsigned spins = 0;
                    while (__hip_atomic_load(chcnt + 16 * c0, __ATOMIC_RELAXED, __HIP_MEMORY_SCOPE_AGENT) < 17u ||
                           __hip_atomic_load(chcnt + 16 * (c0 + 1), __ATOMIC_RELAXED, __HIP_MEMORY_SCOPE_AGENT) < 17u) { __builtin_amdgcn_s_sleep(1); if (++spins > (1u << 22)) break; }
                    __builtin_amdgcn_fence(__ATOMIC_ACQUIRE, "agent");
                    asm volatile("s_waitcnt vmcnt(0)" ::: "memory");
                }
                __syncthreads();
            }
            mlstm_out_item(lds, tid, sid, h, jt, SC, MJ, NST, CST, P, VT, p.in[17], H, wtw, gate67, gate67 ? pcntA : nullptr);
        }
    }
    if (!gate67) SEAM(6);
    const bool fuse_mid = (G >= (MROWS / 256) * (DM / 256));
    if (IN(7)) REPEAT(7) {
        pg8::Gemm g{H, WOUTE, MROWS, 1024, 1024}; pg8::StaticOrder S; S.init(MROWS, 1024, G, blk);
        if (fuse_mid) {
            if (gate67) {
                pg8::Unit u0;
                if (S.next(0, u0)) {
                    if (tid == 0) {
                        unsigned spins = 0;
                        while (__hip_atomic_load(pcntA + 16 * u0.pm, __ATOMIC_RELAXED, __HIP_MEMORY_SCOPE_AGENT) < 16u) { __builtin_amdgcn_s_sleep(1); if (++spins > (1u << 22)) break; }
                        __builtin_amdgcn_fence(__ATOMIC_ACQUIRE, "agent");
                        asm volatile("s_waitcnt vmcnt(0)" ::: "memory");
                    }
                }
                __syncthreads();
            }
            EpiMid E{x_prompt, x_sample, MOD, gpost, gpre + DM, X1P, X1S, H, (float*)(ws + WS_G), (unsigned*)(ws + 16384)};
            pg8::gemm_phase(lds, g, S, E);
        } else {
            EpiPlain E{Y2, DM};
            pg8::gemm_phase(lds, g, S, E);
        }
        {
            const int nunits = (MROWS / 256) * (DM / 256);
            const bool some_idle = G > nunits;
            if (!some_idle || blk >= nunits) {
                const int nw = some_idle ? G - nunits : G, ib = some_idle ? blk - nunits : blk;
                LAS float* scr = (LAS float*)(lds + wave * 16384);
                const int I_C = 16 * 128, I_O = 16 * 32;
                for (int it = ib * 8 + wave; it < I_C + I_O; it += nw * 8) {
                    if (it < I_C) transpose_item(p.in[21], 1024, 4096, WINO, scr, it, lane);
                    else transpose_item(p.in[23], 1024, 1024, WOUTO, scr, it - I_C, lane);
                }
                const int NT = nw * 512;
                for (int i0 = ib * 512 + tid; i0 < 524288; i0 += 4 * NT) {
                    float ka[4], va[4];
#pragma unroll
                    for (int k = 0; k < 4; ++k) { const int i = i0 + k * NT; if (i < 524288) { ka[k] = p.in[7][i]; va[k] = p.in[8][i]; } }
#pragma unroll
                    for (int k = 0; k < 4; ++k) { const int i = i0 + k * NT; if (i < 524288) {
                        NK[i] = f2bf(ka[k]);
                        const int d = i & 63, s2 = (i >> 6) & 255, bh = i >> 14;
                        NVT[(bh * 64 + d) * 256 + s2] = f2bf(va[k]); } }
                }
            }
        }
    }
    SEAM(7);
    if (!fuse_mid) {
    if (IN(8)) REPEAT(8) {
        for (int row0 = gw; row0 < MROWS; row0 += 2 * NGW) {
            const float* xr[2]; const bf16_t* yr[2]; const float* md0[2]; const float* md1[2]; float* x1r[2]; bf16_t* hr[2];
#pragma unroll
            for (int r = 0; r < 2; ++r) {
                const int row = min(row0 + r * NGW, MROWS - 1);
                const int v = row < MP ? 0 : 1 + ((row - MP) >> 12);
                xr[r] = row < MP ? x_prompt + (size_t)row * DM : x_sample + (size_t)(row - MP) * DM;
                yr[r] = Y2 + (size_t)row * DM; md0[r] = MOD + (0 * 3 + v) * 3072; md1[r] = MOD + (1 * 3 + v) * 3072;
                x1r[r] = (float*)X1ROW(row); hr[r] = H + (size_t)row * DM;
            }
            postnorm_rows<true, 2, false, true>(xr, yr, gpost, md0, x1r, gpre + DM, md1, hr, lane);
        }
    }
    SEAM(8);
    }
    if (IN(9)) REPEAT(9) {
        pg8::Gemm g{H, WINO, MROWS, 4096, 1024}; pg8::StaticOrder S; S.init(MROWS, 4096, G, blk);
        EpiOddIn E{P, VCT, out};
        pg8::gemm_phase(lds, g, S, E);
    }
    SEAM(9);
    const bool gate1011 = (G >= (MROWS / 256) * (DM / 256)) && p.coop && IN(10) && IN(11);
    unsigned* pcntB = (unsigned*)(ws + 62464);
    if (IN(10)) REPEAT(10) {
        const WT wtw10 = mk_wt(ws, (unsigned)WS_END);
        LAS float* rpbL = (LAS float*)(lds + 8 * AT_TILE);
        for (int it = blk; it < 512 + 256; it += G) {
            if (it < 512) {
                const int xcd = it & 7, jj = (it >> 3) & 31, b = it >> 8, h = 2 * xcd + (jj >> 4), rblk = jj & 15;
                for (int i = tid; i < 640; i += 512) { const int j = i - 64; rpbL[i] = (j >= 0 && j < 465) ? p.in[22][h * 465 + j] * LOG2E : 0.f; }
                const int r0 = rblk * 4;
                const int rs_lo = min(max(r0 - 4, 0), 56), rs_hi = min(max(r0 + 3 - 4, 0), 56) + 7;
                const int rowq = MP + b * 4096 + r0 * 64, rowk = MP + b * 4096 + rs_lo * 64;
                attn_item<1>(lds, tid, P + (size_t)rowq * NP + h * 64, NP,
                             NK + (size_t)((b * 16 + h) * 256) * 64, 64, NVT + (size_t)((b * 16 + h) * 64) * 256, 256, 4,
                             P + (size_t)rowk * NP + 1024 + h * 64, NP, VCT + (size_t)(h * 64) * MROWS + rowk, MROWS, rs_hi - rs_lo + 1,
                             r0, rs_lo, rpbL,
                             P + (size_t)rowq * NP + 3072 + h * 64, NP, H + (size_t)rowq * DM + h * 64, DM, wtw10, gate1011, gate1011 ? pcntB + 16 * (rowq >> 8) : nullptr);
            } else {
                const int r = it - 512, h = r & 15, b = r >> 4;
                const int rowq = b * 256;
                attn_item<0>(lds, tid, P + (size_t)rowq * NP + h * 64, NP,
                             P, NP, VCT, MROWS, 0,
                             P + (size_t)rowq * NP + 1024 + h * 64, NP, VCT + (size_t)(h * 64) * MROWS + rowq, MROWS, 4,
                             0, 0, nullptr,
                             P + (size_t)rowq * NP + 3072 + h * 64, NP, H + (size_t)rowq * DM + h * 64, DM, wtw10, gate1011, gate1011 ? pcntB + 16 * (rowq >> 8) : nullptr);
            }
        }
    }
    if (!gate1011) SEAM(10);
    const bool fuse_last = (G >= (MROWS / 256) * (DM / 256));
    if (IN(11)) REPEAT(11) {
        pg8::Gemm g{H, WOUTO, MROWS, 1024, 1024}; pg8::StaticOrder S; S.init(MROWS, 1024, G, blk);
        if (fuse_last) {
            if (gate1011) {
                pg8::Unit u0;
                if (S.next(0, u0)) {
                    if (tid == 0) {
                        unsigned spins = 0;
                        while (__hip_atomic_load(pcntB + 16 * u0.pm, __ATOMIC_RELAXED, __HIP_MEMORY_SCOPE_AGENT) < 16u) { __builtin_amdgcn_s_sleep(1); if (++spins > (1u << 22)) break; }
                        __builtin_amdgcn_fence(__ATOMIC_ACQUIRE, "agent");
                        asm volatile("s_waitcnt vmcnt(0)" ::: "memory");
                    }
                }
                __syncthreads();
            }
            EpiFinal E{X1P, X1S, MOD, gpost + DM, out, (float*)(ws + WS_G), (unsigned*)(ws + 16384)};
            pg8::gemm_phase(lds, g, S, E);
        } else {
            EpiPlain E{Y2, DM};
            pg8::gemm_phase(lds, g, S, E);
        }
    }
    if (!fuse_last) {
    SEAM(11);
    if (IN(12)) {
        for (int row0 = gw; row0 < MROWS; row0 += 2 * NGW) {
            const float* xr[2]; const bf16_t* yr[2]; const float* md1[2]; float* x1r[2]; bf16_t* hr[2];
#pragma unroll
            for (int r = 0; r < 2; ++r) {
                const int row = min(row0 + r * NGW, MROWS - 1);
                const int v = row < MP ? 0 : 1 + ((row - MP) >> 12);
                xr[r] = (const float*)X1ROW(row); yr[r] = Y2 + (size_t)row * DM; md1[r] = MOD + (1 * 3 + v) * 3072; x1r[r] = out + (size_t)row * DM; hr[r] = nullptr;
            }
            postnorm_rows<false, 2, true, false>(xr, yr, gpost + DM, md1, x1r, nullptr, md1, hr, lane);
        }
    }
    }
#undef IN
#undef SEAM
#undef REPEAT
#undef lane
#undef wave
#undef gw
#undef X1ROW
}

#ifndef MK_COOP
#define MK_COOP 1
#endif
extern "C" void kernel_launch(void* const* d_in, const int* in_sizes, int n_in, void* d_out, int out_size, void* d_ws, size_t ws_size, hipStream_t stream) {
    static int grid = 0;
    if (grid == 0) {
        int dev = 0, cus = 0, per_cu = 0;
        (void)hipGetDevice(&dev);
        (void)hipDeviceGetAttribute(&cus, hipDeviceAttributeMultiprocessorCount, dev);
        (void)hipFuncSetAttribute((const void*)fwd_megakernel, hipFuncAttributeMaxDynamicSharedMemorySize, LDS_BYTES);
        (void)hipOccupancyMaxActiveBlocksPerMultiprocessor(&per_cu, (const void*)fwd_megakernel, 512, LDS_BYTES);
        if (per_cu < 1) { fprintf(stderr, "kernel_launch: occupancy query returned %d\n", per_cu); per_cu = 1; }
        grid = cus * per_cu;
        if (ws_size < WS_END) fprintf(stderr, "kernel_launch: workspace too small (%zu < %zu)\n", ws_size, (size_t)WS_END);
    }
    Params p{};
    for (int i = 0; i < 24; ++i) p.in[i] = (const float*)d_in[i];
    p.out = (float*)d_out; p.ws = (unsigned char*)d_ws;
#if MK_COOP
    p.ph_lo = 0; p.ph_hi = 13; p.coop = 1; p.pad = 0;
    void* args[] = {&p};
    (void)hipMemsetAsync((char*)d_ws + WS_BAR, 0, 131072, stream);
    hipError_t e = hipLaunchCooperativeKernel((const void*)fwd_megakernel, dim3(grid), dim3(512), args, LDS_BYTES, stream);
    if (e != hipSuccess) fprintf(stderr, "cooperative launch failed: %s (grid %d)\n", hipGetErrorString(e), grid);
#else
    for (int ph = 0; ph < 13; ++ph) {
        p.ph_lo = ph; p.ph_hi = ph + 1; p.coop = 0; p.pad = 0;
        hipLaunchKernelGGL(fwd_megakernel, dim3(grid), dim3(512), LDS_BYTES, stream, p);
    }
#endif
}
```

```cpp
#include <hip/hip_runtime.h>
#include <hip/hip_cooperative_groups.h>
#include <cstdio>
#include <cstdint>
namespace cg = cooperative_groups;

#define LAS __attribute__((address_space(3)))
#define DI __device__ __forceinline__
typedef unsigned short bf16_t;
typedef short bf16x8 __attribute__((ext_vector_type(8)));
typedef short s16x4 __attribute__((ext_vector_type(4)));
typedef float f32x4 __attribute__((ext_vector_type(4)));
typedef float f32x2 __attribute__((ext_vector_type(2)));
typedef float f32x16 __attribute__((ext_vector_type(16)));
typedef unsigned u32x4 __attribute__((ext_vector_type(4)));
typedef unsigned u32x2 __attribute__((ext_vector_type(2)));
typedef __bf16 bf16x2_t __attribute__((ext_vector_type(2)));

constexpr int DM = 1024, MP = 4096, MS = 8192, MROWS = 12288, NP = 4096;
constexpr float EPS = 1e-6f;
constexpr float LOG2E = 1.4426950408889634f;
constexpr float QSCALE = 0.125f * LOG2E;
constexpr int C_QA = 0, C_KA = 512, C_VA = 1024, C_OA = 1536, C_G = 2048, C_QB = 2064, C_KB = 2576, C_VB = 2704, C_Z = 2832, C_END = 3856;
constexpr size_t O_YP = 0, O_YS = 4194304, O_C = 12582912, O_N = 14680064, O_M = 14696448, O_GK = 14696576, O_GV = 15220864, O_NK = 15745152, O_NV = 19939456;
constexpr size_t MiB = 1u << 20;
constexpr size_t WS_BAR = 0;
constexpr size_t WS_MOD = 1 * MiB;
constexpr size_t WS_G = 2 * MiB;
constexpr size_t WS_SC = 3 * MiB;
constexpr size_t WS_CH = 5 * MiB;
constexpr size_t WS_UN = 5 * MiB + 65536;
constexpr size_t WS_NST = 5 * MiB + 65536 + 393216;
constexpr size_t WS_MJ = 5 * MiB + 65536 + 786432;
constexpr size_t WS_CK = 6 * MiB;
constexpr size_t WS_CVT = 6 * MiB + 131072;
constexpr size_t WS_NK = 7 * MiB;
constexpr size_t WS_NVT = 8 * MiB;
constexpr size_t WS_WINE = 10 * MiB;
constexpr size_t WS_WOUTE = 18 * MiB;
constexpr size_t WS_WINO = 20 * MiB;
constexpr size_t WS_WOUTO = 28 * MiB;
constexpr size_t WS_H = 30 * MiB;
constexpr size_t WS_KT = 54 * MiB;
constexpr size_t WS_VT = 66 * MiB;
constexpr size_t WS_Y2 = 54 * MiB;
constexpr size_t WS_P = 78 * MiB;
constexpr size_t WS_CST = 174 * MiB;
constexpr size_t WS_QB = 198 * MiB;
constexpr size_t WS_KB = 210 * MiB;
constexpr size_t WS_VBT = 213 * MiB;
constexpr size_t WS_U = 216 * MiB;
constexpr size_t WS_VCT = 216 * MiB;
constexpr size_t WS_X1P = 10 * MiB;
constexpr size_t WS_X1S = 240 * MiB;
constexpr size_t WS_END = 256 * MiB;

constexpr int REP_MASK = 0, SYNC_REP = 1;
constexpr int LDS_BYTES = 147456;

DI float bf2f(unsigned short b) { return __uint_as_float(((unsigned)b) << 16); }
DI unsigned cvtpk(float lo, float hi) { f32x2 v = {lo, hi}; bf16x2_t b = __builtin_convertvector(v, bf16x2_t); return __builtin_bit_cast(unsigned, b); }
DI unsigned short f2bf(float x) { return (unsigned short)(cvtpk(x, 0.f) & 0xffffu); }
DI float siluf(float x) { return x / (1.f + __expf(-x)); }
DI float sigmf(float x) { return 1.f / (1.f + __expf(-x)); }
DI float wave_sum(float v) {
#pragma unroll
    for (int o = 1; o < 64; o <<= 1) v += __shfl_xor(v, o);
    return v;
}
DI int crow(int i, int h) { return (i & 3) + 8 * (i >> 2) + 4 * h; }
DI bf16x8 pack8(float a0, float a1, float a2, float a3, float a4, float a5, float a6, float a7) {
    u32x4 p; p.x = cvtpk(a0, a1); p.y = cvtpk(a2, a3); p.z = cvtpk(a4, a5); p.w = cvtpk(a6, a7);
    return __builtin_bit_cast(bf16x8, p);
}
#define MFMA32(a, b, c) __builtin_amdgcn_mfma_f32_32x32x16_bf16((a), (b), (c), 0, 0, 0)

namespace pg8 {
constexpr int BM = 256, BK = 64, HALF = 128, HTB = HALF * BK * 2, NXCD = 8, WGM = 8;
DI int lds_byte(int r, int c) { const int st = (r >> 4) * 2 + (c >> 5), rr = r & 15, cc = c & 31, ob = rr * 64 + cc * 2; return st * 1024 + (ob ^ (((ob >> 9) & 1) << 5)); }
DI void stage_rc(int b, int& R, int& C) { const int st = b / 1024, sb = b % 1024, swz = sb ^ (((sb >> 9) & 1) << 5); R = (st >> 1) * 16 + swz / 64; C = (st & 1) * 32 + (swz % 64) / 2; }
DI int perm32(int rho) { const int n = rho >> 4, i = rho & 15; return 8 * (i >> 2) + 4 * n + (i & 3); }
struct Unit { int pm, pn; };
struct Gemm { const bf16_t* A; const bf16_t* Bt; int M, N, K; };
struct StaticOrder {
    int nM, nN, nwg, G, c;
    DI void init(int M, int N, int G_, int c_) { nM = M / BM; nN = N / BM; nwg = nM * nN; G = G_; c = c_; }
    DI bool next(int i, Unit& u) const {
        const long L = (long)i * G + c; if (L >= nwg) return false;
        int wgid = (int)L; { const int q = nwg / NXCD, r = nwg % NXCD, xcd = wgid % NXCD, off = wgid / NXCD; wgid = (xcd < r ? xcd * (q + 1) : r * (q + 1) + (xcd - r) * q) + off; }
        const int nig = WGM * nN, gid = wgid / nig, fm = gid * WGM, gsz = (nM - fm) < WGM ? (nM - fm) : WGM;
        u.pm = fm + ((wgid % nig) % gsz); u.pn = (wgid % nig) / gsz; return true;
    }
};
template <class Epi>
DI void gemm_phase(LAS unsigned char* lds, const Gemm g, const StaticOrder& S, const Epi& E) {
    const int tid = threadIdx.x, wid = __builtin_amdgcn_readfirstlane(tid >> 6), lane = tid & 63, wr = wid >> 2, wc = wid & 3, fr = lane & 15, fq = lane >> 4;
    const int K = g.K, nt = K / BK;
    unsigned voffA[2], voffB[2];
#pragma unroll
    for (int i = 0; i < 2; ++i) { int R, C; stage_rc(tid * 16 + i * 8192, R, C); const int Rb = (R & ~31) + perm32(R & 31);
        voffA[i] = (unsigned)(R * K + C) * 2u; voffB[i] = (unsigned)(Rb * K + C) * 2u; }
    const size_t kstep = (size_t)(BK * 2);
    const size_t hstep = (size_t)HALF * K * 2;
    const size_t tstep = 2 * hstep;
    const unsigned ldsw = (unsigned)wid * 1024u;
    const int aoff = lds_byte(wr * 64 + fr, fq * 8), boff = lds_byte(wc * 32 + fr, fq * 8);
#define PG8_SA(b, h) (((b) * 2 + (h)) * HTB)
#define PG8_SB(b, h) ((4 + (b) * 2 + (h)) * HTB)
#define PG8_STAGE(bufoff, gbase, voff) do { _Pragma("unroll") for (int _i = 0; _i < 2; ++_i) \
        __builtin_amdgcn_global_load_lds((const unsigned*)((const char*)(gbase) + (voff)[_i]), (LAS unsigned*)(lds + (bufoff) + ldsw + _i * 8192), 16, 0, 0); } while (0)
#define PG8_LDA(dst, b, h) do { _Pragma("unroll") for (int m = 0; m < 4; ++m) _Pragma("unroll") for (int k = 0; k < 2; ++k) dst[m][k] = *(const LAS bf16x8*)(lds + PG8_SA(b, h) + aoff + m * 2048 + k * 1024); } while (0)
#define PG8_LDB(dst, b, h) do { _Pragma("unroll") for (int n = 0; n < 2; ++n) _Pragma("unroll") for (int k = 0; k < 2; ++k) dst[n][k] = *(const LAS bf16x8*)(lds + PG8_SB(b, h) + boff + n * 2048 + k * 1024); } while (0)
#define PG8_MMA(ai, bj, At, Bt) do { __builtin_amdgcn_s_setprio(1); _Pragma("unroll") for (int m = 0; m < 4; ++m) _Pragma("unroll") for (int n = 0; n < 2; ++n) _Pragma("unroll") for (int k = 0; k < 2; ++k) \
        acc[ai][bj][m][n] = __builtin_amdgcn_mfma_f32_16x16x32_bf16(Bt[n][k], At[m][k], acc[ai][bj][m][n], 0, 0, 0); __builtin_amdgcn_s_setprio(0); } while (0)
#define PG8_WAIT_V(n) asm volatile("s_waitcnt vmcnt(" #n ")" ::: "memory")
#define PG8_WAIT_L(n) asm volatile("s_waitcnt lgkmcnt(" #n ")" ::: "memory")
#define PG8_BAR __builtin_amdgcn_s_barrier()
#define PG8_SCHED __builtin_amdgcn_sched_barrier(0)
    Unit cur, nxt; int ui = 0;
    if (!S.next(0, cur)) return;
    f32x4 acc[2][2][4][2];
#pragma unroll
    for (int a = 0; a < 2; ++a)
#pragma unroll
        for (int b = 0; b < 2; ++b)
#pragma unroll
            for (int m = 0; m < 4; ++m)
#pragma unroll
                for (int n = 0; n < 2; ++n) acc[a][b][m][n] = (f32x4){0.f, 0.f, 0.f, 0.f};
    bf16x8 At[4][2], B0[2][2], B1[2][2];
    const char* cA = (const char*)g.A + (size_t)cur.pm * tstep; const char* cB = (const char*)g.Bt + (size_t)cur.pn * tstep;
    PG8_STAGE(PG8_SB(0, 0), cB, voffB); PG8_STAGE(PG8_SB(0, 1), cB + hstep, voffB); PG8_STAGE(PG8_SA(0, 0), cA, voffA); PG8_STAGE(PG8_SA(0, 1), cA + hstep, voffA);
    if (wr == 1) PG8_BAR;
    PG8_WAIT_V(2); PG8_BAR;
    PG8_STAGE(PG8_SB(1, 0), cB + kstep, voffB); PG8_STAGE(PG8_SA(1, 0), cA + kstep, voffA); PG8_STAGE(PG8_SB(1, 1), cB + hstep + kstep, voffB);
    PG8_WAIT_V(6); PG8_BAR;
    for (;;) {
        const bool has_next = S.next(ui + 1, nxt);
        const char* nA = has_next ? (const char*)g.A + (size_t)nxt.pm * tstep : cA; const char* nB = has_next ? (const char*)g.Bt + (size_t)nxt.pn * tstep : cB;
        for (int t = 0; t < nt; t += 2) {
            const bool last = (t == nt - 2);
            const char* a1 = cA + (size_t)(t + 1) * kstep;
            const char* a2 = last ? nA : cA + (size_t)(t + 2) * kstep; const char* b2 = last ? nB : cB + (size_t)(t + 2) * kstep;
            const char* a3 = a2 + kstep; const char* b3 = b2 + kstep;
            PG8_LDB(B0, 0, 0); PG8_LDB(B1, 0, 1); PG8_SCHED; PG8_LDA(At, 0, 0); PG8_STAGE(PG8_SA(1, 1), a1 + hstep, voffA);
            PG8_WAIT_V(8); PG8_WAIT_L(0); PG8_BAR; PG8_MMA(0, 0, At, B0); PG8_MMA(0, 1, At, B1); PG8_BAR; PG8_SCHED;
            PG8_LDA(At, 0, 1); PG8_STAGE(PG8_SB(0, 0), b2, voffB); PG8_STAGE(PG8_SB(0, 1), b2 + hstep, voffB); PG8_STAGE(PG8_SA(0, 0), a2, voffA);
            PG8_WAIT_V(8); PG8_WAIT_L(0); PG8_BAR; PG8_MMA(1, 0, At, B0); PG8_MMA(1, 1, At, B1); PG8_BAR; PG8_SCHED;
            PG8_LDB(B0, 1, 0); PG8_LDB(B1, 1, 1); PG8_SCHED; PG8_LDA(At, 1, 0); PG8_STAGE(PG8_SA(0, 1), a2 + hstep, voffA);
            PG8_WAIT_V(8); PG8_WAIT_L(0); PG8_BAR; PG8_MMA(0, 0, At, B0); PG8_MMA(0, 1, At, B1); PG8_BAR; PG8_SCHED;
            PG8_LDA(At, 1, 1); PG8_STAGE(PG8_SB(1, 0), b3, voffB); PG8_STAGE(PG8_SB(1, 1), b3 + hstep, voffB); PG8_STAGE(PG8_SA(1, 0), a3, voffA);
            PG8_WAIT_V(8); PG8_WAIT_L(0); PG8_BAR; PG8_MMA(1, 0, At, B0); PG8_MMA(1, 1, At, B1); PG8_BAR; PG8_SCHED;
        }
        if (wr == 0) PG8_BAR;
        if constexpr (!Epi::AFTER_DRAIN) E(acc, cur, wr, wc, fr, fq);
        if (!has_next) break;
#pragma unroll
        for (int a = 0; a < 2; ++a)
#pragma unroll
            for (int b = 0; b < 2; ++b)
#pragma unroll
                for (int m = 0; m < 4; ++m)
#pragma unroll
                    for (int n = 0; n < 2; ++n) acc[a][b][m][n] = (f32x4){0.f, 0.f, 0.f, 0.f};
        cur = nxt; cA = nA; cB = nB; ++ui;
        if (wr == 1) PG8_BAR;
    }
    PG8_WAIT_V(0);
    PG8_BAR;
    if constexpr (Epi::AFTER_DRAIN) E.fused(acc, cur, wr, wc, fr, fq, lds, wid, lane);
#undef PG8_SA
#undef PG8_SB
#undef PG8_STAGE
#undef PG8_LDA
#undef PG8_LDB
#undef PG8_MMA
#undef PG8_WAIT_V
#undef PG8_WAIT_L
#undef PG8_BAR
#undef PG8_SCHED
}
}

struct Params {
    const float* in[24];
    float* out;
    unsigned char* ws;
    int ph_lo, ph_hi, coop, pad;
};

struct WT { __amdgpu_buffer_rsrc_t rs; const unsigned char* base; };
DI WT mk_wt(const void* base, unsigned bytes) { WT w; w.rs = __builtin_amdgcn_make_buffer_rsrc((void*)base, (short)0, (int)bytes, 0x00020000); w.base = (const unsigned char*)base; return w; }
DI void wt16(const WT& w, const void* p, u32x4 v) { __builtin_amdgcn_raw_buffer_store_b128(v, w.rs, (unsigned)((const unsigned char*)p - w.base), 0, 16); }
DI void st_bf16x8(bf16_t* p, f32x4 a, f32x4 b) {
    u32x4 w; w.x = cvtpk(a[0], a[1]); w.y = cvtpk(a[2], a[3]); w.z = cvtpk(b[0], b[1]); w.w = cvtpk(b[2], b[3]);
    *(u32x4*)p = w;
}

struct EpiEvenIn {
    static constexpr bool AFTER_DRAIN = false;
    bf16_t* P; bf16_t* KT; bf16_t* VT; bf16_t* VbT; float* G; float* out;
    DI void operator()(const f32x4 (&acc)[2][2][4][2], const pg8::Unit& u, int wr, int wc, int fr, int fq) const {
#pragma unroll
        for (int bj = 0; bj < 2; ++bj) {
            const int c8 = u.pn * 256 + bj * 128 + wc * 32 + 8 * fq;
            if (c8 >= C_END) continue;
#pragma unroll
            for (int ai = 0; ai < 2; ++ai)
#pragma unroll
                for (int m = 0; m < 4; ++m) {
                    const int row = u.pm * 256 + ai * 128 + wr * 64 + m * 16 + fr;
                    f32x4 v0 = acc[ai][bj][m][0], v1 = acc[ai][bj][m][1];
                    if (c8 >= C_KA && c8 < C_VA) { v0 = v0 * 0.08838834764831845f; v1 = v1 * 0.08838834764831845f; }
                    if (c8 >= C_Z) {
#pragma unroll
                        for (int j = 0; j < 4; ++j) { v0[j] = siluf(v0[j]); v1[j] = siluf(v1[j]); }
                    }
                    if (c8 >= C_G && c8 < C_QB) {
                        *(f32x4*)(G + (size_t)row * 16 + (c8 - C_G)) = v0; *(f32x4*)(G + (size_t)row * 16 + (c8 - C_G) + 4) = v1;
                    } else {
                        st_bf16x8(P + (size_t)row * NP + c8, v0, v1);
                    }
                    bf16_t* T = nullptr; int tc = 0;
                    if (c8 >= C_KA && c8 < C_VA) { T = KT; tc = c8 - C_KA; }
                    else if (c8 >= C_VA && c8 < C_OA) { T = VT; tc = c8 - C_VA; }
                    else if (c8 >= C_VB && c8 < C_Z) { T = VbT; tc = c8 - C_VB; }
                    if (T) {
#pragma unroll
                        for (int j = 0; j < 4; ++j) { T[(size_t)(tc + j) * MROWS + row] = f2bf(v0[j]); T[(size_t)(tc + 4 + j) * MROWS + row] = f2bf(v1[j]); }
                    }
                    if (c8 >= C_VB && c8 < C_Z && row < MP) {
                        const int c = c8 - C_VB, hk = c >> 6, d = c & 63, b = row >> 8, t = row & 255;
                        float* o = out + O_GV + ((size_t)((b * 2 + hk) * 256 + t)) * 64 + d;
                        *(f32x4*)o = v0; *(f32x4*)(o + 4) = v1;
                    }
                }
        }
    }
};
struct EpiPlain {
    static constexpr bool AFTER_DRAIN = false;
    bf16_t* O; int ldc;
    DI void operator()(const f32x4 (&acc)[2][2][4][2], const pg8::Unit& u, int wr, int wc, int fr, int fq) const {
#pragma unroll
        for (int bj = 0; bj < 2; ++bj) {
            const int c8 = u.pn * 256 + bj * 128 + wc * 32 + 8 * fq;
#pragma unroll
            for (int ai = 0; ai < 2; ++ai)
#pragma unroll
                for (int m = 0; m < 4; ++m) {
                    const int row = u.pm * 256 + ai * 128 + wr * 64 + m * 16 + fr;
                    st_bf16x8(O + (size_t)row * ldc + c8, acc[ai][bj][m][0], acc[ai][bj][m][1]);
                }
        }
    }
};
struct EpiOddIn {
    static constexpr bool AFTER_DRAIN = false;
    bf16_t* P; bf16_t* VcT; float* out;
    DI void operator()(const f32x4 (&acc)[2][2][4][2], const pg8::Unit& u, int wr, int wc, int fr, int fq) const {
#pragma unroll
        for (int bj = 0; bj < 2; ++bj) {
            const int c8 = u.pn * 256 + bj * 128 + wc * 32 + 8 * fq;
            const int seg = c8 >> 10, c = c8 & 1023;
#pragma unroll
            for (int ai = 0; ai < 2; ++ai)
#pragma unroll
                for (int m = 0; m < 4; ++m) {
                    const int row = u.pm * 256 + ai * 128 + wr * 64 + m * 16 + fr;
                    f32x4 v0 = acc[ai][bj][m][0], v1 = acc[ai][bj][m][1];
                    if ((seg == 1 || seg == 2) && row < MP) {
                        const int h = c >> 6, d = c & 63, b = row >> 8, t = row & 255;
                        float* o = out + (seg == 1 ? O_NK : O_NV) + ((size_t)((b * 16 + h) * 256 + t)) * 64 + d;
                        *(f32x4*)o = v0; *(f32x4*)(o + 4) = v1;
                    }
                    if (seg == 2) {
#pragma unroll
                        for (int j = 0; j < 4; ++j) { VcT[(size_t)(c + j) * MROWS + row] = f2bf(v0[j]); VcT[(size_t)(c + 4 + j) * MROWS + row] = f2bf(v1[j]); }
                    } else {
                        if (seg == 0) { v0 = v0 * QSCALE; v1 = v1 * QSCALE; }
                        if (seg == 3) {
#pragma unroll
                            for (int j = 0; j < 4; ++j) { v0[j] = siluf(v0[j]); v1[j] = siluf(v1[j]); }
                        }
                        st_bf16x8(P + (size_t)row * NP + c8, v0, v1);
                    }
                }
        }
    }
};

DI void panel_row_rinv(const f32x4 (&v)[2][2][4][2], const pg8::Unit& u, int wr, int wc, int fr, int fq, LAS float* Pl, LAS float* Sl, int tid, float* slot, unsigned* c) {
#pragma unroll
    for (int ai = 0; ai < 2; ++ai)
#pragma unroll
        for (int m = 0; m < 4; ++m) {
            float sq = 0.f;
#pragma unroll
            for (int bj = 0; bj < 2; ++bj)
#pragma unroll
                for (int n = 0; n < 2; ++n) { const f32x4 x = v[ai][bj][m][n]; sq += (x[0] * x[0] + x[1] * x[1]) + (x[2] * x[2] + x[3] * x[3]); }
            sq += __shfl_xor(sq, 16); sq += __shfl_xor(sq, 32);
            if (fq == 0) Pl[(ai * 128 + wr * 64 + m * 16 + fr) * 4 + wc] = sq;
        }
    __syncthreads();
    if (tid < 256) {
        const float tot = (Pl[tid * 4 + 0] + Pl[tid * 4 + 1]) + (Pl[tid * 4 + 2] + Pl[tid * 4 + 3]);
        __hip_atomic_store(slot + tid * 4 + u.pn, tot, __ATOMIC_RELAXED, __HIP_MEMORY_SCOPE_AGENT);
    }
    asm volatile("s_waitcnt vmcnt(0)" ::: "memory");
    __syncthreads();
    if (tid == 0) {
        __hip_atomic_fetch_add(c, 1u, __ATOMIC_RELAXED, __HIP_MEMORY_SCOPE_AGENT);
        unsigned spins = 0;
        while (__hip_atomic_load(c, __ATOMIC_RELAXED, __HIP_MEMORY_SCOPE_AGENT) < 4u) { __builtin_amdgcn_s_sleep(1); if (++spins > (1u << 22)) break; }
        asm volatile("" ::: "memory");
    }
    __syncthreads();
    if (tid < 256) {
        float t = 0.f;
#pragma unroll
        for (int k = 0; k < 4; ++k) t += __hip_atomic_load(slot + tid * 4 + k, __ATOMIC_RELAXED, __HIP_MEMORY_SCOPE_AGENT);
        Sl[tid] = rsqrtf(t * (1.f / DM) + EPS);
    }
    __syncthreads();
}
struct EpiFinal {
    static constexpr bool AFTER_DRAIN = true;
    const bf16_t* X1P; const bf16_t* X1S; const float* MODl; const float* gpost; float* out; float* xbuf; unsigned* cnt;
    DI void fused(f32x4 (&acc)[2][2][4][2], const pg8::Unit& u, int wr, int wc, int fr, int fq, LAS unsigned char* lds, int wid, int lane) const {
        LAS float* Pl = (LAS float*)lds;
        LAS float* Sl = Pl + 1024;
        const int tid = wid * 64 + lane;
        u32x4 pxr[2][2][4];
#pragma unroll
        for (int bj = 0; bj < 2; ++bj) {
            const int c8 = u.pn * 256 + bj * 128 + wc * 32 + 8 * fq;
#pragma unroll
            for (int ai = 0; ai < 2; ++ai)
#pragma unroll
                for (int m = 0; m < 4; ++m) { const int row = u.pm * 256 + ai * 128 + wr * 64 + m * 16 + fr;
                    pxr[bj][ai][m] = *(const u32x4*)((row < MP ? X1P + (size_t)row * DM : X1S + (size_t)(row - MP) * DM) + c8); }
        }
        panel_row_rinv(acc, u, wr, wc, fr, fq, Pl, Sl, tid, xbuf + (size_t)(u.pm * 256) * 4, cnt + 16 * u.pm);
        const int v = u.pm < 16 ? 0 : 1 + ((u.pm - 16) >> 4);
        const float* gate = MODl + (1 * 3 + v) * 3072 + 2048;
#pragma unroll
        for (int bj = 0; bj < 2; ++bj) {
            const int c8 = u.pn * 256 + bj * 128 + wc * 32 + 8 * fq;
            const f32x4 g0 = *(const f32x4*)(gpost + c8), g1 = *(const f32x4*)(gpost + c8 + 4);
            const f32x4 t0 = *(const f32x4*)(gate + c8), t1 = *(const f32x4*)(gate + c8 + 4);
#pragma unroll
            for (int ai = 0; ai < 2; ++ai)
#pragma unroll
                for (int m = 0; m < 4; ++m) {
                    const int rl = ai * 128 + wr * 64 + m * 16 + fr, row = u.pm * 256 + rl;
                    const float rinv = Sl[rl];
                    const u32x4 xr = pxr[bj][ai][m];
                    const f32x4 y0 = acc[ai][bj][m][0], y1 = acc[ai][bj][m][1];
                    f32x4 o0, o1;
                    o0[0] = __uint_as_float(xr.x << 16) + t0[0] * (y0[0] * rinv * g0[0]); o0[1] = __uint_as_float(xr.x & 0xffff0000u) + t0[1] * (y0[1] * rinv * g0[1]);
                    o0[2] = __uint_as_float(xr.y << 16) + t0[2] * (y0[2] * rinv * g0[2]); o0[3] = __uint_as_float(xr.y & 0xffff0000u) + t0[3] * (y0[3] * rinv * g0[3]);
                    o1[0] = __uint_as_float(xr.z << 16) + t1[0] * (y1[0] * rinv * g1[0]); o1[1] = __uint_as_float(xr.z & 0xffff0000u) + t1[1] * (y1[1] * rinv * g1[1]);
                    o1[2] = __uint_as_float(xr.w << 16) + t1[2] * (y1[2] * rinv * g1[2]); o1[3] = __uint_as_float(xr.w & 0xffff0000u) + t1[3] * (y1[3] * rinv * g1[3]);
                    float* op = out + (size_t)row * DM + c8;
                    *(f32x4*)op = o0; *(f32x4*)(op + 4) = o1;
                }
        }
    }
};

struct EpiMid {
    static constexpr bool AFTER_DRAIN = true;
    const float* x_prompt; const float* x_sample; const float* MODl; const float* gpost; const float* gpre1; bf16_t* X1P; bf16_t* X1S; bf16_t* Hn; float* xbuf; unsigned* cnt;
    DI void fused(f32x4 (&acc)[2][2][4][2], const pg8::Unit& u, int wr, int wc, int fr, int fq, LAS unsigned char* lds, int wid, int lane) const {
        LAS float* Pl = (LAS float*)lds; LAS float* Sl = Pl + 1024;
        const int tid = wid * 64 + lane;
        panel_row_rinv(acc, u, wr, wc, fr, fq, Pl, Sl, tid, xbuf + (size_t)(12288 + u.pm * 256) * 4, cnt + 16 * (48 + u.pm));
        const int v = u.pm < 16 ? 0 : 1 + ((u.pm - 16) >> 4);
        const float* md0 = MODl + (0 * 3 + v) * 3072; const float* md1 = MODl + (1 * 3 + v) * 3072;
        const float* xbase = u.pm < 16 ? x_prompt + (size_t)(u.pm * 256) * DM : x_sample + (size_t)(u.pm * 256 - MP) * DM;
#pragma unroll
        for (int bj = 0; bj < 2; ++bj) {
            const int c8 = u.pn * 256 + bj * 128 + wc * 32 + 8 * fq;
            const f32x4 g0 = *(const f32x4*)(gpost + c8), g1 = *(const f32x4*)(gpost + c8 + 4);
            const f32x4 t0 = *(const f32x4*)(md0 + 2048 + c8), t1 = *(const f32x4*)(md0 + 2048 + c8 + 4);
#pragma unroll
            for (int ai = 0; ai < 2; ++ai)
#pragma unroll
                for (int m = 0; m < 4; ++m) {
                    const int rl = ai * 128 + wr * 64 + m * 16 + fr, row = u.pm * 256 + rl;
                    const float rinv = Sl[rl];
                    const f32x4 x0 = *(const f32x4*)(xbase + (size_t)rl * DM + c8), x1 = *(const f32x4*)(xbase + (size_t)rl * DM + c8 + 4);
                    f32x4 y0 = acc[ai][bj][m][0], y1 = acc[ai][bj][m][1];
#pragma unroll
                    for (int e = 0; e < 4; ++e) { y0[e] = x0[e] + t0[e] * (y0[e] * rinv * g0[e]); y1[e] = x1[e] + t1[e] * (y1[e] * rinv * g1[e]); }
                    acc[ai][bj][m][0] = y0; acc[ai][bj][m][1] = y1;
                    u32x4 w; w.x = cvtpk(y0[0], y0[1]); w.y = cvtpk(y0[2], y0[3]); w.z = cvtpk(y1[0], y1[1]); w.w = cvtpk(y1[2], y1[3]);
                    *(u32x4*)((row < MP ? X1P + (size_t)row * DM : X1S + (size_t)(row - MP) * DM) + c8) = w;
                }
        }
        panel_row_rinv(acc, u, wr, wc, fr, fq, Pl, Sl, tid, xbuf + (size_t)(2 * 12288 + u.pm * 256) * 4, cnt + 16 * (96 + u.pm));
#pragma unroll
        for (int bj = 0; bj < 2; ++bj) {
            const int c8 = u.pn * 256 + bj * 128 + wc * 32 + 8 * fq;
            const f32x4 g0 = *(const f32x4*)(gpre1 + c8), g1 = *(const f32x4*)(gpre1 + c8 + 4);
            const f32x4 a0 = *(const f32x4*)(md1 + 1024 + c8), a1 = *(const f32x4*)(md1 + 1024 + c8 + 4);
            const f32x4 b0 = *(const f32x4*)(md1 + c8), b1 = *(const f32x4*)(md1 + c8 + 4);
#pragma unroll
            for (int ai = 0; ai < 2; ++ai)
#pragma unroll
                for (int m = 0; m < 4; ++m) {
                    const int rl = ai * 128 + wr * 64 + m * 16 + fr, row = u.pm * 256 + rl;
                    const float r1 = Sl[rl];
                    const f32x4 y0 = acc[ai][bj][m][0], y1 = acc[ai][bj][m][1];
                    float o[8];
#pragma unroll
                    for (int e = 0; e < 4; ++e) { o[e] = y0[e] * r1 * g0[e] * (1.f + a0[e]) + b0[e]; o[4 + e] = y1[e] * r1 * g1[e] * (1.f + a1[e]) + b1[e]; }
                    u32x4 w; w.x = cvtpk(o[0], o[1]); w.y = cvtpk(o[2], o[3]); w.z = cvtpk(o[4], o[5]); w.w = cvtpk(o[6], o[7]);
                    *(u32x4*)(Hn + (size_t)row * DM + c8) = w;
                }
        }
    }
};

constexpr int AT_PITCH = 144, AT_TILE = 64 * AT_PITCH;
DI void attn_tile_load(int it, int nt0, const bf16_t* K0, int k0s, const bf16_t* V0, int v0s, const bf16_t* K1, int k1s, const bf16_t* V1, int v1s, int tid, u32x4& kr, u32x4& vr) {
    const int row = tid >> 3, pc = tid & 7;
    const bf16_t* K; const bf16_t* V; int ks, vs, tt;
    if (it < nt0) { K = K0; V = V0; ks = k0s; vs = v0s; tt = it; } else { K = K1; V = V1; ks = k1s; vs = v1s; tt = it - nt0; }
    kr = *(const u32x4*)(K + (size_t)(tt * 64 + row) * ks + pc * 8);
    vr = *(const u32x4*)(V + (size_t)row * vs + tt * 64 + pc * 8);
}
DI void attn_tile_store(LAS unsigned char* kb, LAS unsigned char* vb, int tid, const u32x4& kr, const u32x4& vr, bool nat) {
    const int row = tid >> 3, pc = tid & 7;
    *(LAS u32x4*)(kb + row * AT_PITCH + pc * 16) = kr;
    if (nat) { *(LAS u32x4*)(vb + row * AT_PITCH + pc * 16) = vr; return; }
    const int grp = pc >> 1, b3 = pc & 1;
    u32x2 lo = {vr.x, vr.y}, hi = {vr.z, vr.w};
    *(LAS u32x2*)(vb + row * AT_PITCH + (16 * grp + 4 * b3) * 2) = lo;
    *(LAS u32x2*)(vb + row * AT_PITCH + (16 * grp + 8 + 4 * b3) * 2) = hi;
}

DI void attn_qk(const LAS unsigned char* kb, const bf16x8 (&qf)[4], int l32, int half, float nm, f32x16& s0, f32x16& s1) {
    bf16x8 a[8];
#pragma unroll
    for (int s = 0; s < 4; ++s) {
        a[2 * s] = *(const LAS bf16x8*)(kb + l32 * AT_PITCH + s * 32 + half * 16);
        a[2 * s + 1] = *(const LAS bf16x8*)(kb + (32 + l32) * AT_PITCH + s * 32 + half * 16);
    }
    f32x16 nmC;
#pragma unroll
    for (int i = 0; i < 16; ++i) nmC[i] = nm;
    s0 = MFMA32(a[0], qf[0], nmC); s1 = MFMA32(a[1], qf[0], nmC);
#pragma unroll
    for (int s = 1; s < 4; ++s) { s0 = MFMA32(a[2 * s], qf[s], s0); s1 = MFMA32(a[2 * s + 1], qf[s], s1); }
}
DI void attn_bias(f32x16& s0, f32x16& s1, const LAS float* bp, int half, int cs) {
#pragma unroll
    for (int i = 0; i < 16; ++i) {
        const int kc0 = 8 * (i >> 2) + (i & 3);
        const int kca = kc0 + 4 * half, kcb = kca + 32;
        const float b0 = bp[kc0], b1 = bp[kc0 + 32];
        s0[i] = ((unsigned)(kca - cs) < 16u) ? s0[i] + b0 : -1e30f;
        s1[i] = ((unsigned)(kcb - cs) < 16u) ? s1[i] + b1 : -1e30f;
    }
}
DI float attn_max(const f32x16& s0, const f32x16& s1) {
    float mx = fmaxf(s0[0], s1[0]);
#pragma unroll
    for (int i = 1; i < 16; ++i) mx = fmaxf(mx, fmaxf(s0[i], s1[i]));
    return mx;
}
DI void attn_pv(const LAS unsigned char* vb, f32x16& s0, f32x16& s1, int l32, int half, const bf16x8& ones, f32x16& o0, f32x16& o1, f32x16& lacc) {
    bf16x8 v[8];
#pragma unroll
    for (int s = 0; s < 4; ++s) {
        v[2 * s] = *(const LAS bf16x8*)(vb + l32 * AT_PITCH + (16 * s + 8 * half) * 2);
        v[2 * s + 1] = *(const LAS bf16x8*)(vb + (32 + l32) * AT_PITCH + (16 * s + 8 * half) * 2);
    }
#pragma unroll
    for (int i = 0; i < 16; ++i) { s0[i] = __builtin_amdgcn_exp2f(s0[i]); s1[i] = __builtin_amdgcn_exp2f(s1[i]); }
    bf16x8 pf[4];
    pf[0] = pack8(s0[0], s0[1], s0[2], s0[3], s0[4], s0[5], s0[6], s0[7]);
    pf[1] = pack8(s0[8], s0[9], s0[10], s0[11], s0[12], s0[13], s0[14], s0[15]);
    pf[2] = pack8(s1[0], s1[1], s1[2], s1[3], s1[4], s1[5], s1[6], s1[7]);
    pf[3] = pack8(s1[8], s1[9], s1[10], s1[11], s1[12], s1[13], s1[14], s1[15]);
#pragma unroll
    for (int s = 0; s < 4; ++s) {
        o0 = MFMA32(v[2 * s], pf[s], o0); o1 = MFMA32(v[2 * s + 1], pf[s], o1);
        lacc = MFMA32(ones, pf[s], lacc);
    }
}

DI void attn_qk32(const LAS unsigned char* kb, const bf16x8 (&qf)[4], int krow, int half, float nm, f32x16& sv) {
    f32x16 nmC;
#pragma unroll
    for (int i = 0; i < 16; ++i) nmC[i] = nm;
    const LAS unsigned char* p = kb + krow * AT_PITCH + half * 16;
    sv = MFMA32(*(const LAS bf16x8*)p, qf[0], nmC);
#pragma unroll
    for (int s = 1; s < 4; ++s) sv = MFMA32(*(const LAS bf16x8*)(p + s * 32), qf[s], sv);
}
DI void attn_bias32(f32x16& sv, const LAS float* bp, int kcb, bool rowvalid) {
#pragma unroll
    for (int i = 0; i < 16; ++i) {
        const int kc0 = 8 * (i >> 2) + (i & 3);
        const float b0 = bp[kc0];
        sv[i] = (rowvalid && (unsigned)(kcb + kc0) < 16u) ? sv[i] + b0 : -1e30f;
    }
}
DI float attn_max16(const f32x16& sv) {
    float mx = sv[0];
#pragma unroll
    for (int i = 1; i < 16; ++i) mx = fmaxf(mx, sv[i]);
    return mx;
}
DI void attn_pv32(const LAS unsigned char* vb, f32x16& sv, int l32, int half, int k0, const bf16x8& ones, f32x16& o0, f32x16& o1, f32x16& lacc) {
#pragma unroll
    for (int i = 0; i < 16; ++i) sv[i] = __builtin_amdgcn_exp2f(sv[i]);
    const bf16x8 pf0 = pack8(sv[0], sv[1], sv[2], sv[3], sv[4], sv[5], sv[6], sv[7]);
    const bf16x8 pf1 = pack8(sv[8], sv[9], sv[10], sv[11], sv[12], sv[13], sv[14], sv[15]);
#pragma unroll
    for (int s2 = 0; s2 < 2; ++s2) {
        const LAS unsigned char* p0 = vb + l32 * AT_PITCH + (k0 + 16 * s2 + 4 * half) * 2;
        const LAS unsigned char* p1 = p0 + 32 * AT_PITCH;
        const s16x4 lo0 = *(const LAS s16x4*)p0, hi0 = *(const LAS s16x4*)(p0 + 16);
        const s16x4 lo1 = *(const LAS s16x4*)p1, hi1 = *(const LAS s16x4*)(p1 + 16);
        const bf16x8 A0 = __builtin_shufflevector(lo0, hi0, 0, 1, 2, 3, 4, 5, 6, 7);
        const bf16x8 A1 = __builtin_shufflevector(lo1, hi1, 0, 1, 2, 3, 4, 5, 6, 7);
        o0 = MFMA32(A0, s2 == 0 ? pf0 : pf1, o0); o1 = MFMA32(A1, s2 == 0 ? pf0 : pf1, o1);
        lacc = MFMA32(ones, s2 == 0 ? pf0 : pf1, lacc);
    }
}

template <int MODE>
DI void attn_item(LAS unsigned char* lds, int tid,
                  const bf16_t* Q, int qstride,
                  const bf16_t* K0, int k0s, const bf16_t* V0, int v0s, int nt0,
                  const bf16_t* K1, int k1s, const bf16_t* V1, int v1s, int nt1,
                  int r0, int rs_lo, const LAS float* rpbL,
                  const bf16_t* Z, int zstride, bf16_t* O, int ostride, const WT& wt, bool usewt, unsigned* pcnt) {
    const int lane = tid & 63, w = tid >> 6, l32 = lane & 31, half = lane >> 5;
    const int np = (nt0 + nt1 + 1) >> 1;
    const int ng = w & 3, nrp = w >> 2;
    const int qc = (MODE == 1) ? 16 * ng + (l32 & 15) : 0;
    const int qrw = (MODE == 1) ? 2 * nrp + (l32 >> 4) : 0;
    const int qr = r0 + qrw;
    const int qrow = (MODE == 1) ? qrw * 64 + qc : w * 32 + l32;
    const int k0 = (ng == 0) ? 0 : (ng == 1) ? 8 : (ng == 2) ? 24 : 32;
    bf16x8 qf[4];
#pragma unroll
    for (int s = 0; s < 4; ++s) qf[s] = *(const bf16x8*)(Q + (size_t)qrow * qstride + 16 * s + 8 * half);
    f32x16 o0, o1, lacc;
#pragma unroll
    for (int i = 0; i < 16; ++i) { o0[i] = 0.f; o1[i] = 0.f; lacc[i] = 0.f; }
    float m_run = 0.f;
    const bf16x8 ones = {0x3F80, 0x3F80, 0x3F80, 0x3F80, 0x3F80, 0x3F80, 0x3F80, 0x3F80};
    const int cs = min(max(qc - 8, 0), 48);
    const int rsq = min(max(qr - 4, 0), 56);
    const int rsw_lo = min(max(r0 + 2 * nrp - 4, 0), 56), rsw_hi = min(max(r0 + 2 * nrp + 1 - 4, 0), 56) + 8;

    u32x4 eka, eva, ekb, evb;
#define AT_LOAD(pair, ka, va, kb_, vb_) do { attn_tile_load(2 * (pair), nt0, K0, k0s, V0, v0s, K1, k1s, V1, v1s, tid, ka, va); \
        attn_tile_load(2 * (pair) + 1, nt0, K0, k0s, V0, v0s, K1, k1s, V1, v1s, tid, kb_, vb_); } while (0)
#define AT_STORE(stage, pair, ka, va, kb_, vb_) do { LAS unsigned char* nb_ = lds + (stage) * 4 * AT_TILE; const bool nat_ = (MODE == 1) && (2 * (pair) >= nt0); \
        attn_tile_store(nb_, nb_ + AT_TILE, tid, ka, va, nat_); attn_tile_store(nb_ + 2 * AT_TILE, nb_ + 3 * AT_TILE, tid, kb_, vb_, nat_); } while (0)
#define AT_SLOWPATH(ip_, EXTRA) \
            mx = fmaxf(mx, __shfl_xor(mx, 32)); \
            const bool need = ((ip_) == 0) || (mx > 8.f); \
            if (__builtin_amdgcn_ballot_w64(need) != 0ull) { \
                const float delta = need ? mx : 0.f; \
                const float alpha = __builtin_amdgcn_exp2f(-delta); \
                m_run += delta; \
                _Pragma("unroll") for (int i = 0; i < 16; ++i) { EXTRA; o0[i] *= alpha; o1[i] *= alpha; lacc[i] *= alpha; } \
            }
#define AT_COMPUTE(ip_) do { \
        LAS unsigned char* base = lds + ((ip_) & 1) * 4 * AT_TILE; \
        const int ita = 2 * (ip_), itb = 2 * (ip_) + 1; \
        if (MODE == 1 && ita >= nt0) { \
            const int kra_ = rs_lo + (ita - nt0), krb_ = kra_ + 1; \
            const bool acta = (kra_ >= rsw_lo) && (kra_ < rsw_hi), actb = (krb_ >= rsw_lo) && (krb_ < rsw_hi); \
            if (acta || actb) { \
                f32x16 sa, sb; \
                _Pragma("unroll") for (int i = 0; i < 16; ++i) { sa[i] = -1e30f; sb[i] = -1e30f; } \
                float mx = -3.0e38f; \
                if (acta) { attn_qk32(base, qf, k0 + l32, half, -m_run, sa); \
                    attn_bias32(sa, rpbL + 64 + (kra_ - qr + 7) * 31 + (k0 - qc + 15) + 4 * half, k0 + 4 * half - cs, (kra_ >= rsq) && (kra_ < rsq + 8)); mx = attn_max16(sa); } \
                if (actb) { attn_qk32(base + 2 * AT_TILE, qf, k0 + l32, half, -m_run, sb); \
                    attn_bias32(sb, rpbL + 64 + (krb_ - qr + 7) * 31 + (k0 - qc + 15) + 4 * half, k0 + 4 * half - cs, (krb_ >= rsq) && (krb_ < rsq + 8)); mx = fmaxf(mx, attn_max16(sb)); } \
                AT_SLOWPATH(ip_, sa[i] -= delta; sb[i] -= delta) \
                if (acta) attn_pv32(base + AT_TILE, sa, l32, half, k0, ones, o0, o1, lacc); \
                if (actb) attn_pv32(base + 3 * AT_TILE, sb, l32, half, k0, ones, o0, o1, lacc); \
            } \
        } else { \
            f32x16 sa0, sa1, sb0, sb1; \
            attn_qk(base, qf, l32, half, -m_run, sa0, sa1); \
            attn_qk(base + 2 * AT_TILE, qf, l32, half, -m_run, sb0, sb1); \
            float mx = fmaxf(attn_max(sa0, sa1), attn_max(sb0, sb1)); \
            AT_SLOWPATH(ip_, sa0[i] -= delta; sa1[i] -= delta; sb0[i] -= delta; sb1[i] -= delta) \
            attn_pv(base + AT_TILE, sa0, sa1, l32, half, ones, o0, o1, lacc); \
            attn_pv(base + 3 * AT_TILE, sb0, sb1, l32, half, ones, o0, o1, lacc); \
        } } while (0)
    AT_LOAD(0, eka, eva, ekb, evb);
    AT_STORE(0, 0, eka, eva, ekb, evb);
    __syncthreads();
    for (int ip = 0; ip < np; ++ip) {
        if (ip + 1 < np) AT_LOAD(ip + 1, eka, eva, ekb, evb);
        AT_COMPUTE(ip);
        if (ip + 1 < np) AT_STORE((ip + 1) & 1, ip + 1, eka, eva, ekb, evb);
        __syncthreads();
    }
#undef AT_LOAD
#undef AT_STORE
#undef AT_COMPUTE
#undef AT_SLOWPATH
    const float inv = 1.f / lacc[0];
    {
        LAS float* ot = (LAS float*)lds;
#pragma unroll
        for (int dt = 0; dt < 2; ++dt)
#pragma unroll
            for (int i = 0; i < 16; ++i) ot[qrow * 65 + dt * 32 + crow(i, half)] = (dt == 0 ? o0[i] : o1[i]) * inv;
        __syncthreads();
#pragma unroll
        for (int j = 0; j < 4; ++j) {
            const int idx = tid + 512 * j, row = idx >> 3, pc = idx & 7;
            const u32x4 zz = *(const u32x4*)(Z + (size_t)row * zstride + pc * 8);
            const LAS float* sp = ot + row * 65 + pc * 8;
            u32x4 ov;
            ov.x = cvtpk(sp[0] * __uint_as_float(zz.x << 16), sp[1] * __uint_as_float(zz.x & 0xffff0000u));
            ov.y = cvtpk(sp[2] * __uint_as_float(zz.y << 16), sp[3] * __uint_as_float(zz.y & 0xffff0000u));
            ov.z = cvtpk(sp[4] * __uint_as_float(zz.z << 16), sp[5] * __uint_as_float(zz.z & 0xffff0000u));
            ov.w = cvtpk(sp[6] * __uint_as_float(zz.w << 16), sp[7] * __uint_as_float(zz.w & 0xffff0000u));
            if (usewt) wt16(wt, O + (size_t)row * ostride + pc * 8, ov); else *(u32x4*)(O + (size_t)row * ostride + pc * 8) = ov;
        }
        if (pcnt) asm volatile("s_waitcnt vmcnt(0)" ::: "memory");
        __syncthreads();
        if (pcnt && tid == 0) __hip_atomic_fetch_add(pcnt, 1u, __ATOMIC_RELAXED, __HIP_MEMORY_SCOPE_AGENT);
    }
}

DI int chain_base(int sid, int h, int dir) { return sid < 16 ? ((sid * 4 + h) * 2 + dir) * 2 : 256 + (((sid - 16) * 4 + h) * 2 + dir) * 32; }
DI int seq_rowbase(int sid) { return sid < 16 ? sid * 256 : MP + (sid - 16) * 4096; }
DI float chain_m0(const float* state_m, int sid, int h, int dir) { return sid < 16 ? 0.f : state_m[((sid - 16) * 2 + dir) * 4 + h]; }
DI float chain_m_at(const float* CH, int base, int js, float m0) {
    float m = m0;
    for (int i = 0; i < js; ++i) { const float bL = CH[(base + i) * 2], rmL = CH[(base + i) * 2 + 1]; m = bL + fmaxf(m, rmL); }
    return m;
}

DI void gate_scan_item(int sid, int h, int dir, int js, int lane, const float* G, const float* bg, float* SC, float* CH) {
    const int nc = sid < 16 ? 2 : 32, T = nc * 128, rb = seq_rowbase(sid);
    const float bi = bg[(dir * 2) * 4 + h], bff = bg[(dir * 2 + 1) * 4 + h];
    float ig[2], lf[2]; int row[2];
#pragma unroll
    for (int e = 0; e < 2; ++e) {
        const int Ppos = js * 128 + 2 * lane + e; const int t = dir ? (T - 1 - Ppos) : Ppos; row[e] = rb + t;
        ig[e] = G[(size_t)row[e] * 16 + (dir * 2) * 4 + h] + bi;
        const float fg = G[(size_t)row[e] * 16 + (dir * 2 + 1) * 4 + h] + bff;
        lf[e] = fminf(fg, 0.f) - log1pf(expf(-fabsf(fg)));
    }
    const float tot = lf[0] + lf[1];
    float x = tot;
#pragma unroll
    for (int o = 1; o < 64; o <<= 1) { const float y = __shfl_up(x, o); if (lane >= o) x += y; }
    const float excl = x - tot;
    const float b0 = excl + lf[0], b1 = excl + tot;
    const float a0 = ig[0] - b0, a1 = ig[1] - b1;
    const float lm = fmaxf(a0, a1);
    float xm = lm;
#pragma unroll
    for (int o = 1; o < 64; o <<= 1) { const float y = __shfl_up(xm, o); if (lane >= o) xm = fmaxf(xm, y); }
    float em = __shfl_up(xm, 1); if (lane == 0) em = -3.0e38f;
    const float rm0 = fmaxf(em, a0), rm1 = fmaxf(em, lm);
    *(f32x4*)(SC + ((size_t)row[0] * 8 + h * 2 + dir) * 4) = (f32x4){a0, b0, rm0, 0.f};
    *(f32x4*)(SC + ((size_t)row[1] * 8 + h * 2 + dir) * 4) = (f32x4){a1, b1, rm1, 0.f};
    if (lane == 63) { const int slot = chain_base(sid, h, dir) + js; CH[slot * 2] = b1; CH[slot * 2 + 1] = rm1; }
}

DI void qknorm_item(int row, int lane, const u32x4 (&rawqk)[2], const float* gq, const float* gk, bf16_t* Qb, bf16_t* Kb, float* out) {
    const bool sample = row >= MP;
    const int t = sample ? ((row - MP) & 4095) : 0;
    const int grow = t >> 6, gcol = t & 63;
    const int sub = lane & 7, d0 = sub * 8;
    const float pos = (float)((sub < 4) ? grow : gcol);
#pragma unroll
    for (int pass = 0; pass < 2; ++pass) {
        const u32x4 raw = rawqk[pass];
        float x[8];
        x[0] = __uint_as_float(raw.x << 16); x[1] = __uint_as_float(raw.x & 0xffff0000u);
        x[2] = __uint_as_float(raw.y << 16); x[3] = __uint_as_float(raw.y & 0xffff0000u);
        x[4] = __uint_as_float(raw.z << 16); x[5] = __uint_as_float(raw.z & 0xffff0000u);
        x[6] = __uint_as_float(raw.w << 16); x[7] = __uint_as_float(raw.w & 0xffff0000u);
        float ss = 0.f;
#pragma unroll
        for (int e = 0; e < 8; ++e) ss += x[e] * x[e];
        ss += __shfl_xor(ss, 1); ss += __shfl_xor(ss, 2); ss += __shfl_xor(ss, 4);
        const float r = rsqrtf(ss * (1.f / 64.f) + EPS);
        const float* gw = pass == 0 ? gq : gk;
        float y[8];
#pragma unroll
        for (int e = 0; e < 8; ++e) y[e] = x[e] * r * gw[d0 + e];
        if (pass == 1 && !sample && lane < 16) {
            const int hk = lane >> 3, b = row >> 8, tt = row & 255;
            float* o = out + O_GK + ((size_t)((b * 2 + hk) * 256 + tt)) * 64 + d0;
            *(f32x4*)o = (f32x4){y[0], y[1], y[2], y[3]}; *(f32x4*)(o + 4) = (f32x4){y[4], y[5], y[6], y[7]};
        }
        float z[8];
#pragma unroll
        for (int e = 0; e < 8; ++e) {
            const float partner = __shfl_xor(y[e], 2);
            if (sample) {
                const int i = (d0 + e) & 15;
                const float freq = __builtin_amdgcn_exp2f(-(float)i * (13.287712379549449f / 16.f));
                float rev = pos * freq * 0.15915494309189535f; rev -= floorf(rev);
                const float sn = __builtin_amdgcn_sinf(rev), cn = __builtin_amdgcn_cosf(rev);
                z[e] = (sub & 2) ? (partner * sn + y[e] * cn) : (y[e] * cn - partner * sn);
            } else z[e] = y[e];
        }
        if (pass == 0) {
#pragma unroll
            for (int e = 0; e < 8; ++e) z[e] *= QSCALE;
            u32x4 w; w.x = cvtpk(z[0], z[1]); w.y = cvtpk(z[2], z[3]); w.z = cvtpk(z[4], z[5]); w.w = cvtpk(z[6], z[7]);
            *(u32x4*)(Qb + (size_t)row * 512 + lane * 8) = w;
        } else if (lane < 16) {
            u32x4 w; w.x = cvtpk(z[0], z[1]); w.y = cvtpk(z[2], z[3]); w.z = cvtpk(z[4], z[5]); w.w = cvtpk(z[6], z[7]);
            *(u32x4*)(Kb + (size_t)row * 128 + lane * 8) = w;
        }
    }
}

DI void mlstm_u_item(LAS unsigned char* lds, int tid, int sid, int h, int dir, int js,
                     const float* SC, const float* CH, const float* state_m, const bf16_t* KT, const bf16_t* VT, bf16_t* U, float* Un, const WT& wtw, unsigned* ucnt) {
    const int lane = tid & 63, w = tid >> 6, l32 = lane & 31, half = lane >> 5;
    const int nc = sid < 16 ? 2 : 32, rb = seq_rowbase(sid);
    const int jt = dir ? nc - 1 - js : js, R0 = rb + jt * 128;
    const int base = chain_base(sid, h, dir), slot = base + js;
    const float Mx = CH[slot * 2 + 1];
    LAS float* wkL = (LAS float*)lds;
    if (tid < 128) wkL[tid] = expf(SC[((size_t)(R0 + tid) * 8 + h * 2 + dir) * 4] - Mx);
    const int vi = w & 3, kh = w >> 2;
    f32x16 acc0, acc1;
#pragma unroll
    for (int i = 0; i < 16; ++i) { acc0[i] = 0.f; acc1[i] = 0.f; }
    LAS unsigned char* VtL = lds + 1024; LAS unsigned char* KtL = lds + 1024 + 34816;
    {
        u32x4 rv[8];
        const int r0 = tid >> 4, pc = tid & 15;
        const bf16_t* gv = VT + (size_t)(h * 128 + r0) * MROWS + R0 + pc * 8;
        const bf16_t* gk = KT + (size_t)(h * 128 + r0) * MROWS + R0 + pc * 8;
#pragma unroll
        for (int i = 0; i < 8; ++i) rv[i] = *(const u32x4*)((i >> 2 ? gk : gv) + (size_t)(32 * (i & 3)) * MROWS);
        LAS unsigned char* lv = VtL + r0 * 272 + pc * 16;
#pragma unroll
        for (int i = 0; i < 8; ++i) *(LAS u32x4*)(lv + (i >> 2) * 34816 + (32 * (i & 3)) * 272) = rv[i];
    }
    __syncthreads();
#pragma unroll
    for (int s = 0; s < 8; ++s) {
        const int so = 16 * s + 8 * half;
        const u32x4 raw = *(const LAS u32x4*)(VtL + (vi * 32 + l32) * 272 + so * 2);
        const bf16x8 B0 = *(const LAS bf16x8*)(KtL + (kh * 64 + l32) * 272 + so * 2);
        const bf16x8 B1 = *(const LAS bf16x8*)(KtL + (kh * 64 + 32 + l32) * 272 + so * 2);
        const f32x4 wa = *(const LAS f32x4*)(wkL + so), wb = *(const LAS f32x4*)(wkL + so + 4);
        const bf16x8 A = pack8(__uint_as_float(raw.x << 16) * wa[0], __uint_as_float(raw.x & 0xffff0000u) * wa[1], __uint_as_float(raw.y << 16) * wa[2], __uint_as_float(raw.y & 0xffff0000u) * wa[3],
                               __uint_as_float(raw.z << 16) * wb[0], __uint_as_float(raw.z & 0xffff0000u) * wb[1], __uint_as_float(raw.w << 16) * wb[2], __uint_as_float(raw.w & 0xffff0000u) * wb[3]);
        acc0 = MFMA32(A, B0, acc0); acc1 = MFMA32(A, B1, acc1);
    }
    bf16_t* Uo = U + (size_t)slot * 16384;
    {
        LAS unsigned char* st = lds + 1024 + 2 * 34816 + w * 4608;
#pragma unroll
        for (int i = 0; i < 16; ++i) {
            const int v = crow(i, half);
            *(LAS bf16_t*)(st + v * 144 + l32 * 2) = f2bf(acc0[i]);
            *(LAS bf16_t*)(st + v * 144 + (32 + l32) * 2) = f2bf(acc1[i]);
        }
        asm volatile("s_waitcnt lgkmcnt(0)" ::: "memory");
#pragma unroll
        for (int j = 0; j < 4; ++j) {
            const int pidx = lane + 64 * j, row = pidx >> 3, pc = pidx & 7;
            const u32x4 val = *(const LAS u32x4*)(st + row * 144 + pc * 16);
            wt16(wtw, Uo + (vi * 32 + row) * 128 + kh * 64 + pc * 8, val);
        }
    }
    if (tid < 128) {
        float s = 0.f;
#pragma unroll
        for (int j = 0; j < 16; ++j) {
            const u32x4 raw = *(const LAS u32x4*)(KtL + tid * 272 + j * 16);
            s += __uint_as_float(raw.x << 16) * wkL[8 * j] + __uint_as_float(raw.x & 0xffff0000u) * wkL[8 * j + 1]
               + __uint_as_float(raw.y << 16) * wkL[8 * j + 2] + __uint_as_float(raw.y & 0xffff0000u) * wkL[8 * j + 3]
               + __uint_as_float(raw.z << 16) * wkL[8 * j + 4] + __uint_as_float(raw.z & 0xffff0000u) * wkL[8 * j + 5]
               + __uint_as_float(raw.w << 16) * wkL[8 * j + 6] + __uint_as_float(raw.w & 0xffff0000u) * wkL[8 * j + 7];
        }
        __hip_atomic_store(Un + slot * 128 + tid, s, __ATOMIC_RELAXED, __HIP_MEMORY_SCOPE_AGENT);
    }
    asm volatile("s_waitcnt vmcnt(0)" ::: "memory");
    __syncthreads();
    if (tid == 0 && ucnt) __hip_atomic_fetch_add(ucnt + 16 * (sid < 16 ? (sid * 4 + h) * 2 + dir : 128 + ((sid - 16) * 4 + h) * 2 + dir), 1u, __ATOMIC_RELAXED, __HIP_MEMORY_SCOPE_AGENT);
}

constexpr int ML_PITCH = 272, ML_ARR = 128 * ML_PITCH;
constexpr int ML_SCAL = 4 * ML_ARR;
DI void mlstm_out_item(LAS unsigned char* lds, int tid, int sid, int h, int jt,
                       const float* SC, const float* MJp, const float* nst, const bf16_t* Cst,
                       const bf16_t* P, const bf16_t* VT, const float* ghn, bf16_t* Yg, const WT& wtd, bool usewt, unsigned* pcnt) {
    const int lane = tid & 63, w = tid >> 6, l32 = lane & 31, half = lane >> 5;
    const int wt = w & 3, vh = w >> 2;
    const int nc = sid < 16 ? 2 : 32, rb = seq_rowbase(sid), R0 = rb + jt * 128;
    LAS unsigned char* KL = lds; LAS unsigned char* VL = lds + ML_ARR; LAS unsigned char* CL = lds + 2 * ML_ARR;
    LAS float* aL = (LAS float*)(lds + ML_SCAL);
    LAS float* nL = aL + 256;
    LAS float* ssqL = nL + 256;
    const int tl = wt * 32 + l32;
    const int qrow = R0 + tl;
    const int slot0 = chain_base(sid, h, 0) + jt, slot1 = chain_base(sid, h, 1) + (nc - 1 - jt);
    bf16x8 qf[8];
#pragma unroll
    for (int s = 0; s < 8; ++s) qf[s] = *(const bf16x8*)(P + (size_t)qrow * NP + C_QA + h * 128 + 16 * s + 8 * half);
    {
        u32x4 rk[4], rv[4], rc0[4], rc1[4];
#pragma unroll
        for (int i = 0; i < 4; ++i) {
            const int idx = tid + 512 * i, row = idx >> 4, pc = idx & 15;
            rk[i] = *(const u32x4*)(P + (size_t)(R0 + row) * NP + C_KA + h * 128 + pc * 8);
            rv[i] = *(const u32x4*)(VT + (size_t)(h * 128 + row) * MROWS + R0 + pc * 8);
            rc0[i] = *(const u32x4*)(Cst + (size_t)slot0 * 16384 + row * 128 + pc * 8);
            rc1[i] = *(const u32x4*)(Cst + (size_t)slot1 * 16384 + row * 128 + pc * 8);
        }
        float av = 0.f, nv = 0.f;
        if (tid < 256) {
            const int dir = tid >> 7, s2 = tid & 127;
            av = SC[((size_t)(R0 + s2) * 8 + h * 2 + dir) * 4];
            nv = nst[(size_t)(dir ? slot1 : slot0) * 128 + s2];
        }
#pragma unroll
        for (int i = 0; i < 4; ++i) {
            const int idx = tid + 512 * i, row = idx >> 4, pc = idx & 15;
            *(LAS u32x4*)(KL + row * ML_PITCH + pc * 16) = rk[i];
            *(LAS u32x4*)(CL + row * ML_PITCH + pc * 16) = rc0[i];
            *(LAS u32x4*)(CL + ML_ARR + row * ML_PITCH + pc * 16) = rc1[i];
            const int grp = pc >> 1, b3 = pc & 1;
            u32x2 lo = {rv[i].x, rv[i].y}, hi = {rv[i].z, rv[i].w};
            *(LAS u32x2*)(VL + row * ML_PITCH + (16 * grp + 4 * b3) * 2) = lo;
            *(LAS u32x2*)(VL + row * ML_PITCH + (16 * grp + 8 + 4 * b3) * 2) = hi;
        }
        if (tid < 256) { aL[tid] = av; nL[tid] = nv; }
    }
    __syncthreads();
    f32x16 hs0, hs1;
#pragma unroll
    for (int i = 0; i < 16; ++i) { hs0[i] = 0.f; hs1[i] = 0.f; }
#pragma unroll 1
    for (int dir = 0; dir < 2; ++dir) {
        const int js = dir ? nc - 1 - jt : jt;
        const float m = MJp[chain_base(sid, h, dir) + js];
        const f32x4 sc = *(const f32x4*)(SC + ((size_t)qrow * 8 + h * 2 + dir) * 4);
        const float mx = fmaxf(m, sc[2]);
        const float u_t = -mx, w_inter = expf(m - mx), flo = expf(-(sc[1] + mx));
        f32x16 a0, a1;
#pragma unroll
        for (int i = 0; i < 16; ++i) { a0[i] = 0.f; a1[i] = 0.f; }
        const LAS unsigned char* Cp = CL + dir * ML_ARR + (vh * 64 + l32) * ML_PITCH + 16 * half;
#pragma unroll
        for (int s = 0; s < 8; ++s) {
            const bf16x8 A0 = *(const LAS bf16x8*)(Cp + 32 * s);
            const bf16x8 A1 = *(const LAS bf16x8*)(Cp + 32 * ML_PITCH + 32 * s);
            a0 = MFMA32(A0, qf[s], a0); a1 = MFMA32(A1, qf[s], a1);
        }
#pragma unroll
        for (int i = 0; i < 16; ++i) { a0[i] *= w_inter; a1[i] *= w_inter; }
        float dq = 0.f;
#pragma unroll
        for (int s = 0; s < 8; ++s)
#pragma unroll
            for (int e = 0; e < 8; ++e) dq += bf2f((unsigned short)qf[s][e]) * nL[dir * 128 + 16 * s + 8 * half + e];
        dq += __shfl_xor(dq, 32);
        float rsum = 0.f;
        const int st_lo = dir ? wt : 0, st_hi = dir ? 3 : wt;
        for (int st = st_lo; st <= st_hi; ++st) {
            f32x16 S;
#pragma unroll
            for (int i = 0; i < 16; ++i) S[i] = 0.f;
            const LAS unsigned char* Kp = KL + (st * 32 + l32) * ML_PITCH + 16 * half;
#pragma unroll
            for (int s = 0; s < 8; ++s) { const bf16x8 A = *(const LAS bf16x8*)(Kp + 32 * s); S = MFMA32(A, qf[s], S); }
#pragma unroll
            for (int i = 0; i < 16; ++i) {
                const int sl = st * 32 + crow(i, half);
                const bool valid = dir ? (sl >= tl) : (sl <= tl);
                const float dcy = __expf(u_t + aL[dir * 128 + sl]);
                const float p = valid ? S[i] * dcy : 0.f;
                S[i] = p; rsum += p;
            }
            const bf16x8 pf0 = pack8(S[0], S[1], S[2], S[3], S[4], S[5], S[6], S[7]);
            const bf16x8 pf1 = pack8(S[8], S[9], S[10], S[11], S[12], S[13], S[14], S[15]);
            const LAS unsigned char* Vp = VL + (vh * 64 + l32) * ML_PITCH + (st * 32 + 8 * half) * 2;
            {
                const bf16x8 A0 = *(const LAS bf16x8*)(Vp), A1 = *(const LAS bf16x8*)(Vp + 32 * ML_PITCH);
                a0 = MFMA32(A0, pf0, a0); a1 = MFMA32(A1, pf0, a1);
                const bf16x8 B0 = *(const LAS bf16x8*)(Vp + 32), B1 = *(const LAS bf16x8*)(Vp + 32 * ML_PITCH + 32);
                a0 = MFMA32(B0, pf1, a0); a1 = MFMA32(B1, pf1, a1);
            }
        }
        rsum += __shfl_xor(rsum, 32);
        const float den = w_inter * dq + rsum;
        const float inv = 1.f / fmaxf(fabsf(den), flo);
#pragma unroll
        for (int i = 0; i < 16; ++i) { hs0[i] += a0[i] * inv; hs1[i] += a1[i] * inv; }
    }
    float ssq = 0.f;
#pragma unroll
    for (int i = 0; i < 16; ++i) ssq += hs0[i] * hs0[i] + hs1[i] * hs1[i];
    ssq += __shfl_xor(ssq, 32);
    if (half == 0) ssqL[w * 32 + l32] = ssq;
    __syncthreads();
    const float tot = ssq + ssqL[(w ^ 4) * 32 + l32];
    const float rn = rsqrtf(tot * (1.f / 128.f) + EPS);
    {
        LAS float* ht = (LAS float*)lds;
#pragma unroll
        for (int vt = 0; vt < 2; ++vt)
#pragma unroll
            for (int i = 0; i < 16; ++i) ht[tl * 129 + vh * 64 + vt * 32 + crow(i, half)] = (vt == 0 ? hs0[i] : hs1[i]) * rn;
        __syncthreads();
#pragma unroll
        for (int j = 0; j < 4; ++j) {
            const int idx = tid + 512 * j, row = idx >> 4, pc = idx & 15, col = h * 128 + pc * 8;
            const bf16_t* prow = P + (size_t)(R0 + row) * NP;
            const u32x4 oa = *(const u32x4*)(prow + C_OA + col), zz = *(const u32x4*)(prow + C_Z + col);
            const f32x4 g0 = *(const f32x4*)(ghn + col), g1 = *(const f32x4*)(ghn + col + 4);
            const LAS float* sp = ht + row * 129 + pc * 8;
            u32x4 ov;
            ov.x = cvtpk(sp[0] * g0[0] * sigmf(__uint_as_float(oa.x << 16)) * __uint_as_float(zz.x << 16), sp[1] * g0[1] * sigmf(__uint_as_float(oa.x & 0xffff0000u)) * __uint_as_float(zz.x & 0xffff0000u));
            ov.y = cvtpk(sp[2] * g0[2] * sigmf(__uint_as_float(oa.y << 16)) * __uint_as_float(zz.y << 16), sp[3] * g0[3] * sigmf(__uint_as_float(oa.y & 0xffff0000u)) * __uint_as_float(zz.y & 0xffff0000u));
            ov.z = cvtpk(sp[4] * g1[0] * sigmf(__uint_as_float(oa.z << 16)) * __uint_as_float(zz.z << 16), sp[5] * g1[1] * sigmf(__uint_as_float(oa.z & 0xffff0000u)) * __uint_as_float(zz.z & 0xffff0000u));
            ov.w = cvtpk(sp[6] * g1[2] * sigmf(__uint_as_float(oa.w << 16)) * __uint_as_float(zz.w << 16), sp[7] * g1[3] * sigmf(__uint_as_float(oa.w & 0xffff0000u)) * __uint_as_float(zz.w & 0xffff0000u));
            if (usewt) wt16(wtd, Yg + (size_t)(R0 + row) * DM + col, ov); else *(u32x4*)(Yg + (size_t)(R0 + row) * DM + col) = ov;
        }
    }
    if (pcnt) asm volatile("s_waitcnt vmcnt(0)" ::: "memory");
    __syncthreads();
    if (pcnt && tid == 0) __hip_atomic_fetch_add(pcnt + 16 * (R0 >> 8), 1u, __ATOMIC_RELAXED, __HIP_MEMORY_SCOPE_AGENT);
}

DI void transpose_item(const float* W, int K, int N, bf16_t* WT, LAS float* scr, int item, int lane) {
    const int nblk = (N + 31) / 32, kb = item / nblk, nb = item % nblk, k0 = 64 * kb, n0 = 32 * nb;
    const int nn = n0 + (lane & 31);
    float tv[32];
#pragma unroll
    for (int i = 0; i < 32; ++i) { const int kk = 2 * i + (lane >> 5); tv[i] = (nn < N) ? __builtin_nontemporal_load(W + (size_t)(k0 + kk) * N + nn) : 0.f; }
#pragma unroll
    for (int i = 0; i < 32; ++i) { const int kk = 2 * i + (lane >> 5); scr[kk * 33 + (lane & 31)] = tv[i]; }
    asm volatile("s_waitcnt lgkmcnt(0)" ::: "memory");
    const int c = lane & 7;
#pragma unroll
    for (int j = 0; j < 4; ++j) { const int n = (lane >> 3) + 8 * j; const LAS float* s = scr + (8 * c) * 33 + n;
        u32x4 o; o.x = cvtpk(s[0 * 33], s[1 * 33]); o.y = cvtpk(s[2 * 33], s[3 * 33]); o.z = cvtpk(s[4 * 33], s[5 * 33]); o.w = cvtpk(s[6 * 33], s[7 * 33]);
        *(u32x4*)(WT + (size_t)(n0 + n) * K + k0 + 8 * c) = o; }
    asm volatile("s_waitcnt lgkmcnt(0)" ::: "memory");
}

template <int NR>
DI void prenorm_rows(const float* const (&xrow)[NR], const float* gpre, const float* const (&md)[NR], bf16_t* const (&orow)[NR], int lane) {
    f32x4 v[NR][4];
#pragma unroll
    for (int r = 0; r < NR; ++r)
#pragma unroll
        for (int j = 0; j < 4; ++j) v[r][j] = *(const f32x4*)(xrow[r] + 4 * lane + 256 * j);
#pragma unroll
    for (int r = 0; r < NR; ++r) {
        float s = 0.f;
#pragma unroll
        for (int j = 0; j < 4; ++j) s += (v[r][j].x * v[r][j].x + v[r][j].y * v[r][j].y) + (v[r][j].z * v[r][j].z + v[r][j].w * v[r][j].w);
        const float rr = rsqrtf(wave_sum(s) * (1.f / DM) + EPS);
#pragma unroll
        for (int j = 0; j < 4; ++j) {
            const int c = 4 * lane + 256 * j;
            const f32x4 g = *(const f32x4*)(gpre + c), a = *(const f32x4*)(md[r] + 1024 + c), b = *(const f32x4*)(md[r] + c);
            f32x4 o;
#pragma unroll
            for (int e = 0; e < 4; ++e) o[e] = v[r][j][e] * rr * g[e] * (1.f + a[e]) + b[e];
            u32x2 w; w.x = cvtpk(o[0], o[1]); w.y = cvtpk(o[2], o[3]);
            *(u32x2*)(orow[r] + c) = w;
        }
    }
}
template <bool NEXT, int NR, bool XBF, bool X1BF>
DI void postnorm_rows(const float* const (&xrow)[NR], const bf16_t* const (&yrow)[NR], const float* gpost, const float* const (&md0)[NR], float* const (&x1row)[NR],
                      const float* gpre, const float* const (&md1)[NR], bf16_t* const (&hrow)[NR], int lane) {
    f32x4 y[NR][4], x[NR][4];
#pragma unroll
    for (int r = 0; r < NR; ++r)
#pragma unroll
        for (int j = 0; j < 4; ++j) {
            const u32x2 raw = *(const u32x2*)(yrow[r] + 4 * lane + 256 * j);
            y[r][j] = (f32x4){__uint_as_float(raw.x << 16), __uint_as_float(raw.x & 0xffff0000u), __uint_as_float(raw.y << 16), __uint_as_float(raw.y & 0xffff0000u)};
            if (XBF) {
                const u32x2 rx = *(const u32x2*)((const bf16_t*)xrow[r] + 4 * lane + 256 * j);
                x[r][j] = (f32x4){__uint_as_float(rx.x << 16), __uint_as_float(rx.x & 0xffff0000u), __uint_as_float(rx.y << 16), __uint_as_float(rx.y & 0xffff0000u)};
            } else x[r][j] = *(const f32x4*)(xrow[r] + 4 * lane + 256 * j);
        }
#pragma unroll
    for (int r = 0; r < NR; ++r) {
        float s = 0.f;
#pragma unroll
        for (int j = 0; j < 4; ++j) s += (y[r][j].x * y[r][j].x + y[r][j].y * y[r][j].y) + (y[r][j].z * y[r][j].z + y[r][j].w * y[r][j].w);
        const float rr = rsqrtf(wave_sum(s) * (1.f / DM) + EPS);
        float s1 = 0.f;
#pragma unroll
        for (int j = 0; j < 4; ++j) {
            const int c = 4 * lane + 256 * j;
            const f32x4 g = *(const f32x4*)(gpost + c), gt = *(const f32x4*)(md0[r] + 2048 + c);
#pragma unroll
            for (int e = 0; e < 4; ++e) x[r][j][e] = x[r][j][e] + gt[e] * (y[r][j][e] * rr * g[e]);
            if (X1BF) { u32x2 wx; wx.x = cvtpk(x[r][j][0], x[r][j][1]); wx.y = cvtpk(x[r][j][2], x[r][j][3]); *(u32x2*)((bf16_t*)x1row[r] + c) = wx; }
            else *(f32x4*)(x1row[r] + c) = x[r][j];
            s1 += (x[r][j].x * x[r][j].x + x[r][j].y * x[r][j].y) + (x[r][j].z * x[r][j].z + x[r][j].w * x[r][j].w);
        }
        if (NEXT) {
            const float r1 = rsqrtf(wave_sum(s1) * (1.f / DM) + EPS);
#pragma unroll
            for (int j = 0; j < 4; ++j) {
                const int c = 4 * lane + 256 * j;
                const f32x4 g = *(const f32x4*)(gpre + c), a = *(const f32x4*)(md1[r] + 1024 + c), b = *(const f32x4*)(md1[r] + c);
                f32x4 o;
#pragma unroll
                for (int e = 0; e < 4; ++e) o[e] = x[r][j][e] * r1 * g[e] * (1.f + a[e]) + b[e];
                u32x2 w; w.x = cvtpk(o[0], o[1]); w.y = cvtpk(o[2], o[3]);
                *(u32x2*)(hrow[r] + c) = w;
            }
        }
    }
}

#define XB_TMO      128
#define XB_XCNT(j)  (256  + 64 * (j))
#define XB_XSUB(j)  (1280 + 64 * (j))
#define XB_XGEN(j)  (2304 + 64 * (j))
#define XB_TOP      3328
#define XB_TOPGEN   3392
#define XCD_BAR_WORDS 3456
#define XB_SPIN_CAP (1u << 18)
DI unsigned xb_ld(unsigned* p)              { return __hip_atomic_load(p, __ATOMIC_RELAXED, __HIP_MEMORY_SCOPE_AGENT); }
DI unsigned xb_add(unsigned* p, unsigned v) { return __hip_atomic_fetch_add(p, v, __ATOMIC_RELAXED, __HIP_MEMORY_SCOPE_AGENT); }
DI unsigned xb_xcc_id() { return (unsigned)__builtin_amdgcn_s_getreg((3 << 11) | 20) & 0xFu; }
#define XB_SPIN(cond, bar) do { unsigned _sp = 0; while (cond) { __builtin_amdgcn_s_sleep(1); \
    if ((++_sp & 255u) == 0u) { if (xb_ld(&(bar)[XB_TMO])) break; if (_sp > XB_SPIN_CAP) { atomicAdd(&(bar)[XB_TMO], 1u); break; } } } } while (0)
struct XcdBarrier { unsigned* bar; unsigned x; volatile LAS unsigned* st; };
DI XcdBarrier xcd_barrier_post(unsigned* bar, volatile LAS unsigned* st) {
    XcdBarrier b; b.bar = bar; b.x = xb_xcc_id(); b.st = st;
    if (threadIdx.x == 0) (void)xb_add(&bar[XB_XCNT(b.x)], 1u);
    return b;
}
DI void xcd_barrier_complete(unsigned* bar, unsigned x, unsigned& nloc, unsigned& nx) {
    const unsigned G = gridDim.x * gridDim.y * gridDim.z;
    unsigned sum, cnt, mine, sp = 0u;
    for (;;) {
        sum = 0u; cnt = 0u; mine = 0u;
#pragma unroll
        for (unsigned j = 0; j < 16; ++j) { const unsigned c = xb_ld(&bar[XB_XCNT(j)]); sum += c; cnt += (c > 0u) ? 1u : 0u; mine = (j == x) ? c : mine; }
        if (sum == G) break;
        __builtin_amdgcn_s_sleep(1);
        if ((++sp & 255u) == 0u) { if (xb_ld(&bar[XB_TMO])) break; if (sp > XB_SPIN_CAP) { atomicAdd(&bar[XB_TMO], 1u); break; } }
    }
    nloc = mine > 0u ? mine : 1u; nx = cnt > 0u ? cnt : 1u;
}
DI void xcd_barrier(const XcdBarrier& b) {
    asm volatile("s_waitcnt vmcnt(0)" ::: "memory");
    __syncthreads();
    if (threadIdx.x == 0) {
        unsigned* bar = b.bar;
        __builtin_amdgcn_s_waitcnt(0);
        unsigned nloc = b.st[0], nx = b.st[1];
        if (nloc == 0u) { xcd_barrier_complete(bar, b.x, nloc, nx); b.st[0] = nloc; b.st[1] = nx; }
        const unsigned old = xb_add(&bar[XB_XSUB(b.x)], 1u);
        const unsigned gen = old / nloc;
        if (old + 1u == (gen + 1u) * nloc) {
            __builtin_amdgcn_fence(__ATOMIC_RELEASE, "agent");
            asm volatile("s_waitcnt vmcnt(0)" ::: "memory");
            const unsigned og = xb_add(&bar[XB_TOP], 1u);
            const unsigned tg = og / nx;
            if (og + 1u == (tg + 1u) * nx) xb_add(&bar[XB_TOPGEN], 1u);
            else XB_SPIN(xb_ld(&bar[XB_TOPGEN]) == tg, bar);
            __builtin_amdgcn_fence(__ATOMIC_ACQUIRE, "agent");
            xb_add(&bar[XB_XGEN(b.x)], 1u);
            asm volatile("s_waitcnt vmcnt(0)" ::: "memory");
        } else {
            XB_SPIN(xb_ld(&bar[XB_XGEN(b.x)]) == gen, bar);
            __builtin_amdgcn_fence(__ATOMIC_ACQUIRE, "agent");
            asm volatile("s_waitcnt vmcnt(0)" ::: "memory");
        }
    }
    __syncthreads();
}

__global__ void __launch_bounds__(512, 2) fwd_megakernel(Params p) {
    extern __shared__ __attribute__((aligned(16))) unsigned char lds_raw[];
    LAS unsigned char* lds = (LAS unsigned char*)lds_raw;
    cg::grid_group grid = cg::this_grid();
    const int tid = threadIdx.x;
    const int G = gridDim.x, blk = blockIdx.x;
#define lane ((int)(threadIdx.x & 63u))
#define wave (__builtin_amdgcn_readfirstlane((int)(threadIdx.x >> 6)))
#define gw (blk * 8 + wave)
    const int NGW = G * 8;
    unsigned char* ws = p.ws;
    float* out = p.out;
    const float* x_prompt = p.in[0]; const float* x_sample = p.in[1];
    const float* st_C = p.in[2]; const float* st_n = p.in[3]; const float* st_m = p.in[4];
    const float* gpre = p.in[13]; const float* gpost = p.in[14];
    float* MOD = (float*)(ws + WS_MOD); float* Gt = (float*)(ws + WS_G); float* SC = (float*)(ws + WS_SC); float* CH = (float*)(ws + WS_CH);
    float* UN = (float*)(ws + WS_UN); float* NST = (float*)(ws + WS_NST); float* MJ = (float*)(ws + WS_MJ);
    bf16_t* CK = (bf16_t*)(ws + WS_CK); bf16_t* CVT = (bf16_t*)(ws + WS_CVT); bf16_t* NK = (bf16_t*)(ws + WS_NK); bf16_t* NVT = (bf16_t*)(ws + WS_NVT);
    bf16_t* WINE = (bf16_t*)(ws + WS_WINE); bf16_t* WOUTE = (bf16_t*)(ws + WS_WOUTE); bf16_t* WINO = (bf16_t*)(ws + WS_WINO); bf16_t* WOUTO = (bf16_t*)(ws + WS_WOUTO);
    bf16_t* H = (bf16_t*)(ws + WS_H); bf16_t* KT = (bf16_t*)(ws + WS_KT); bf16_t* VT = (bf16_t*)(ws + WS_VT); bf16_t* Y2 = (bf16_t*)(ws + WS_Y2);
    bf16_t* P = (bf16_t*)(ws + WS_P); bf16_t* CST = (bf16_t*)(ws + WS_CST); bf16_t* QB = (bf16_t*)(ws + WS_QB); bf16_t* KB = (bf16_t*)(ws + WS_KB);
    bf16_t* VBT = (bf16_t*)(ws + WS_VBT); bf16_t* U = (bf16_t*)(ws + WS_U); bf16_t* VCT = (bf16_t*)(ws + WS_VCT);
    bf16_t* X1P = (bf16_t*)(ws + WS_X1P); bf16_t* X1S = (bf16_t*)(ws + WS_X1S);
#define X1ROW(r) ((r) < MP ? X1P + (size_t)(r) * DM : X1S + (size_t)((r) - MP) * DM)
    const int lo = p.ph_lo, hi = p.ph_hi;
    volatile LAS unsigned* bst = (volatile LAS unsigned*)(lds + LDS_BYTES - 64);
    if (tid == 0) { bst[0] = 0u; bst[1] = 0u; }
    __syncthreads();
    XcdBarrier xbar = xcd_barrier_post((unsigned*)(ws + WS_BAR), bst);
    if (p.coop == 2) grid.sync();
#define IN(k) (lo <= (k) && (k) < hi)
#define SEAM(k) do { if (p.coop && IN(k) && IN((k) + 1)) { for (int sr_ = 0; sr_ < SYNC_REP; ++sr_) xcd_barrier(xbar); } } while (0)
#define REPEAT(k) _Pragma("unroll 1") for (int rep_ = 0; rep_ < 1 + ((REP_MASK >> (k)) & 1); ++rep_)

    if (IN(0)) REPEAT(0) {
        for (int mb = blk; mb < 192; mb += G) {
            const int l = mb / 96, j0 = (mb % 96) * 32;
            LAS float* sL = (LAS float*)lds;
            LAS float* red = sL + 3072;
            for (int i = tid; i < 3072; i += 512) { const int v = i >> 10, k = i & 1023; const float cv = (v == 0) ? p.in[10][k] : p.in[9][(v - 1) * 1024 + k]; sL[i] = siluf(cv); }
            __syncthreads();
            const int col = tid & 31, kg = tid >> 5;
            float a0 = 0.f, a1 = 0.f, a2 = 0.f;
            const float* wp = p.in[11] + ((size_t)l * 1024 + kg * 64) * 3072 + j0 + col;
#pragma unroll
            for (int i0 = 0; i0 < 64; i0 += 32) {
                float wv[32];
#pragma unroll
                for (int i = 0; i < 32; ++i) wv[i] = __builtin_nontemporal_load(wp + (size_t)(i0 + i) * 3072);
#pragma unroll
                for (int i = 0; i < 32; ++i) { const int k = kg * 64 + i0 + i; a0 += sL[k] * wv[i]; a1 += sL[1024 + k] * wv[i]; a2 += sL[2048 + k] * wv[i]; }
            }
            red[(0 * 16 + kg) * 32 + col] = a0; red[(1 * 16 + kg) * 32 + col] = a1; red[(2 * 16 + kg) * 32 + col] = a2;
            __syncthreads();
            if (tid < 96) { const int v = tid >> 5, c = tid & 31; float s = p.in[12][l * 3072 + j0 + c];
                for (int k2 = 0; k2 < 16; ++k2) s += red[(v * 16 + k2) * 32 + c];
                __hip_atomic_store(MOD + (l * 3 + v) * 3072 + j0 + c, s, __ATOMIC_RELAXED, __HIP_MEMORY_SCOPE_AGENT); }
            asm volatile("s_waitcnt vmcnt(0)" ::: "memory");
            __syncthreads();
            if (tid == 0) __hip_atomic_fetch_add((unsigned*)(ws + 16384) + 16 * 160, 1u, __ATOMIC_RELAXED, __HIP_MEMORY_SCOPE_AGENT);
        }
        {
            LAS float* scr = (LAS float*)(lds + wave * 16384);
            const int I_E = 16 * 121, I_O = 16 * 32;
            for (int it = gw; it < I_E + I_O; it += NGW) {
                if (it < I_E) transpose_item(p.in[15], 1024, 3856, WINE, scr, it, lane);
                else transpose_item(p.in[20], 1024, 1024, WOUTE, scr, it - I_E, lane);
            }
        }
        {
            const int gt = blk * 512 + tid, NT = G * 512;
            for (int i = gt; i < 65536; i += NT) {
                CK[i] = f2bf(p.in[5][i]);
                const int d = i & 63, s = (i >> 6) & 255, bh = i >> 14;
                CVT[(bh * 64 + d) * 256 + s] = f2bf(p.in[6][i]);
            }
        }
        __syncthreads();
        if (tid == 0) {
            unsigned* c = (unsigned*)(ws + 16384) + 16 * 160; unsigned spins = 0;
            while (__hip_atomic_load(c, __ATOMIC_RELAXED, __HIP_MEMORY_SCOPE_AGENT) < 192u) { __builtin_amdgcn_s_sleep(1); if (++spins > (1u << 22)) break; }
            __builtin_amdgcn_fence(__ATOMIC_ACQUIRE, "agent");
            asm volatile("s_waitcnt vmcnt(0)" ::: "memory");
        }
        __syncthreads();
    }
    if (IN(1)) REPEAT(1) {
        for (int row0 = gw; row0 < MROWS; row0 += 2 * NGW) {
            const float* xr[2]; const float* md[2]; bf16_t* orow[2];
#pragma unroll
            for (int r = 0; r < 2; ++r) {
                const int row = min(row0 + r * NGW, MROWS - 1);
                const int v = row < MP ? 0 : 1 + ((row - MP) >> 12);
                xr[r] = row < MP ? x_prompt + (size_t)row * DM : x_sample + (size_t)(row - MP) * DM;
                md[r] = MOD + (0 * 3 + v) * 3072; orow[r] = H + (size_t)row * DM;
            }
            prenorm_rows<2>(xr, gpre, md, orow, lane);
        }
    }
    SEAM(1);
    if (IN(2)) REPEAT(2) {
        pg8::Gemm g{H, WINE, MROWS, 4096, 1024}; pg8::StaticOrder S; S.init(MROWS, 4096, G, blk);
        EpiEvenIn E{P, KT, VT, VBT, Gt, out};
        pg8::gemm_phase(lds, g, S, E);
    }
    SEAM(2);
    if (IN(3)) REPEAT(3) {
        for (int it = gw; it < 768; it += NGW) {
            int sid, h, dir, js;
            if (it < 256) { js = it & 1; dir = (it >> 1) & 1; h = (it >> 2) & 3; sid = it >> 4; }
            else { const int r = it - 256; js = r & 31; dir = (r >> 5) & 1; h = (r >> 6) & 3; sid = 16 + (r >> 8); }
            gate_scan_item(sid, h, dir, js, lane, Gt, p.in[16], SC, CH);
        }
        for (int row0 = gw; row0 < MROWS; row0 += 2 * NGW) {
            const int row1 = row0 + NGW; const bool two = row1 < MROWS;
            u32x4 ra[2], rb[2];
            ra[0] = *(const u32x4*)(P + (size_t)row0 * NP + C_QB + lane * 8); ra[1] = *(const u32x4*)(P + (size_t)row0 * NP + C_KB + lane * 8);
            if (two) { rb[0] = *(const u32x4*)(P + (size_t)row1 * NP + C_QB + lane * 8); rb[1] = *(const u32x4*)(P + (size_t)row1 * NP + C_KB + lane * 8); }
            qknorm_item(row0, lane, ra, p.in[18], p.in[19], QB, KB, out);
            if (two) qknorm_item(row1, lane, rb, p.in[18], p.in[19], QB, KB, out);
        }
    }
    SEAM(3);
    const bool gate67 = (G >= (MROWS / 256) * (DM / 256)) && p.coop && IN(4) && IN(5) && IN(6) && IN(7);
    unsigned* pcntA = (unsigned*)(ws + 65536);
    const bool gate45 = (G == 256) && p.coop && IN(4) && IN(5) && IN(6);
    unsigned* ucnt = (unsigned*)(ws + 49152);
    if (IN(4)) REPEAT(4) {
        const WT wtw4 = mk_wt(ws, (unsigned)WS_END);
        const int NIT = 256 + 768 + 128;
        for (int it = blk; it < NIT; it += G) {
            if (it < 256) {
                const int xcd = it & 7, jj = it >> 3, b = xcd >> 2, kv = (xcd >> 1) & 1, idx = (xcd & 1) * 32 + jj, qh = kv * 4 + (idx & 3), qblk = idx >> 2;
                const int rowq = MP + b * 4096 + qblk * 256;
                attn_item<0>(lds, tid, QB + (size_t)rowq * 512 + qh * 64, 512,
                             CK + (size_t)((b * 2 + kv) * 256) * 64, 64, CVT + (size_t)((b * 2 + kv) * 64) * 256, 256, 4,
                             KB + (size_t)(MP + b * 4096) * 128 + kv * 64, 128, VBT + (size_t)(kv * 64) * MROWS + MP + b * 4096, MROWS, 64,
                             0, 0, nullptr,
                             P + (size_t)rowq * NP + C_Z + 512 + qh * 64, NP, H + (size_t)rowq * DM + 512 + qh * 64, DM, wtw4, gate67, gate67 ? pcntA + 16 * (rowq >> 8) : nullptr);
            } else if (it < 256 + 768) {
                const int r0 = it - 256; int sid, h, dir, js;
                if (r0 < 256) { js = r0 & 1; dir = (r0 >> 1) & 1; h = (r0 >> 2) & 3; sid = r0 >> 4; }
                else { const int r = r0 - 256; js = r & 31; dir = (r >> 5) & 1; h = (r >> 6) & 3; sid = 16 + (r >> 8); }
                mlstm_u_item(lds, tid, sid, h, dir, js, SC, CH, st_m, KT, VT, U, UN, wtw4, gate45 ? ucnt : nullptr);
            } else {
                const int r = it - 1024, qh = r & 7, b = r >> 3, kv = qh >> 2;
                const int rowq = b * 256;
                attn_item<0>(lds, tid, QB + (size_t)rowq * 512 + qh * 64, 512,
                             KB, 128, VBT, MROWS, 0,
                             KB + (size_t)rowq * 128 + kv * 64, 128, VBT + (size_t)(kv * 64) * MROWS + rowq, MROWS, 4,
                             0, 0, nullptr,
                             P + (size_t)rowq * NP + C_Z + 512 + qh * 64, NP, H + (size_t)rowq * DM + 512 + qh * 64, DM, wtw4, gate67, gate67 ? pcntA + 16 * (rowq >> 8) : nullptr);
            }
        }
    }
    if (!gate45) SEAM(4);
    const bool gate56 = (G == 256) && p.coop && IN(5) && IN(6);
    unsigned* chcnt = (unsigned*)(ws + 32768);
    if (IN(5)) REPEAT(5) {
        const WT wtw = mk_wt(ws, (unsigned)WS_END);
        const int NT = G * 512;
        const int nS = 16 * 2048, nP = 128 * 2048;
        const int perS = (nS + G - 1) / G;
        const int nvb = gate56 ? 2 : 1;
        const int sblk = gate56 ? blk - 128 : blk;
        if (!gate56 || blk >= 128) {
            for (int ps = 0; ps < 2; ++ps) {
                const int pass = 1 - ps;
                if (gate45) {
                    if (tid == 0) {
                        unsigned spins = 0; bool ok = false;
                        while (!ok) {
                            ok = true;
                            for (int vbi = 0; vbi < 2; ++vbi) {
                                const int vb = sblk + 128 * vbi;
                                if (pass == 1) {
                                    ok = ok && __hip_atomic_load(ucnt + 16 * (vb >> 2), __ATOMIC_RELAXED, __HIP_MEMORY_SCOPE_AGENT) >= 2u
                                            && __hip_atomic_load(ucnt + 16 * ((vb >> 2) + 64), __ATOMIC_RELAXED, __HIP_MEMORY_SCOPE_AGENT) >= 2u;
                                    if (vb < 36) for (int q = 0; q < 4; ++q) { const int c = vb * 4 + q; ok = ok && __hip_atomic_load(ucnt + 16 * c, __ATOMIC_RELAXED, __HIP_MEMORY_SCOPE_AGENT) >= (c < 128 ? 2u : 32u); }
                                } else ok = ok && __hip_atomic_load(ucnt + 16 * (128 + (vb >> 4)), __ATOMIC_RELAXED, __HIP_MEMORY_SCOPE_AGENT) >= 32u;
                            }
                            if (!ok) { __builtin_amdgcn_s_sleep(1); if (++spins > (1u << 22)) break; }
                        }
                        __builtin_amdgcn_fence(__ATOMIC_ACQUIRE, "agent");
                        asm volatile("s_waitcnt vmcnt(0)" ::: "memory");
                    }
                    __syncthreads();
                }
                for (int vbi = 0; vbi < nvb; ++vbi) {
                    const int vb = sblk + 128 * vbi;
                    int i0, i1, st;
                    if (pass == 1) { i0 = vb * 512 + tid; i1 = nP; st = NT; }
                    else if (gate56) { const bool on = (vbi == 0) && (tid < 256); i0 = on ? (sblk + 128 * (tid >> 7)) * 128 + (tid & 127) : 0; i1 = on ? i0 + 1 : 0; st = 1; }
                    else { i0 = vb * perS + tid; i1 = min((vb + 1) * perS, nS); st = 512; }
                    for (int idx0 = i0; idx0 < i1; idx0 += st) {
            const int idx = pass == 0 ? nP + idx0 : idx0;
            const int chain = idx >> 11, e8 = (idx & 2047) * 8;
            int sid, h, dir;
            if (chain < 128) { dir = chain & 1; h = (chain >> 1) & 3; sid = chain >> 3; } else { const int r = chain - 128; dir = r & 1; h = (r >> 1) & 3; sid = 16 + (r >> 3); }
            const int nc = sid < 16 ? 2 : 32, base = chain_base(sid, h, dir);
            float cur[8];
            if (sid < 16) {
#pragma unroll
                for (int e = 0; e < 8; ++e) cur[e] = 0.f;
            } else {
                const float* c0 = st_C + ((size_t)(((sid - 16) * 2 + dir) * 4 + h)) * 16384 + e8;
                const f32x4 a = *(const f32x4*)c0, b = *(const f32x4*)(c0 + 4);
                cur[0] = a[0]; cur[1] = a[1]; cur[2] = a[2]; cur[3] = a[3]; cur[4] = b[0]; cur[5] = b[1]; cur[6] = b[2]; cur[7] = b[3];
            }
            float m = chain_m0(st_m, sid, h, dir);
            const bf16_t* __restrict__ Ub = U + (size_t)base * 16384 + e8;
            bf16_t* __restrict__ Cb = CST + (size_t)base * 16384 + e8;
            for (int js0 = 0; js0 < nc; js0 += 8) {
                u32x4 raw[8];
#pragma unroll
                for (int j = 0; j < 8; ++j) if (js0 + j < nc) raw[j] = *(const u32x4*)(Ub + (size_t)(js0 + j) * 16384);
#pragma unroll
                for (int j = 0; j < 8; ++j) if (js0 + j < nc) {
                    const int js = js0 + j;
                    const float bL = CH[(base + js) * 2], rmL = CH[(base + js) * 2 + 1];
                    const float Mx = fmaxf(m, rmL), a = expf(m - Mx), f = expf(rmL - Mx);
                    if (e8 == 0) __hip_atomic_store(MJ + base + js, m, __ATOMIC_RELAXED, __HIP_MEMORY_SCOPE_AGENT);
                    u32x4 wv; wv.x = cvtpk(cur[0], cur[1]); wv.y = cvtpk(cur[2], cur[3]); wv.z = cvtpk(cur[4], cur[5]); wv.w = cvtpk(cur[6], cur[7]);
                    wt16(wtw, Cb + (size_t)js * 16384, wv);
                    cur[0] = a * cur[0] + f * __uint_as_float(raw[j].x << 16); cur[1] = a * cur[1] + f * __uint_as_float(raw[j].x & 0xffff0000u);
                    cur[2] = a * cur[2] + f * __uint_as_float(raw[j].y << 16); cur[3] = a * cur[3] + f * __uint_as_float(raw[j].y & 0xffff0000u);
                    cur[4] = a * cur[4] + f * __uint_as_float(raw[j].z << 16); cur[5] = a * cur[5] + f * __uint_as_float(raw[j].z & 0xffff0000u);
                    cur[6] = a * cur[6] + f * __uint_as_float(raw[j].w << 16); cur[7] = a * cur[7] + f * __uint_as_float(raw[j].w & 0xffff0000u);
                    m = bL + Mx;
                }
            }
            if (sid < 16) {
                float* o = out + O_C + ((size_t)((sid * 2 + dir) * 4 + h)) * 16384 + e8;
                *(f32x4*)o = (f32x4){cur[0], cur[1], cur[2], cur[3]}; *(f32x4*)(o + 4) = (f32x4){cur[4], cur[5], cur[6], cur[7]};
            }
                            }
                }
                if (pass == 1) {
                    for (int vbi = 0; vbi < nvb; ++vbi)
                    for (int idx = (sblk + 128 * vbi) * 512 + tid; idx < 144 * 128; idx += NT) {
            const int chain = idx >> 7, k = idx & 127;
            int sid, h, dir;
            if (chain < 128) { dir = chain & 1; h = (chain >> 1) & 3; sid = chain >> 3; } else { const int r = chain - 128; dir = r & 1; h = (r >> 1) & 3; sid = 16 + (r >> 3); }
            const int nc = sid < 16 ? 2 : 32, base = chain_base(sid, h, dir);
            float cur = sid < 16 ? 0.f : st_n[(((sid - 16) * 2 + dir) * 4 + h) * 128 + k];
            float m = chain_m0(st_m, sid, h, dir);
            for (int js0 = 0; js0 < nc; js0 += 8) {
                float un[8];
#pragma unroll
                for (int j = 0; j < 8; ++j) if (js0 + j < nc) un[j] = UN[(size_t)(base + js0 + j) * 128 + k];
#pragma unroll
                for (int j = 0; j < 8; ++j) if (js0 + j < nc) {
                    const int js = js0 + j;
                    const float bL = CH[(base + js) * 2], rmL = CH[(base + js) * 2 + 1];
                    const float Mx = fmaxf(m, rmL), a = expf(m - Mx), f = expf(rmL - Mx);
                    __hip_atomic_store(NST + (size_t)(base + js) * 128 + k, cur, __ATOMIC_RELAXED, __HIP_MEMORY_SCOPE_AGENT);
                    cur = a * cur + f * un[j];
                    m = bL + Mx;
                }
            }
            if (sid < 16) {
                out[O_N + ((size_t)((sid * 2 + dir) * 4 + h)) * 128 + k] = cur;
                if (k == 0) out[O_M + (sid * 2 + dir) * 4 + h] = m;
            }
                            }
                }
                if (gate56) {
                    asm volatile("s_waitcnt vmcnt(0)" ::: "memory");
                    __syncthreads();
                    if (tid == 0) {
                        for (int vbi = 0; vbi < 2; ++vbi) {
                            const int vb = sblk + 128 * vbi;
                            if (pass == 1) {
                                __hip_atomic_fetch_add(chcnt + 16 * (vb >> 2), 1u, __ATOMIC_RELAXED, __HIP_MEMORY_SCOPE_AGENT);
                                __hip_atomic_fetch_add(chcnt + 16 * ((vb >> 2) + 64), 1u, __ATOMIC_RELAXED, __HIP_MEMORY_SCOPE_AGENT);
                                if (vb < 36) for (int q = 0; q < 4; ++q) __hip_atomic_fetch_add(chcnt + 16 * (vb * 4 + q), 1u, __ATOMIC_RELAXED, __HIP_MEMORY_SCOPE_AGENT);
                            } else {
                                __hip_atomic_fetch_add(chcnt + 16 * (128 + (vb >> 4)), 1u, __ATOMIC_RELAXED, __HIP_MEMORY_SCOPE_AGENT);
                            }
                        }
                    }
                }
            }
        } else {
            const int r = blk, jt = r & 1, h = (r >> 1) & 3, sid = r >> 3;
            if (tid == 0) {
                const int c0 = (sid * 4 + h) * 2; unsigned spins = 0;
                while (__hip_atomic_load(chcnt + 16 * c0, __ATOMIC_RELAXED, __HIP_MEMORY_SCOPE_AGENT) < 5u ||
                       __hip_atomic_load(chcnt + 16 * (c0 + 1), __ATOMIC_RELAXED, __HIP_MEMORY_SCOPE_AGENT) < 5u) { __builtin_amdgcn_s_sleep(1); if (++spins > (1u << 22)) break; }
                __builtin_amdgcn_fence(__ATOMIC_ACQUIRE, "agent");
                asm volatile("s_waitcnt vmcnt(0)" ::: "memory");
            }
            __syncthreads();
            mlstm_out_item(lds, tid, sid, h, jt, SC, MJ, NST, CST, P, VT, p.in[17], H, wtw, gate67, gate67 ? pcntA : nullptr);
        }
    }
    if (!gate56) SEAM(5);
    if (IN(6)) REPEAT(6) {
        const WT wtw = mk_wt(ws, (unsigned)WS_END);
        for (int it = blk; it < (gate56 ? 256 : 384); it += G) {
            int sid, h, jt;
            if (it < 256) { jt = it & 31; h = (it >> 5) & 3; sid = 16 + (it >> 7); }
            else { const int r = it - 256; jt = r & 1; h = (r >> 1) & 3; sid = r >> 3; }
            if (gate56) {
                if (tid == 0) {
                    const int c0 = 128 + ((sid - 16) * 4 + h) * 2; unsigned spins = 0;
                    while (__hip_atomic_load(chcnt + 16 * c0, __ATOMIC_RELAXED, __HIP_MEMORY_SCOPE_AGENT) < 17u ||
                           __hip_atomic_load(chcnt + 16 * (c0 + 1), __ATOMIC_RELAXED, __HIP_MEMORY_SCOPE_AGENT) < 17u) { __builtin_amdgcn_s_sleep(1); if (++spins > (1u << 22)) break; }
                    __builtin_amdgcn_fence(__ATOMIC_ACQUIRE, "agent");
                    asm volatile("s_waitcnt vmcnt(0)" ::: "memory");
                }
                __syncthreads();
            }
            mlstm_out_item(lds, tid, sid, h, jt, SC, MJ, NST, CST, P, VT, p.in[17], H, wtw, gate67, gate67 ? pcntA : nullptr);
        }
    }
    if (!gate67) SEAM(6);
    const bool fuse_mid = (G >= (MROWS / 256) * (DM / 256));
    if (IN(7)) REPEAT(7) {
        pg8::Gemm g{H, WOUTE, MROWS, 1024, 1024}; pg8::StaticOrder S; S.init(MROWS, 1024, G, blk);
        if (fuse_mid) {
            if (gate67) {
                pg8::Unit u0;
                if (S.next(0, u0)) {
                    if (tid == 0) {
                        unsigned spins = 0;
                        while (__hip_atomic_load(pcntA + 16 * u0.pm, __ATOMIC_RELAXED, __HIP_MEMORY_SCOPE_AGENT) < 16u) { __builtin_amdgcn_s_sleep(1); if (++spins > (1u << 22)) break; }
                        __builtin_amdgcn_fence(__ATOMIC_ACQUIRE, "agent");
                        asm volatile("s_waitcnt vmcnt(0)" ::: "memory");
                    }
                }
                __syncthreads();
            }
            EpiMid E{x_prompt, x_sample, MOD, gpost, gpre + DM, X1P, X1S, H, (float*)(ws + WS_G), (unsigned*)(ws + 16384)};
            pg8::gemm_phase(lds, g, S, E);
        } else {
            EpiPlain E{Y2, DM};
            pg8::gemm_phase(lds, g, S, E);
        }
        {
            const int nunits = (MROWS / 256) * (DM / 256);
            const bool some_idle = G > nunits;
            if (!some_idle || blk >= nunits) {
                const int nw = some_idle ? G - nunits : G, ib = some_idle ? blk - nunits : blk;
                LAS float* scr = (LAS float*)(lds + wave * 16384);
                const int I_C = 16 * 128, I_O = 16 * 32;
                for (int it = ib * 8 + wave; it < I_C + I_O; it += nw * 8) {
                    if (it < I_C) transpose_item(p.in[21], 1024, 4096, WINO, scr, it, lane);
                    else transpose_item(p.in[23], 1024, 1024, WOUTO, scr, it - I_C, lane);
                }
                const int NT = nw * 512;
                for (int i0 = ib * 512 + tid; i0 < 524288; i0 += 4 * NT) {
                    float ka[4], va[4];
#pragma unroll
                    for (int k = 0; k < 4; ++k) { const int i = i0 + k * NT; if (i < 524288) { ka[k] = p.in[7][i]; va[k] = p.in[8][i]; } }
#pragma unroll
                    for (int k = 0; k < 4; ++k) { const int i = i0 + k * NT; if (i < 524288) {
                        NK[i] = f2bf(ka[k]);
                        const int d = i & 63, s2 = (i >> 6) & 255, bh = i >> 14;
                        NVT[(bh * 64 + d) * 256 + s2] = f2bf(va[k]); } }
                }
            }
        }
    }
    SEAM(7);
    if (!fuse_mid) {
    if (IN(8)) REPEAT(8) {
        for (int row0 = gw; row0 < MROWS; row0 += 2 * NGW) {
            const float* xr[2]; const bf16_t* yr[2]; const float* md0[2]; const float* md1[2]; float* x1r[2]; bf16_t* hr[2];
#pragma unroll
            for (int r = 0; r < 2; ++r) {
                const int row = min(row0 + r * NGW, MROWS - 1);
                const int v = row < MP ? 0 : 1 + ((row - MP) >> 12);
                xr[r] = row < MP ? x_prompt + (size_t)row * DM : x_sample + (size_t)(row - MP) * DM;
                yr[r] = Y2 + (size_t)row * DM; md0[r] = MOD + (0 * 3 + v) * 3072; md1[r] = MOD + (1 * 3 + v) * 3072;
                x1r[r] = (float*)X1ROW(row); hr[r] = H + (size_t)row * DM;
            }
            postnorm_rows<true, 2, false, true>(xr, yr, gpost, md0, x1r, gpre + DM, md1, hr, lane);
        }
    }
    SEAM(8);
    }
    if (IN(9)) REPEAT(9) {
        pg8::Gemm g{H, WINO, MROWS, 4096, 1024}; pg8::StaticOrder S; S.init(MROWS, 4096, G, blk);
        EpiOddIn E{P, VCT, out};
        pg8::gemm_phase(lds, g, S, E);
    }
    SEAM(9);
    const bool gate1011 = (G >= (MROWS / 256) * (DM / 256)) && p.coop && IN(10) && IN(11);
    unsigned* pcntB = (unsigned*)(ws + 62464);
    if (IN(10)) REPEAT(10) {
        const WT wtw10 = mk_wt(ws, (unsigned)WS_END);
        LAS float* rpbL = (LAS float*)(lds + 8 * AT_TILE);
        for (int it = blk; it < 512 + 256; it += G) {
            if (it < 512) {
                const int xcd = it & 7, jj = (it >> 3) & 31, b = it >> 8, h = 2 * xcd + (jj >> 4), rblk = jj & 15;
                for (int i = tid; i < 640; i += 512) { const int j = i - 64; rpbL[i] = (j >= 0 && j < 465) ? p.in[22][h * 465 + j] * LOG2E : 0.f; }
                const int r0 = rblk * 4;
                const int rs_lo = min(max(r0 - 4, 0), 56), rs_hi = min(max(r0 + 3 - 4, 0), 56) + 7;
                const int rowq = MP + b * 4096 + r0 * 64, rowk = MP + b * 4096 + rs_lo * 64;
                attn_item<1>(lds, tid, P + (size_t)rowq * NP + h * 64, NP,
                             NK + (size_t)((b * 16 + h) * 256) * 64, 64, NVT + (size_t)((b * 16 + h) * 64) * 256, 256, 4,
                             P + (size_t)rowk * NP + 1024 + h * 64, NP, VCT + (size_t)(h * 64) * MROWS + rowk, MROWS, rs_hi - rs_lo + 1,
                             r0, rs_lo, rpbL,
                             P + (size_t)rowq * NP + 3072 + h * 64, NP, H + (size_t)rowq * DM + h * 64, DM, wtw10, gate1011, gate1011 ? pcntB + 16 * (rowq >> 8) : nullptr);
            } else {
                const int r = it - 512, h = r & 15, b = r >> 4;
                const int rowq = b * 256;
                attn_item<0>(lds, tid, P + (size_t)rowq * NP + h * 64, NP,
                             P, NP, VCT, MROWS, 0,
                             P + (size_t)rowq * NP + 1024 + h * 64, NP, VCT + (size_t)(h * 64) * MROWS + rowq, MROWS, 4,
                             0, 0, nullptr,
                             P + (size_t)rowq * NP + 3072 + h * 64, NP, H + (size_t)rowq * DM + h * 64, DM, wtw10, gate1011, gate1011 ? pcntB + 16 * (rowq >> 8) : nullptr);
            }
        }
    }
    if (!gate1011) SEAM(10);
    const bool fuse_last = (G >= (MROWS / 256) * (DM / 256));
    if (IN(11)) REPEAT(11) {
        pg8::Gemm g{H, WOUTO, MROWS, 1024, 1024}; pg8::StaticOrder S; S.init(MROWS, 1024, G, blk);
        if (fuse_last) {
            if (gate1011) {
                pg8::Unit u0;
                if (S.next(0, u0)) {
                    if (tid == 0) {
                        unsigned spins = 0;
                        while (__hip_atomic_load(pcntB + 16 * u0.pm, __ATOMIC_RELAXED, __HIP_MEMORY_SCOPE_AGENT) < 16u) { __builtin_amdgcn_s_sleep(1); if (++spins > (1u << 22)) break; }
                        __builtin_amdgcn_fence(__ATOMIC_ACQUIRE, "agent");
                        asm volatile("s_waitcnt vmcnt(0)" ::: "memory");
                    }
                }
                __syncthreads();
            }
            EpiFinal E{X1P, X1S, MOD, gpost + DM, out, (float*)(ws + WS_G), (unsigned*)(ws + 16384)};
            pg8::gemm_phase(lds, g, S, E);
        } else {
            EpiPlain E{Y2, DM};
            pg8::gemm_phase(lds, g, S, E);
        }
    }
    if (!fuse_last) {
    SEAM(11);
    if (IN(12)) {
        for (int row0 = gw; row0 < MROWS; row0 += 2 * NGW) {
            const float* xr[2]; const bf16_t* yr[2]; const float* md1[2]; float* x1r[2]; bf16_t* hr[2];
#pragma unroll
            for (int r = 0; r < 2; ++r) {
                const int row = min(row0 + r * NGW, MROWS - 1);
                const int v = row < MP ? 0 : 1 + ((row - MP) >> 12);
                xr[r] = (const float*)X1ROW(row); yr[r] = Y2 + (size_t)row * DM; md1[r] = MOD + (1 * 3 + v) * 3072; x1r[r] = out + (size_t)row * DM; hr[r] = nullptr;
            }
            postnorm_rows<false, 2, true, false>(xr, yr, gpost + DM, md1, x1r, nullptr, md1, hr, lane);
        }
    }
    }
#undef IN
#undef SEAM
#undef REPEAT
#undef lane
#undef wave
#undef gw
#undef X1ROW
}

#ifndef MK_COOP
#define MK_COOP 1
#endif
extern "C" void kernel_launch(void* const* d_in, const int* in_sizes, int n_in, void* d_out, int out_size, void* d_ws, size_t ws_size, hipStream_t stream) {
    static int grid = 0;
    if (grid == 0) {
        int dev = 0, cus = 0, per_cu = 0;
        (void)hipGetDevice(&dev);
        (void)hipDeviceGetAttribute(&cus, hipDeviceAttributeMultiprocessorCount, dev);
        (void)hipFuncSetAttribute((const void*)fwd_megakernel, hipFuncAttributeMaxDynamicSharedMemorySize, LDS_BYTES);
        (void)hipOccupancyMaxActiveBlocksPerMultiprocessor(&per_cu, (const void*)fwd_megakernel, 512, LDS_BYTES);
        if (per_cu < 1) { fprintf(stderr, "kernel_launch: occupancy query returned %d\n", per_cu); per_cu = 1; }
        grid = cus * per_cu;
        if (ws_size < WS_END) fprintf(stderr, "kernel_launch: workspace too small (%zu < %zu)\n", ws_size, (size_t)WS_END);
    }
    Params p{};
    for (int i = 0; i < 24; ++i) p.in[i] = (const float*)d_in[i];
    p.out = (float*)d_out; p.ws = (unsigned char*)d_ws;
#if MK_COOP
    p.ph_lo = 0; p.ph_hi = 13; p.coop = 1; p.pad = 0;
    void* args[] = {&p};
    (void)hipMemsetAsync((char*)d_ws + WS_BAR, 0, 131072, stream);
    hipError_t e = hipLaunchCooperativeKernel((const void*)fwd_megakernel, dim3(grid), dim3(512), args, LDS_BYTES, stream);
    if (e != hipSuccess) fprintf(stderr, "cooperative launch failed: %s (grid %d)\n", hipGetErrorString(e), grid);
#else
    for (int ph = 0; ph < 13; ++ph) {
        p.ph_lo = ph; p.ph_hi = ph + 1; p.coop = 0; p.pad = 0;
        hipLaunchKernelGGL(fwd_megakernel, dim3(grid), dim3(512), LDS_BYTES, stream, p);
    }
#endif
}
```

```cpp
#include <hip/hip_runtime.h>
#include <hip/hip_cooperative_groups.h>
#include <cstdio>
#include <cstdint>
namespace cg = cooperative_groups;

#define LAS __attribute__((address_space(3)))
#define DI __device__ __forceinline__
typedef unsigned short bf16_t;
typedef short bf16x8 __attribute__((ext_vector_type(8)));
typedef short s16x4 __attribute__((ext_vector_type(4)));
typedef float f32x4 __attribute__((ext_vector_type(4)));
typedef float f32x2 __attribute__((ext_vector_type(2)));
typedef float f32x16 __attribute__((ext_vector_type(16)));
typedef unsigned u32x4 __attribute__((ext_vector_type(4)));
typedef unsigned u32x2 __attribute__((ext_vector_type(2)));
typedef __bf16 bf16x2_t __attribute__((ext_vector_type(2)));

constexpr int DM = 1024, MP = 4096, MS = 8192, MROWS = 12288, NP = 4096;
constexpr float EPS = 1e-6f;
constexpr float LOG2E = 1.4426950408889634f;
constexpr float QSCALE = 0.125f * LOG2E;
constexpr int C_QA = 0, C_KA = 512, C_VA = 1024, C_OA = 1536, C_G = 2048, C_QB = 2064, C_KB = 2576, C_VB = 2704, C_Z = 2832, C_END = 3856;
constexpr size_t O_YP = 0, O_YS = 4194304, O_C = 12582912, O_N = 14680064, O_M = 14696448, O_GK = 14696576, O_GV = 15220864, O_NK = 15745152, O_NV = 19939456;
constexpr size_t MiB = 1u << 20;
constexpr size_t WS_BAR = 0;
constexpr size_t WS_MOD = 1 * MiB;
constexpr size_t WS_G = 2 * MiB;
constexpr size_t WS_SC = 3 * MiB;
constexpr size_t WS_CH = 5 * MiB;
constexpr size_t WS_UN = 5 * MiB + 65536;
constexpr size_t WS_NST = 5 * MiB + 65536 + 393216;
constexpr size_t WS_MJ = 5 * MiB + 65536 + 786432;
constexpr size_t WS_CK = 6 * MiB;
constexpr size_t WS_CVT = 6 * MiB + 131072;
constexpr size_t WS_NK = 7 * MiB;
constexpr size_t WS_NVT = 8 * MiB;
constexpr size_t WS_WINE = 10 * MiB;
constexpr size_t WS_WOUTE = 18 * MiB;
constexpr size_t WS_WINO = 20 * MiB;
constexpr size_t WS_WOUTO = 28 * MiB;
constexpr size_t WS_H = 30 * MiB;
constexpr size_t WS_KT = 54 * MiB;
constexpr size_t WS_VT = 66 * MiB;
constexpr size_t WS_Y2 = 54 * MiB;
constexpr size_t WS_P = 78 * MiB;
constexpr size_t WS_CST = 174 * MiB;
constexpr size_t WS_QB = 198 * MiB;
constexpr size_t WS_KB = 210 * MiB;
constexpr size_t WS_VBT = 213 * MiB;
constexpr size_t WS_U = 216 * MiB;
constexpr size_t WS_VCT = 216 * MiB;
constexpr size_t WS_X1P = 10 * MiB;
constexpr size_t WS_X1S = 240 * MiB;
constexpr size_t WS_END = 256 * MiB;

constexpr int REP_MASK = 0, SYNC_REP = 1;
constexpr int LDS_BYTES = 147456;

DI float bf2f(unsigned short b) { return __uint_as_float(((unsigned)b) << 16); }
DI unsigned cvtpk(float lo, float hi) { f32x2 v = {lo, hi}; bf16x2_t b = __builtin_convertvector(v, bf16x2_t); return __builtin_bit_cast(unsigned, b); }
DI unsigned short f2bf(float x) { return (unsigned short)(cvtpk(x, 0.f) & 0xffffu); }
DI float siluf(float x) { return x / (1.f + __expf(-x)); }
DI float sigmf(float x) { return 1.f / (1.f + __expf(-x)); }
DI float wave_sum(float v) {
#pragma unroll
    for (int o = 1; o < 64; o <<= 1) v += __shfl_xor(v, o);
    return v;
}
DI int crow(int i, int h) { return (i & 3) + 8 * (i >> 2) + 4 * h; }
DI bf16x8 pack8(float a0, float a1, float a2, float a3, float a4, float a5, float a6, float a7) {
    u32x4 p; p.x = cvtpk(a0, a1); p.y = cvtpk(a2, a3); p.z = cvtpk(a4, a5); p.w = cvtpk(a6, a7);
    return __builtin_bit_cast(bf16x8, p);
}
#define MFMA32(a, b, c) __builtin_amdgcn_mfma_f32_32x32x16_bf16((a), (b), (c), 0, 0, 0)

namespace pg8 {
constexpr int BM = 256, BK = 64, HALF = 128, HTB = HALF * BK * 2, NXCD = 8, WGM = 8;
DI int lds_byte(int r, int c) { const int st = (r >> 4) * 2 + (c >> 5), rr = r & 15, cc = c & 31, ob = rr * 64 + cc * 2; return st * 1024 + (ob ^ (((ob >> 9) & 1) << 5)); }
DI void stage_rc(int b, int& R, int& C) { const int st = b / 1024, sb = b % 1024, swz = sb ^ (((sb >> 9) & 1) << 5); R = (st >> 1) * 16 + swz / 64; C = (st & 1) * 32 + (swz % 64) / 2; }
DI int perm32(int rho) { const int n = rho >> 4, i = rho & 15; return 8 * (i >> 2) + 4 * n + (i & 3); }
struct Unit { int pm, pn; };
struct Gemm { const bf16_t* A; const bf16_t* Bt; int M, N, K; };
struct StaticOrder {
    int nM, nN, nwg, G, c;
    DI void init(int M, int N, int G_, int c_) { nM = M / BM; nN = N / BM; nwg = nM * nN; G = G_; c = c_; }
    DI bool next(int i, Unit& u) const {
        const long L = (long)i * G + c; if (L >= nwg) return false;
        int wgid = (int)L; { const int q = nwg / NXCD, r = nwg % NXCD, xcd = wgid % NXCD, off = wgid / NXCD; wgid = (xcd < r ? xcd * (q + 1) : r * (q + 1) + (xcd - r) * q) + off; }
        const int nig = WGM * nN, gid = wgid / nig, fm = gid * WGM, gsz = (nM - fm) < WGM ? (nM - fm) : WGM;
        u.pm = fm + ((wgid % nig) % gsz); u.pn = (wgid % nig) / gsz; return true;
    }
};
template <class Epi>
DI void gemm_phase(LAS unsigned char* lds, const Gemm g, const StaticOrder& S, const Epi& E) {
    const int tid = threadIdx.x, wid = __builtin_amdgcn_readfirstlane(tid >> 6), lane = tid & 63, wr = wid >> 2, wc = wid & 3, fr = lane & 15, fq = lane >> 4;
    const int K = g.K, nt = K / BK;
    unsigned voffA[2], voffB[2];
#pragma unroll
    for (int i = 0; i < 2; ++i) { int R, C; stage_rc(tid * 16 + i * 8192, R, C); const int Rb = (R & ~31) + perm32(R & 31);
        voffA[i] = (unsigned)(R * K + C) * 2u; voffB[i] = (unsigned)(Rb * K + C) * 2u; }
    const size_t kstep = (size_t)(BK * 2);
    const size_t hstep = (size_t)HALF * K * 2;
    const size_t tstep = 2 * hstep;
    const unsigned ldsw = (unsigned)wid * 1024u;
    const int aoff = lds_byte(wr * 64 + fr, fq * 8), boff = lds_byte(wc * 32 + fr, fq * 8);
#define PG8_SA(b, h) (((b) * 2 + (h)) * HTB)
#define PG8_SB(b, h) ((4 + (b) * 2 + (h)) * HTB)
#define PG8_STAGE(bufoff, gbase, voff) do { _Pragma("unroll") for (int _i = 0; _i < 2; ++_i) \
        __builtin_amdgcn_global_load_lds((const unsigned*)((const char*)(gbase) + (voff)[_i]), (LAS unsigned*)(lds + (bufoff) + ldsw + _i * 8192), 16, 0, 0); } while (0)
#define PG8_LDA(dst, b, h) do { _Pragma("unroll") for (int m = 0; m < 4; ++m) _Pragma("unroll") for (int k = 0; k < 2; ++k) dst[m][k] = *(const LAS bf16x8*)(lds + PG8_SA(b, h) + aoff + m * 2048 + k * 1024); } while (0)
#define PG8_LDB(dst, b, h) do { _Pragma("unroll") for (int n = 0; n < 2; ++n) _Pragma("unroll") for (int k = 0; k < 2; ++k) dst[n][k] = *(const LAS bf16x8*)(lds + PG8_SB(b, h) + boff + n * 2048 + k * 1024); } while (0)
#define PG8_MMA(ai, bj, At, Bt) do { __builtin_amdgcn_s_setprio(1); _Pragma("unroll") for (int m = 0; m < 4; ++m) _Pragma("unroll") for (int n = 0; n < 2; ++n) _Pragma("unroll") for (int k = 0; k < 2; ++k) \
        acc[ai][bj][m][n] = __builtin_amdgcn_mfma_f32_16x16x32_bf16(Bt[n][k], At[m][k], acc[ai][bj][m][n], 0, 0, 0); __builtin_amdgcn_s_setprio(0); } while (0)
#define PG8_WAIT_V(n) asm volatile("s_waitcnt vmcnt(" #n ")" ::: "memory")
#define PG8_WAIT_L(n) asm volatile("s_waitcnt lgkmcnt(" #n ")" ::: "memory")
#define PG8_BAR __builtin_amdgcn_s_barrier()
#define PG8_SCHED __builtin_amdgcn_sched_barrier(0)
    Unit cur, nxt; int ui = 0;
    if (!S.next(0, cur)) return;
    f32x4 acc[2][2][4][2];
#pragma unroll
    for (int a = 0; a < 2; ++a)
#pragma unroll
        for (int b = 0; b < 2; ++b)
#pragma unroll
            for (int m = 0; m < 4; ++m)
#pragma unroll
                for (int n = 0; n < 2; ++n) acc[a][b][m][n] = (f32x4){0.f, 0.f, 0.f, 0.f};
    bf16x8 At[4][2], B0[2][2], B1[2][2];
    const char* cA = (const char*)g.A + (size_t)cur.pm * tstep; const char* cB = (const char*)g.Bt + (size_t)cur.pn * tstep;
    PG8_STAGE(PG8_SB(0, 0), cB, voffB); PG8_STAGE(PG8_SB(0, 1), cB + hstep, voffB); PG8_STAGE(PG8_SA(0, 0), cA, voffA); PG8_STAGE(PG8_SA(0, 1), cA + hstep, voffA);
    if (wr == 1) PG8_BAR;
    PG8_WAIT_V(2); PG8_BAR;
    PG8_STAGE(PG8_SB(1, 0), cB + kstep, voffB); PG8_STAGE(PG8_SA(1, 0), cA + kstep, voffA); PG8_STAGE(PG8_SB(1, 1), cB + hstep + kstep, voffB);
    PG8_WAIT_V(6); PG8_BAR;
    for (;;) {
        const bool has_next = S.next(ui + 1, nxt);
        const char* nA = has_next ? (const char*)g.A + (size_t)nxt.pm * tstep : cA; const char* nB = has_next ? (const char*)g.Bt + (size_t)nxt.pn * tstep : cB;
        for (int t = 0; t < nt; t += 2) {
            const bool last = (t == nt - 2);
            const char* a1 = cA + (size_t)(t + 1) * kstep;
            const char* a2 = last ? nA : cA + (size_t)(t + 2) * kstep; const char* b2 = last ? nB : cB + (size_t)(t + 2) * kstep;
            const char* a3 = a2 + kstep; const char* b3 = b2 + kstep;
            PG8_LDB(B0, 0, 0); PG8_LDB(B1, 0, 1); PG8_SCHED; PG8_LDA(At, 0, 0); PG8_STAGE(PG8_SA(1, 1), a1 + hstep, voffA);
            PG8_WAIT_V(8); PG8_WAIT_L(0); PG8_BAR; PG8_MMA(0, 0, At, B0); PG8_MMA(0, 1, At, B1); PG8_BAR; PG8_SCHED;
            PG8_LDA(At, 0, 1); PG8_STAGE(PG8_SB(0, 0), b2, voffB); PG8_STAGE(PG8_SB(0, 1), b2 + hstep, voffB); PG8_STAGE(PG8_SA(0, 0), a2, voffA);
            PG8_WAIT_V(8); PG8_WAIT_L(0); PG8_BAR; PG8_MMA(1, 0, At, B0); PG8_MMA(1, 1, At, B1); PG8_BAR; PG8_SCHED;
            PG8_LDB(B0, 1, 0); PG8_LDB(B1, 1, 1); PG8_SCHED; PG8_LDA(At, 1, 0); PG8_STAGE(PG8_SA(0, 1), a2 + hstep, voffA);
            PG8_WAIT_V(8); PG8_WAIT_L(0); PG8_BAR; PG8_MMA(0, 0, At, B0); PG8_MMA(0, 1, At, B1); PG8_BAR; PG8_SCHED;
            PG8_LDA(At, 1, 1); PG8_STAGE(PG8_SB(1, 0), b3, voffB); PG8_STAGE(PG8_SB(1, 1), b3 + hstep, voffB); PG8_STAGE(PG8_SA(1, 0), a3, voffA);
            PG8_WAIT_V(8); PG8_WAIT_L(0); PG8_BAR; PG8_MMA(1, 0, At, B0); PG8_MMA(1, 1, At, B1); PG8_BAR; PG8_SCHED;
        }
        if (wr == 0) PG8_BAR;
        if constexpr (!Epi::AFTER_DRAIN) E(acc, cur, wr, wc, fr, fq);
        if (!has_next) break;
#pragma unroll
        for (int a = 0; a < 2; ++a)
#pragma unroll
            for (int b = 0; b < 2; ++b)
#pragma unroll
                for (int m = 0; m < 4; ++m)
#pragma unroll
                    for (int n = 0; n < 2; ++n) acc[a][b][m][n] = (f32x4){0.f, 0.f, 0.f, 0.f};
        cur = nxt; cA = nA; cB = nB; ++ui;
        if (wr == 1) PG8_BAR;
    }
    PG8_WAIT_V(0);
    PG8_BAR;
    if constexpr (Epi::AFTER_DRAIN) E.fused(acc, cur, wr, wc, fr, fq, lds, wid, lane);
#undef PG8_SA
#undef PG8_SB
#undef PG8_STAGE
#undef PG8_LDA
#undef PG8_LDB
#undef PG8_MMA
#undef PG8_WAIT_V
#undef PG8_WAIT_L
#undef PG8_BAR
#undef PG8_SCHED
}
}

struct Params {
    const float* in[24];
    float* out;
    unsigned char* ws;
    int ph_lo, ph_hi, coop, pad;
};

struct WT { __amdgpu_buffer_rsrc_t rs; const unsigned char* base; };
DI WT mk_wt(const void* base, unsigned bytes) { WT w; w.rs = __builtin_amdgcn_make_buffer_rsrc((void*)base, (short)0, (int)bytes, 0x00020000); w.base = (const unsigned char*)base; return w; }
DI void wt16(const WT& w, const void* p, u32x4 v) { __builtin_amdgcn_raw_buffer_store_b128(v, w.rs, (unsigned)((const unsigned char*)p - w.base), 0, 16); }
DI void st_bf16x8(bf16_t* p, f32x4 a, f32x4 b) {
    u32x4 w; w.x = cvtpk(a[0], a[1]); w.y = cvtpk(a[2], a[3]); w.z = cvtpk(b[0], b[1]); w.w = cvtpk(b[2], b[3]);
    *(u32x4*)p = w;
}

struct EpiEvenIn {
    static constexpr bool AFTER_DRAIN = false;
    bf16_t* P; bf16_t* KT; bf16_t* VT; bf16_t* VbT; float* G; float* out;
    DI void operator()(const f32x4 (&acc)[2][2][4][2], const pg8::Unit& u, int wr, int wc, int fr, int fq) const {
#pragma unroll
        for (int bj = 0; bj < 2; ++bj) {
            const int c8 = u.pn * 256 + bj * 128 + wc * 32 + 8 * fq;
            if (c8 >= C_END) continue;
#pragma unroll
            for (int ai = 0; ai < 2; ++ai)
#pragma unroll
                for (int m = 0; m < 4; ++m) {
                    const int row = u.pm * 256 + ai * 128 + wr * 64 + m * 16 + fr;
                    f32x4 v0 = acc[ai][bj][m][0], v1 = acc[ai][bj][m][1];
                    if (c8 >= C_KA && c8 < C_VA) { v0 = v0 * 0.08838834764831845f; v1 = v1 * 0.08838834764831845f; }
                    if (c8 >= C_Z) {
#pragma unroll
                        for (int j = 0; j < 4; ++j) { v0[j] = siluf(v0[j]); v1[j] = siluf(v1[j]); }
                    }
                    if (c8 >= C_G && c8 < C_QB) {
                        *(f32x4*)(G + (size_t)row * 16 + (c8 - C_G)) = v0; *(f32x4*)(G + (size_t)row * 16 + (c8 - C_G) + 4) = v1;
                    } else {
                        st_bf16x8(P + (size_t)row * NP + c8, v0, v1);
                    }
                    bf16_t* T = nullptr; int tc = 0;
                    if (c8 >= C_KA && c8 < C_VA) { T = KT; tc = c8 - C_KA; }
                    else if (c8 >= C_VA && c8 < C_OA) { T = VT; tc = c8 - C_VA; }
                    else if (c8 >= C_VB && c8 < C_Z) { T = VbT; tc = c8 - C_VB; }
                    if (T) {
#pragma unroll
                        for (int j = 0; j < 4; ++j) { T[(size_t)(tc + j) * MROWS + row] = f2bf(v0[j]); T[(size_t)(tc + 4 + j) * MROWS + row] = f2bf(v1[j]); }
                    }
                    if (c8 >= C_VB && c8 < C_Z && row < MP) {
                        const int c = c8 - C_VB, hk = c >> 6, d = c & 63, b = row >> 8, t = row & 255;
                        float* o = out + O_GV + ((size_t)((b * 2 + hk) * 256 + t)) * 64 + d;
                        __builtin_nontemporal_store(v0, (f32x4*)o); __builtin_nontemporal_store(v1, (f32x4*)(o + 4));
                    }
                }
        }
    }
};
struct EpiPlain {
    static constexpr bool AFTER_DRAIN = false;
    bf16_t* O; int ldc;
    DI void operator()(const f32x4 (&acc)[2][2][4][2], const pg8::Unit& u, int wr, int wc, int fr, int fq) const {
#pragma unroll
        for (int bj = 0; bj < 2; ++bj) {
            const int c8 = u.pn * 256 + bj * 128 + wc * 32 + 8 * fq;
#pragma unroll
            for (int ai = 0; ai < 2; ++ai)
#pragma unroll
                for (int m = 0; m < 4; ++m) {
                    const int row = u.pm * 256 + ai * 128 + wr * 64 + m * 16 + fr;
                    st_bf16x8(O + (size_t)row * ldc + c8, acc[ai][bj][m][0], acc[ai][bj][m][1]);
                }
        }
    }
};
struct EpiOddIn {
    static constexpr bool AFTER_DRAIN = false;
    bf16_t* P; bf16_t* VcT; float* out;
    DI void operator()(const f32x4 (&acc)[2][2][4][2], const pg8::Unit& u, int wr, int wc, int fr, int fq) const {
#pragma unroll
        for (int bj = 0; bj < 2; ++bj) {
            const int c8 = u.pn * 256 + bj * 128 + wc * 32 + 8 * fq;
            const int seg = c8 >> 10, c = c8 & 1023;
#pragma unroll
            for (int ai = 0; ai < 2; ++ai)
#pragma unroll
                for (int m = 0; m < 4; ++m) {
                    const int row = u.pm * 256 + ai * 128 + wr * 64 + m * 16 + fr;
                    f32x4 v0 = acc[ai][bj][m][0], v1 = acc[ai][bj][m][1];
                    if ((seg == 1 || seg == 2) && row < MP) {
                        const int h = c >> 6, d = c & 63, b = row >> 8, t = row & 255;
                        float* o = out + (seg == 1 ? O_NK : O_NV) + ((size_t)((b * 16 + h) * 256 + t)) * 64 + d;
                        __builtin_nontemporal_store(v0, (f32x4*)o); __builtin_nontemporal_store(v1, (f32x4*)(o + 4));
                    }
                    if (seg == 2) {
#pragma unroll
                        for (int j = 0; j < 4; ++j) { VcT[(size_t)(c + j) * MROWS + row] = f2bf(v0[j]); VcT[(size_t)(c + 4 + j) * MROWS + row] = f2bf(v1[j]); }
                    } else {
                        if (seg == 0) { v0 = v0 * QSCALE; v1 = v1 * QSCALE; }
                        if (seg == 3) {
#pragma unroll
                            for (int j = 0; j < 4; ++j) { v0[j] = siluf(v0[j]); v1[j] = siluf(v1[j]); }
                        }
                        st_bf16x8(P + (size_t)row * NP + c8, v0, v1);
                    }
                }
        }
    }
};

DI void panel_row_rinv(const f32x4 (&v)[2][2][4][2], const pg8::Unit& u, int wr, int wc, int fr, int fq, LAS float* Pl, LAS float* Sl, int tid, float* slot, unsigned* c) {
#pragma unroll
    for (int ai = 0; ai < 2; ++ai)
#pragma unroll
        for (int m = 0; m < 4; ++m) {
            float sq = 0.f;
#pragma unroll
            for (int bj = 0; bj < 2; ++bj)
#pragma unroll
                for (int n = 0; n < 2; ++n) { const f32x4 x = v[ai][bj][m][n]; sq += (x[0] * x[0] + x[1] * x[1]) + (x[2] * x[2] + x[3] * x[3]); }
            sq += __shfl_xor(sq, 16); sq += __shfl_xor(sq, 32);
            if (fq == 0) Pl[(ai * 128 + wr * 64 + m * 16 + fr) * 4 + wc] = sq;
        }
    __syncthreads();
    if (tid < 256) {
        const float tot = (Pl[tid * 4 + 0] + Pl[tid * 4 + 1]) + (Pl[tid * 4 + 2] + Pl[tid * 4 + 3]);
        __hip_atomic_store(slot + tid * 4 + u.pn, tot, __ATOMIC_RELAXED, __HIP_MEMORY_SCOPE_AGENT);
    }
    asm volatile("s_waitcnt vmcnt(0)" ::: "memory");
    __syncthreads();
    if (tid == 0) {
        __hip_atomic_fetch_add(c, 1u, __ATOMIC_RELAXED, __HIP_MEMORY_SCOPE_AGENT);
        unsigned spins = 0;
        while (__hip_atomic_load(c, __ATOMIC_RELAXED, __HIP_MEMORY_SCOPE_AGENT) < 4u) { __builtin_amdgcn_s_sleep(1); if (++spins > (1u << 22)) break; }
        asm volatile("" ::: "memory");
    }
    __syncthreads();
    if (tid < 256) {
        float t = 0.f;
#pragma unroll
        for (int k = 0; k < 4; ++k) t += __hip_atomic_load(slot + tid * 4 + k, __ATOMIC_RELAXED, __HIP_MEMORY_SCOPE_AGENT);
        Sl[tid] = rsqrtf(t * (1.f / DM) + EPS);
    }
    __syncthreads();
}
struct EpiFinal {
    static constexpr bool AFTER_DRAIN = true;
    const bf16_t* X1P; const bf16_t* X1S; const float* MODl; const float* gpost; float* out; float* xbuf; unsigned* cnt;
    DI void fused(f32x4 (&acc)[2][2][4][2], const pg8::Unit& u, int wr, int wc, int fr, int fq, LAS unsigned char* lds, int wid, int lane) const {
        LAS float* Pl = (LAS float*)lds;
        LAS float* Sl = Pl + 1024;
        const int tid = wid * 64 + lane;
        u32x4 pxr[2][2][4];
#pragma unroll
        for (int bj = 0; bj < 2; ++bj) {
            const int c8 = u.pn * 256 + bj * 128 + wc * 32 + 8 * fq;
#pragma unroll
            for (int ai = 0; ai < 2; ++ai)
#pragma unroll
                for (int m = 0; m < 4; ++m) { const int row = u.pm * 256 + ai * 128 + wr * 64 + m * 16 + fr;
                    pxr[bj][ai][m] = *(const u32x4*)((row < MP ? X1P + (size_t)row * DM : X1S + (size_t)(row - MP) * DM) + c8); }
        }
        panel_row_rinv(acc, u, wr, wc, fr, fq, Pl, Sl, tid, xbuf + (size_t)(u.pm * 256) * 4, cnt + 16 * u.pm);
        const int v = u.pm < 16 ? 0 : 1 + ((u.pm - 16) >> 4);
        const float* gate = MODl + (1 * 3 + v) * 3072 + 2048;
#pragma unroll
        for (int bj = 0; bj < 2; ++bj) {
            const int c8 = u.pn * 256 + bj * 128 + wc * 32 + 8 * fq;
            const f32x4 g0 = *(const f32x4*)(gpost + c8), g1 = *(const f32x4*)(gpost + c8 + 4);
            const f32x4 t0 = *(const f32x4*)(gate + c8), t1 = *(const f32x4*)(gate + c8 + 4);
#pragma unroll
            for (int ai = 0; ai < 2; ++ai)
#pragma unroll
                for (int m = 0; m < 4; ++m) {
                    const int rl = ai * 128 + wr * 64 + m * 16 + fr, row = u.pm * 256 + rl;
                    const float rinv = Sl[rl];
                    const u32x4 xr = pxr[bj][ai][m];
                    const f32x4 y0 = acc[ai][bj][m][0], y1 = acc[ai][bj][m][1];
                    f32x4 o0, o1;
                    o0[0] = __uint_as_float(xr.x << 16) + t0[0] * (y0[0] * rinv * g0[0]); o0[1] = __uint_as_float(xr.x & 0xffff0000u) + t0[1] * (y0[1] * rinv * g0[1]);
                    o0[2] = __uint_as_float(xr.y << 16) + t0[2] * (y0[2] * rinv * g0[2]); o0[3] = __uint_as_float(xr.y & 0xffff0000u) + t0[3] * (y0[3] * rinv * g0[3]);
                    o1[0] = __uint_as_float(xr.z << 16) + t1[0] * (y1[0] * rinv * g1[0]); o1[1] = __uint_as_float(xr.z & 0xffff0000u) + t1[1] * (y1[1] * rinv * g1[1]);
                    o1[2] = __uint_as_float(xr.w << 16) + t1[2] * (y1[2] * rinv * g1[2]); o1[3] = __uint_as_float(xr.w & 0xffff0000u) + t1[3] * (y1[3] * rinv * g1[3]);
                    float* op = out + (size_t)row * DM + c8;
                    __builtin_nontemporal_store(o0, (f32x4*)op); __builtin_nontemporal_store(o1, (f32x4*)(op + 4));
                }
        }
    }
};

struct EpiMid {
    static constexpr bool AFTER_DRAIN = true;
    const float* x_prompt; const float* x_sample; const float* MODl; const float* gpost; const float* gpre1; bf16_t* X1P; bf16_t* X1S; bf16_t* Hn; float* xbuf; unsigned* cnt;
    DI void fused(f32x4 (&acc)[2][2][4][2], const pg8::Unit& u, int wr, int wc, int fr, int fq, LAS unsigned char* lds, int wid, int lane) const {
        LAS float* Pl = (LAS float*)lds; LAS float* Sl = Pl + 1024;
        const int tid = wid * 64 + lane;
        panel_row_rinv(acc, u, wr, wc, fr, fq, Pl, Sl, tid, xbuf + (size_t)(12288 + u.pm * 256) * 4, cnt + 16 * (48 + u.pm));
        const int v = u.pm < 16 ? 0 : 1 + ((u.pm - 16) >> 4);
        const float* md0 = MODl + (0 * 3 + v) * 3072; const float* md1 = MODl + (1 * 3 + v) * 3072;
        const float* xbase = u.pm < 16 ? x_prompt + (size_t)(u.pm * 256) * DM : x_sample + (size_t)(u.pm * 256 - MP) * DM;
#pragma unroll
        for (int bj = 0; bj < 2; ++bj) {
            const int c8 = u.pn * 256 + bj * 128 + wc * 32 + 8 * fq;
            const f32x4 g0 = *(const f32x4*)(gpost + c8), g1 = *(const f32x4*)(gpost + c8 + 4);
            const f32x4 t0 = *(const f32x4*)(md0 + 2048 + c8), t1 = *(const f32x4*)(md0 + 2048 + c8 + 4);
#pragma unroll
            for (int ai = 0; ai < 2; ++ai)
#pragma unroll
                for (int m = 0; m < 4; ++m) {
                    const int rl = ai * 128 + wr * 64 + m * 16 + fr, row = u.pm * 256 + rl;
                    const float rinv = Sl[rl];
                    const f32x4 x0 = *(const f32x4*)(xbase + (size_t)rl * DM + c8), x1 = *(const f32x4*)(xbase + (size_t)rl * DM + c8 + 4);
                    f32x4 y0 = acc[ai][bj][m][0], y1 = acc[ai][bj][m][1];
#pragma unroll
                    for (int e = 0; e < 4; ++e) { y0[e] = x0[e] + t0[e] * (y0[e] * rinv * g0[e]); y1[e] = x1[e] + t1[e] * (y1[e] * rinv * g1[e]); }
                    acc[ai][bj][m][0] = y0; acc[ai][bj][m][1] = y1;
                    u32x4 w; w.x = cvtpk(y0[0], y0[1]); w.y = cvtpk(y0[2], y0[3]); w.z = cvtpk(y1[0], y1[1]); w.w = cvtpk(y1[2], y1[3]);
                    *(u32x4*)((row < MP ? X1P + (size_t)row * DM : X1S + (size_t)(row - MP) * DM) + c8) = w;
                }
        }
        panel_row_rinv(acc, u, wr, wc, fr, fq, Pl, Sl, tid, xbuf + (size_t)(2 * 12288 + u.pm * 256) * 4, cnt + 16 * (96 + u.pm));
#pragma unroll
        for (int bj = 0; bj < 2; ++bj) {
            const int c8 = u.pn * 256 + bj * 128 + wc * 32 + 8 * fq;
            const f32x4 g0 = *(const f32x4*)(gpre1 + c8), g1 = *(const f32x4*)(gpre1 + c8 + 4);
            const f32x4 a0 = *(const f32x4*)(md1 + 1024 + c8), a1 = *(const f32x4*)(md1 + 1024 + c8 + 4);
            const f32x4 b0 = *(const f32x4*)(md1 + c8), b1 = *(const f32x4*)(md1 + c8 + 4);
#pragma unroll
            for (int ai = 0; ai < 2; ++ai)
#pragma unroll
                for (int m = 0; m < 4; ++m) {
                    const int rl = ai * 128 + wr * 64 + m * 16 + fr, row = u.pm * 256 + rl;
                    const float r1 = Sl[rl];
                    const f32x4 y0 = acc[ai][bj][m][0], y1 = acc[ai][bj][m][1];
                    float o[8];
#pragma unroll
                    for (int e = 0; e < 4; ++e) { o[e] = y0[e] * r1 * g0[e] * (1.f + a0[e]) + b0[e]; o[4 + e] = y1[e] * r1 * g1[e] * (1.f + a1[e]) + b1[e]; }
                    u32x4 w; w.x = cvtpk(o[0], o[1]); w.y = cvtpk(o[2], o[3]); w.z = cvtpk(o[4], o[5]); w.w = cvtpk(o[6], o[7]);
                    *(u32x4*)(Hn + (size_t)row * DM + c8) = w;
                }
        }
    }
};

constexpr int AT_PITCH = 144, AT_TILE = 64 * AT_PITCH;
DI void attn_tile_load(int it, int nt0, const bf16_t* K0, int k0s, const bf16_t* V0, int v0s, const bf16_t* K1, int k1s, const bf16_t* V1, int v1s, int tid, u32x4& kr, u32x4& vr) {
    const int row = tid >> 3, pc = tid & 7;
    const bf16_t* K; const bf16_t* V; int ks, vs, tt;
    if (it < nt0) { K = K0; V = V0; ks = k0s; vs = v0s; tt = it; } else { K = K1; V = V1; ks = k1s; vs = v1s; tt = it - nt0; }
    kr = *(const u32x4*)(K + (size_t)(tt * 64 + row) * ks + pc * 8);
    vr = *(const u32x4*)(V + (size_t)row * vs + tt * 64 + pc * 8);
}
DI void attn_tile_store(LAS unsigned char* kb, LAS unsigned char* vb, int tid, const u32x4& kr, const u32x4& vr, bool nat) {
    const int row = tid >> 3, pc = tid & 7;
    *(LAS u32x4*)(kb + row * AT_PITCH + pc * 16) = kr;
    if (nat) { *(LAS u32x4*)(vb + row * AT_PITCH + pc * 16) = vr; return; }
    const int grp = pc >> 1, b3 = pc & 1;
    u32x2 lo = {vr.x, vr.y}, hi = {vr.z, vr.w};
    *(LAS u32x2*)(vb + row * AT_PITCH + (16 * grp + 4 * b3) * 2) = lo;
    *(LAS u32x2*)(vb + row * AT_PITCH + (16 * grp + 8 + 4 * b3) * 2) = hi;
}

DI void attn_qk(const LAS unsigned char* kb, const bf16x8 (&qf)[4], int l32, int half, float nm, f32x16& s0, f32x16& s1) {
    bf16x8 a[8];
#pragma unroll
    for (int s = 0; s < 4; ++s) {
        a[2 * s] = *(const LAS bf16x8*)(kb + l32 * AT_PITCH + s * 32 + half * 16);
        a[2 * s + 1] = *(const LAS bf16x8*)(kb + (32 + l32) * AT_PITCH + s * 32 + half * 16);
    }
    f32x16 nmC;
#pragma unroll
    for (int i = 0; i < 16; ++i) nmC[i] = nm;
    s0 = MFMA32(a[0], qf[0], nmC); s1 = MFMA32(a[1], qf[0], nmC);
#pragma unroll
    for (int s = 1; s < 4; ++s) { s0 = MFMA32(a[2 * s], qf[s], s0); s1 = MFMA32(a[2 * s + 1], qf[s], s1); }
}
DI void attn_bias(f32x16& s0, f32x16& s1, const LAS float* bp, int half, int cs) {
#pragma unroll
    for (int i = 0; i < 16; ++i) {
        const int kc0 = 8 * (i >> 2) + (i & 3);
        const int kca = kc0 + 4 * half, kcb = kca + 32;
        const float b0 = bp[kc0], b1 = bp[kc0 + 32];
        s0[i] = ((unsigned)(kca - cs) < 16u) ? s0[i] + b0 : -1e30f;
        s1[i] = ((unsigned)(kcb - cs) < 16u) ? s1[i] + b1 : -1e30f;
    }
}
DI float attn_max(const f32x16& s0, const f32x16& s1) {
    float mx = fmaxf(s0[0], s1[0]);
#pragma unroll
    for (int i = 1; i < 16; ++i) mx = fmaxf(mx, fmaxf(s0[i], s1[i]));
    return mx;
}
DI void attn_pv(const LAS unsigned char* vb, f32x16& s0, f32x16& s1, int l32, int half, const bf16x8& ones, f32x16& o0, f32x16& o1, f32x16& lacc) {
    bf16x8 v[8];
#pragma unroll
    for (int s = 0; s < 4; ++s) {
        v[2 * s] = *(const LAS bf16x8*)(vb + l32 * AT_PITCH + (16 * s + 8 * half) * 2);
        v[2 * s + 1] = *(const LAS bf16x8*)(vb + (32 + l32) * AT_PITCH + (16 * s + 8 * half) * 2);
    }
#pragma unroll
    for (int i = 0; i < 16; ++i) { s0[i] = __builtin_amdgcn_exp2f(s0[i]); s1[i] = __builtin_amdgcn_exp2f(s1[i]); }
    bf16x8 pf[4];
    pf[0] = pack8(s0[0], s0[1], s0[2], s0[3], s0[4], s0[5], s0[6], s0[7]);
    pf[1] = pack8(s0[8], s0[9], s0[10], s0[11], s0[12], s0[13], s0[14], s0[15]);
    pf[2] = pack8(s1[0], s1[1], s1[2], s1[3], s1[4], s1[5], s1[6], s1[7]);
    pf[3] = pack8(s1[8], s1[9], s1[10], s1[11], s1[12], s1[13], s1[14], s1[15]);
#pragma unroll
    for (int s = 0; s < 4; ++s) {
        o0 = MFMA32(v[2 * s], pf[s], o0); o1 = MFMA32(v[2 * s + 1], pf[s], o1);
        lacc = MFMA32(ones, pf[s], lacc);
    }
}

DI void attn_qk32(const LAS unsigned char* kb, const bf16x8 (&qf)[4], int krow, int half, float nm, f32x16& sv) {
    f32x16 nmC;
#pragma unroll
    for (int i = 0; i < 16; ++i) nmC[i] = nm;
    const LAS unsigned char* p = kb + krow * AT_PITCH + half * 16;
    sv = MFMA32(*(const LAS bf16x8*)p, qf[0], nmC);
#pragma unroll
    for (int s = 1; s < 4; ++s) sv = MFMA32(*(const LAS bf16x8*)(p + s * 32), qf[s], sv);
}
DI void attn_bias32(f32x16& sv, const LAS float* bp, int kcb, bool rowvalid) {
#pragma unroll
    for (int i = 0; i < 16; ++i) {
        const int kc0 = 8 * (i >> 2) + (i & 3);
        const float b0 = bp[kc0];
        sv[i] = (rowvalid && (unsigned)(kcb + kc0) < 16u) ? sv[i] + b0 : -1e30f;
    }
}
DI float attn_max16(const f32x16& sv) {
    float mx = sv[0];
#pragma unroll
    for (int i = 1; i < 16; ++i) mx = fmaxf(mx, sv[i]);
    return mx;
}
DI void attn_pv32(const LAS unsigned char* vb, f32x16& sv, int l32, int half, int k0, const bf16x8& ones, f32x16& o0, f32x16& o1, f32x16& lacc) {
#pragma unroll
    for (int i = 0; i < 16; ++i) sv[i] = __builtin_amdgcn_exp2f(sv[i]);
    const bf16x8 pf0 = pack8(sv[0], sv[1], sv[2], sv[3], sv[4], sv[5], sv[6], sv[7]);
    const bf16x8 pf1 = pack8(sv[8], sv[9], sv[10], sv[11], sv[12], sv[13], sv[14], sv[15]);
#pragma unroll
    for (int s2 = 0; s2 < 2; ++s2) {
        const LAS unsigned char* p0 = vb + l32 * AT_PITCH + (k0 + 16 * s2 + 4 * half) * 2;
        const LAS unsigned char* p1 = p0 + 32 * AT_PITCH;
        const s16x4 lo0 = *(const LAS s16x4*)p0, hi0 = *(const LAS s16x4*)(p0 + 16);
        const s16x4 lo1 = *(const LAS s16x4*)p1, hi1 = *(const LAS s16x4*)(p1 + 16);
        const bf16x8 A0 = __builtin_shufflevector(lo0, hi0, 0, 1, 2, 3, 4, 5, 6, 7);
        const bf16x8 A1 = __builtin_shufflevector(lo1, hi1, 0, 1, 2, 3, 4, 5, 6, 7);
        o0 = MFMA32(A0, s2 == 0 ? pf0 : pf1, o0); o1 = MFMA32(A1, s2 == 0 ? pf0 : pf1, o1);
        lacc = MFMA32(ones, s2 == 0 ? pf0 : pf1, lacc);
    }
}

template <int MODE>
DI void attn_item(LAS unsigned char* lds, int tid,
                  const bf16_t* Q, int qstride,
                  const bf16_t* K0, int k0s, const bf16_t* V0, int v0s, int nt0,
                  const bf16_t* K1, int k1s, const bf16_t* V1, int v1s, int nt1,
                  int r0, int rs_lo, const LAS float* rpbL,
                  const bf16_t* Z, int zstride, bf16_t* O, int ostride, const WT& wt, bool usewt, unsigned* pcnt) {
    const int lane = tid & 63, w = tid >> 6, l32 = lane & 31, half = lane >> 5;
    const int np = (nt0 + nt1 + 1) >> 1;
    const int ng = w & 3, nrp = w >> 2;
    const int qc = (MODE == 1) ? 16 * ng + (l32 & 15) : 0;
    const int qrw = (MODE == 1) ? 2 * nrp + (l32 >> 4) : 0;
    const int qr = r0 + qrw;
    const int qrow = (MODE == 1) ? qrw * 64 + qc : w * 32 + l32;
    const int k0 = (ng == 0) ? 0 : (ng == 1) ? 8 : (ng == 2) ? 24 : 32;
    bf16x8 qf[4];
#pragma unroll
    for (int s = 0; s < 4; ++s) qf[s] = *(const bf16x8*)(Q + (size_t)qrow * qstride + 16 * s + 8 * half);
    f32x16 o0, o1, lacc;
#pragma unroll
    for (int i = 0; i < 16; ++i) { o0[i] = 0.f; o1[i] = 0.f; lacc[i] = 0.f; }
    float m_run = 0.f;
    const bf16x8 ones = {0x3F80, 0x3F80, 0x3F80, 0x3F80, 0x3F80, 0x3F80, 0x3F80, 0x3F80};
    const int cs = min(max(qc - 8, 0), 48);
    const int rsq = min(max(qr - 4, 0), 56);
    const int rsw_lo = min(max(r0 + 2 * nrp - 4, 0), 56), rsw_hi = min(max(r0 + 2 * nrp + 1 - 4, 0), 56) + 8;

    u32x4 eka, eva, ekb, evb;
#define AT_LOAD(pair, ka, va, kb_, vb_) do { attn_tile_load(2 * (pair), nt0, K0, k0s, V0, v0s, K1, k1s, V1, v1s, tid, ka, va); \
        attn_tile_load(2 * (pair) + 1, nt0, K0, k0s, V0, v0s, K1, k1s, V1, v1s, tid, kb_, vb_); } while (0)
#define AT_STORE(stage, pair, ka, va, kb_, vb_) do { LAS unsigned char* nb_ = lds + (stage) * 4 * AT_TILE; const bool nat_ = (MODE == 1) && (2 * (pair) >= nt0); \
        attn_tile_store(nb_, nb_ + AT_TILE, tid, ka, va, nat_); attn_tile_store(nb_ + 2 * AT_TILE, nb_ + 3 * AT_TILE, tid, kb_, vb_, nat_); } while (0)
#define AT_SLOWPATH(ip_, EXTRA) \
            mx = fmaxf(mx, __shfl_xor(mx, 32)); \
            const bool need = ((ip_) == 0) || (mx > 8.f); \
            if (__builtin_amdgcn_ballot_w64(need) != 0ull) { \
                const float delta = need ? mx : 0.f; \
                const float alpha = __builtin_amdgcn_exp2f(-delta); \
                m_run += delta; \
                _Pragma("unroll") for (int i = 0; i < 16; ++i) { EXTRA; o0[i] *= alpha; o1[i] *= alpha; lacc[i] *= alpha; } \
            }
#define AT_COMPUTE(ip_) do { \
        LAS unsigned char* base = lds + ((ip_) & 1) * 4 * AT_TILE; \
        const int ita = 2 * (ip_), itb = 2 * (ip_) + 1; \
        if (MODE == 1 && ita >= nt0) { \
            const int kra_ = rs_lo + (ita - nt0), krb_ = kra_ + 1; \
            const bool acta = (kra_ >= rsw_lo) && (kra_ < rsw_hi), actb = (krb_ >= rsw_lo) && (krb_ < rsw_hi); \
            if (acta || actb) { \
                f32x16 sa, sb; \
                _Pragma("unroll") for (int i = 0; i < 16; ++i) { sa[i] = -1e30f; sb[i] = -1e30f; } \
                float mx = -3.0e38f; \
                if (acta) { attn_qk32(base, qf, k0 + l32, half, -m_run, sa); \
                    attn_bias32(sa, rpbL + 64 + (kra_ - qr + 7) * 31 + (k0 - qc + 15) + 4 * half, k0 + 4 * half - cs, (kra_ >= rsq) && (kra_ < rsq + 8)); mx = attn_max16(sa); } \
                if (actb) { attn_qk32(base + 2 * AT_TILE, qf, k0 + l32, half, -m_run, sb); \
                    attn_bias32(sb, rpbL + 64 + (krb_ - qr + 7) * 31 + (k0 - qc + 15) + 4 * half, k0 + 4 * half - cs, (krb_ >= rsq) && (krb_ < rsq + 8)); mx = fmaxf(mx, attn_max16(sb)); } \
                AT_SLOWPATH(ip_, sa[i] -= delta; sb[i] -= delta) \
                if (acta) attn_pv32(base + AT_TILE, sa, l32, half, k0, ones, o0, o1, lacc); \
                if (actb) attn_pv32(base + 3 * AT_TILE, sb, l32, half, k0, ones, o0, o1, lacc); \
            } \
        } else { \
            f32x16 sa0, sa1, sb0, sb1; \
            attn_qk(base, qf, l32, half, -m_run, sa0, sa1); \
            attn_qk(base + 2 * AT_TILE, qf, l32, half, -m_run, sb0, sb1); \
            float mx = fmaxf(attn_max(sa0, sa1), attn_max(sb0, sb1)); \
            AT_SLOWPATH(ip_, sa0[i] -= delta; sa1[i] -= delta; sb0[i] -= delta; sb1[i] -= delta) \
            attn_pv(base + AT_TILE, sa0, sa1, l32, half, ones, o0, o1, lacc); \
            attn_pv(base + 3 * AT_TILE, sb0, sb1, l32, half, ones, o0, o1, lacc); \
        } } while (0)
    AT_LOAD(0, eka, eva, ekb, evb);
    AT_STORE(0, 0, eka, eva, ekb, evb);
    __syncthreads();
    for (int ip = 0; ip < np; ++ip) {
        if (ip + 1 < np) AT_LOAD(ip + 1, eka, eva, ekb, evb);
        AT_COMPUTE(ip);
        if (ip + 1 < np) AT_STORE((ip + 1) & 1, ip + 1, eka, eva, ekb, evb);
        __syncthreads();
    }
#undef AT_LOAD
#undef AT_STORE
#undef AT_COMPUTE
#undef AT_SLOWPATH
    const float inv = 1.f / lacc[0];
    {
        LAS float* ot = (LAS float*)lds;
#pragma unroll
        for (int dt = 0; dt < 2; ++dt)
#pragma unroll
            for (int i = 0; i < 16; ++i) ot[qrow * 65 + dt * 32 + crow(i, half)] = (dt == 0 ? o0[i] : o1[i]) * inv;
        __syncthreads();
#pragma unroll
        for (int j = 0; j < 4; ++j) {
            const int idx = tid + 512 * j, row = idx >> 3, pc = idx & 7;
            const u32x4 zz = *(const u32x4*)(Z + (size_t)row * zstride + pc * 8);
            const LAS float* sp = ot + row * 65 + pc * 8;
            u32x4 ov;
            ov.x = cvtpk(sp[0] * __uint_as_float(zz.x << 16), sp[1] * __uint_as_float(zz.x & 0xffff0000u));
            ov.y = cvtpk(sp[2] * __uint_as_float(zz.y << 16), sp[3] * __uint_as_float(zz.y & 0xffff0000u));
            ov.z = cvtpk(sp[4] * __uint_as_float(zz.z << 16), sp[5] * __uint_as_float(zz.z & 0xffff0000u));
            ov.w = cvtpk(sp[6] * __uint_as_float(zz.w << 16), sp[7] * __uint_as_float(zz.w & 0xffff0000u));
            if (usewt) wt16(wt, O + (size_t)row * ostride + pc * 8, ov); else *(u32x4*)(O + (size_t)row * ostride + pc * 8) = ov;
        }
        if (pcnt) asm volatile("s_waitcnt vmcnt(0)" ::: "memory");
        __syncthreads();
        if (pcnt && tid == 0) __hip_atomic_fetch_add(pcnt, 1u, __ATOMIC_RELAXED, __HIP_MEMORY_SCOPE_AGENT);
    }
}

DI int chain_base(int sid, int h, int dir) { return sid < 16 ? ((sid * 4 + h) * 2 + dir) * 2 : 256 + (((sid - 16) * 4 + h) * 2 + dir) * 32; }
DI int seq_rowbase(int sid) { return sid < 16 ? sid * 256 : MP + (sid - 16) * 4096; }
DI float chain_m0(const float* state_m, int sid, int h, int dir) { return sid < 16 ? 0.f : state_m[((sid - 16) * 2 + dir) * 4 + h]; }
DI float chain_m_at(const float* CH, int base, int js, float m0) {
    float m = m0;
    for (int i = 0; i < js; ++i) { const float bL = CH[(base + i) * 2], rmL = CH[(base + i) * 2 + 1]; m = bL + fmaxf(m, rmL); }
    return m;
}

DI void gate_scan_item(int sid, int h, int dir, int js, int lane, const float* G, const float* bg, float* SC, float* CH) {
    const int nc = sid < 16 ? 2 : 32, T = nc * 128, rb = seq_rowbase(sid);
    const float bi = bg[(dir * 2) * 4 + h], bff = bg[(dir * 2 + 1) * 4 + h];
    float ig[2], lf[2]; int row[2];
#pragma unroll
    for (int e = 0; e < 2; ++e) {
        const int Ppos = js * 128 + 2 * lane + e; const int t = dir ? (T - 1 - Ppos) : Ppos; row[e] = rb + t;
        ig[e] = G[(size_t)row[e] * 16 + (dir * 2) * 4 + h] + bi;
        const float fg = G[(size_t)row[e] * 16 + (dir * 2 + 1) * 4 + h] + bff;
        lf[e] = fminf(fg, 0.f) - log1pf(expf(-fabsf(fg)));
    }
    const float tot = lf[0] + lf[1];
    float x = tot;
#pragma unroll
    for (int o = 1; o < 64; o <<= 1) { const float y = __shfl_up(x, o); if (lane >= o) x += y; }
    const float excl = x - tot;
    const float b0 = excl + lf[0], b1 = excl + tot;
    const float a0 = ig[0] - b0, a1 = ig[1] - b1;
    const float lm = fmaxf(a0, a1);
    float xm = lm;
#pragma unroll
    for (int o = 1; o < 64; o <<= 1) { const float y = __shfl_up(xm, o); if (lane >= o) xm = fmaxf(xm, y); }
    float em = __shfl_up(xm, 1); if (lane == 0) em = -3.0e38f;
    const float rm0 = fmaxf(em, a0), rm1 = fmaxf(em, lm);
    *(f32x4*)(SC + ((size_t)row[0] * 8 + h * 2 + dir) * 4) = (f32x4){a0, b0, rm0, 0.f};
    *(f32x4*)(SC + ((size_t)row[1] * 8 + h * 2 + dir) * 4) = (f32x4){a1, b1, rm1, 0.f};
    if (lane == 63) { const int slot = chain_base(sid, h, dir) + js; CH[slot * 2] = b1; CH[slot * 2 + 1] = rm1; }
}

DI void qknorm_item(int row, int lane, const u32x4 (&rawqk)[2], const float* gq, const float* gk, bf16_t* Qb, bf16_t* Kb, float* out) {
    const bool sample = row >= MP;
    const int t = sample ? ((row - MP) & 4095) : 0;
    const int grow = t >> 6, gcol = t & 63;
    const int sub = lane & 7, d0 = sub * 8;
    const float pos = (float)((sub < 4) ? grow : gcol);
#pragma unroll
    for (int pass = 0; pass < 2; ++pass) {
        const u32x4 raw = rawqk[pass];
        float x[8];
        x[0] = __uint_as_float(raw.x << 16); x[1] = __uint_as_float(raw.x & 0xffff0000u);
        x[2] = __uint_as_float(raw.y << 16); x[3] = __uint_as_float(raw.y & 0xffff0000u);
        x[4] = __uint_as_float(raw.z << 16); x[5] = __uint_as_float(raw.z & 0xffff0000u);
        x[6] = __uint_as_float(raw.w << 16); x[7] = __uint_as_float(raw.w & 0xffff0000u);
        float ss = 0.f;
#pragma unroll
        for (int e = 0; e < 8; ++e) ss += x[e] * x[e];
        ss += __shfl_xor(ss, 1); ss += __shfl_xor(ss, 2); ss += __shfl_xor(ss, 4);
        const float r = rsqrtf(ss * (1.f / 64.f) + EPS);
        const float* gw = pass == 0 ? gq : gk;
        float y[8];
#pragma unroll
        for (int e = 0; e < 8; ++e) y[e] = x[e] * r * gw[d0 + e];
        if (pass == 1 && !sample && lane < 16) {
            const int hk = lane >> 3, b = row >> 8, tt = row & 255;
            float* o = out + O_GK + ((size_t)((b * 2 + hk) * 256 + tt)) * 64 + d0;
            *(f32x4*)o = (f32x4){y[0], y[1], y[2], y[3]}; *(f32x4*)(o + 4) = (f32x4){y[4], y[5], y[6], y[7]};
        }
        float z[8];
#pragma unroll
        for (int e = 0; e < 8; ++e) {
            const float partner = __shfl_xor(y[e], 2);
            if (sample) {
                const int i = (d0 + e) & 15;
                const float freq = __builtin_amdgcn_exp2f(-(float)i * (13.287712379549449f / 16.f));
                float rev = pos * freq * 0.15915494309189535f; rev -= floorf(rev);
                const float sn = __builtin_amdgcn_sinf(rev), cn = __builtin_amdgcn_cosf(rev);
                z[e] = (sub & 2) ? (partner * sn + y[e] * cn) : (y[e] * cn - partner * sn);
            } else z[e] = y[e];
        }
        if (pass == 0) {
#pragma unroll
            for (int e = 0; e < 8; ++e) z[e] *= QSCALE;
            u32x4 w; w.x = cvtpk(z[0], z[1]); w.y = cvtpk(z[2], z[3]); w.z = cvtpk(z[4], z[5]); w.w = cvtpk(z[6], z[7]);
            *(u32x4*)(Qb + (size_t)row * 512 + lane * 8) = w;
        } else if (lane < 16) {
            u32x4 w; w.x = cvtpk(z[0], z[1]); w.y = cvtpk(z[2], z[3]); w.z = cvtpk(z[4], z[5]); w.w = cvtpk(z[6], z[7]);
            *(u32x4*)(Kb + (size_t)row * 128 + lane * 8) = w;
        }
    }
}

DI void mlstm_u_item(LAS unsigned char* lds, int tid, int sid, int h, int dir, int js,
                     const float* SC, const float* CH, const float* state_m, const bf16_t* KT, const bf16_t* VT, bf16_t* U, float* Un, const WT& wtw, unsigned* ucnt) {
    const int lane = tid & 63, w = tid >> 6, l32 = lane & 31, half = lane >> 5;
    const int nc = sid < 16 ? 2 : 32, rb = seq_rowbase(sid);
    const int jt = dir ? nc - 1 - js : js, R0 = rb + jt * 128;
    const int base = chain_base(sid, h, dir), slot = base + js;
    const float Mx = CH[slot * 2 + 1];
    LAS float* wkL = (LAS float*)lds;
    if (tid < 128) wkL[tid] = expf(SC[((size_t)(R0 + tid) * 8 + h * 2 + dir) * 4] - Mx);
    const int vi = w & 3, kh = w >> 2;
    f32x16 acc0, acc1;
#pragma unroll
    for (int i = 0; i < 16; ++i) { acc0[i] = 0.f; acc1[i] = 0.f; }
    LAS unsigned char* VtL = lds + 1024; LAS unsigned char* KtL = lds + 1024 + 34816;
    {
        u32x4 rv[8];
        const int r0 = tid >> 4, pc = tid & 15;
        const bf16_t* gv = VT + (size_t)(h * 128 + r0) * MROWS + R0 + pc * 8;
        const bf16_t* gk = KT + (size_t)(h * 128 + r0) * MROWS + R0 + pc * 8;
#pragma unroll
        for (int i = 0; i < 8; ++i) rv[i] = *(const u32x4*)((i >> 2 ? gk : gv) + (size_t)(32 * (i & 3)) * MROWS);
        LAS unsigned char* lv = VtL + r0 * 272 + pc * 16;
#pragma unroll
        for (int i = 0; i < 8; ++i) *(LAS u32x4*)(lv + (i >> 2) * 34816 + (32 * (i & 3)) * 272) = rv[i];
    }
    __syncthreads();
#pragma unroll
    for (int s = 0; s < 8; ++s) {
        const int so = 16 * s + 8 * half;
        const u32x4 raw = *(const LAS u32x4*)(VtL + (vi * 32 + l32) * 272 + so * 2);
        const bf16x8 B0 = *(const LAS bf16x8*)(KtL + (kh * 64 + l32) * 272 + so * 2);
        const bf16x8 B1 = *(const LAS bf16x8*)(KtL + (kh * 64 + 32 + l32) * 272 + so * 2);
        const f32x4 wa = *(const LAS f32x4*)(wkL + so), wb = *(const LAS f32x4*)(wkL + so + 4);
        const bf16x8 A = pack8(__uint_as_float(raw.x << 16) * wa[0], __uint_as_float(raw.x & 0xffff0000u) * wa[1], __uint_as_float(raw.y << 16) * wa[2], __uint_as_float(raw.y & 0xffff0000u) * wa[3],
                               __uint_as_float(raw.z << 16) * wb[0], __uint_as_float(raw.z & 0xffff0000u) * wb[1], __uint_as_float(raw.w << 16) * wb[2], __uint_as_float(raw.w & 0xffff0000u) * wb[3]);
        acc0 = MFMA32(A, B0, acc0); acc1 = MFMA32(A, B1, acc1);
    }
    bf16_t* Uo = U + (size_t)slot * 16384;
    {
        LAS unsigned char* st = lds + 1024 + 2 * 34816 + w * 4608;
#pragma unroll
        for (int i = 0; i < 16; ++i) {
            const int v = crow(i, half);
            *(LAS bf16_t*)(st + v * 144 + l32 * 2) = f2bf(acc0[i]);
            *(LAS bf16_t*)(st + v * 144 + (32 + l32) * 2) = f2bf(acc1[i]);
        }
        asm volatile("s_waitcnt lgkmcnt(0)" ::: "memory");
#pragma unroll
        for (int j = 0; j < 4; ++j) {
            const int pidx = lane + 64 * j, row = pidx >> 3, pc = pidx & 7;
            const u32x4 val = *(const LAS u32x4*)(st + row * 144 + pc * 16);
            wt16(wtw, Uo + (vi * 32 + row) * 128 + kh * 64 + pc * 8, val);
        }
    }
    if (tid < 128) {
        float s = 0.f;
#pragma unroll
        for (int j = 0; j < 16; ++j) {
            const u32x4 raw = *(const LAS u32x4*)(KtL + tid * 272 + j * 16);
            s += __uint_as_float(raw.x << 16) * wkL[8 * j] + __uint_as_float(raw.x & 0xffff0000u) * wkL[8 * j + 1]
               + __uint_as_float(raw.y << 16) * wkL[8 * j + 2] + __uint_as_float(raw.y & 0xffff0000u) * wkL[8 * j + 3]
               + __uint_as_float(raw.z << 16) * wkL[8 * j + 4] + __uint_as_float(raw.z & 0xffff0000u) * wkL[8 * j + 5]
               + __uint_as_float(raw.w << 16) * wkL[8 * j + 6] + __uint_as_float(raw.w & 0xffff0000u) * wkL[8 * j + 7];
        }
        __hip_atomic_store(Un + slot * 128 + tid, s, __ATOMIC_RELAXED, __HIP_MEMORY_SCOPE_AGENT);
    }
    asm volatile("s_waitcnt vmcnt(0)" ::: "memory");
    __syncthreads();
    if (tid == 0 && ucnt) __hip_atomic_fetch_add(ucnt + 16 * (sid < 16 ? (sid * 4 + h) * 2 + dir : 128 + ((sid - 16) * 4 + h) * 2 + dir), 1u, __ATOMIC_RELAXED, __HIP_MEMORY_SCOPE_AGENT);
}

constexpr int ML_PITCH = 272, ML_ARR = 128 * ML_PITCH;
constexpr int ML_SCAL = 4 * ML_ARR;
DI void mlstm_out_item(LAS unsigned char* lds, int tid, int sid, int h, int jt,
                       const float* SC, const float* MJp, const float* nst, const bf16_t* Cst,
                       const bf16_t* P, const bf16_t* VT, const float* ghn, bf16_t* Yg, const WT& wtd, bool usewt, unsigned* pcnt) {
    const int lane = tid & 63, w = tid >> 6, l32 = lane & 31, half = lane >> 5;
    const int wt = w & 3, vh = w >> 2;
    const int nc = sid < 16 ? 2 : 32, rb = seq_rowbase(sid), R0 = rb + jt * 128;
    LAS unsigned char* KL = lds; LAS unsigned char* VL = lds + ML_ARR; LAS unsigned char* CL = lds + 2 * ML_ARR;
    LAS float* aL = (LAS float*)(lds + ML_SCAL);
    LAS float* nL = aL + 256;
    LAS float* ssqL = nL + 256;
    const int tl = wt * 32 + l32;
    const int qrow = R0 + tl;
    const int slot0 = chain_base(sid, h, 0) + jt, slot1 = chain_base(sid, h, 1) + (nc - 1 - jt);
    bf16x8 qf[8];
#pragma unroll
    for (int s = 0; s < 8; ++s) qf[s] = *(const bf16x8*)(P + (size_t)qrow * NP + C_QA + h * 128 + 16 * s + 8 * half);
    {
        u32x4 rk[4], rv[4], rc0[4], rc1[4];
#pragma unroll
        for (int i = 0; i < 4; ++i) {
            const int idx = tid + 512 * i, row = idx >> 4, pc = idx & 15;
            rk[i] = *(const u32x4*)(P + (size_t)(R0 + row) * NP + C_KA + h * 128 + pc * 8);
            rv[i] = *(const u32x4*)(VT + (size_t)(h * 128 + row) * MROWS + R0 + pc * 8);
            rc0[i] = *(const u32x4*)(Cst + (size_t)slot0 * 16384 + row * 128 + pc * 8);
            rc1[i] = *(const u32x4*)(Cst + (size_t)slot1 * 16384 + row * 128 + pc * 8);
        }
        float av = 0.f, nv = 0.f;
        if (tid < 256) {
            const int dir = tid >> 7, s2 = tid & 127;
            av = SC[((size_t)(R0 + s2) * 8 + h * 2 + dir) * 4];
            nv = nst[(size_t)(dir ? slot1 : slot0) * 128 + s2];
        }
#pragma unroll
        for (int i = 0; i < 4; ++i) {
            const int idx = tid + 512 * i, row = idx >> 4, pc = idx & 15;
            *(LAS u32x4*)(KL + row * ML_PITCH + pc * 16) = rk[i];
            *(LAS u32x4*)(CL + row * ML_PITCH + pc * 16) = rc0[i];
            *(LAS u32x4*)(CL + ML_ARR + row * ML_PITCH + pc * 16) = rc1[i];
            const int grp = pc >> 1, b3 = pc & 1;
            u32x2 lo = {rv[i].x, rv[i].y}, hi = {rv[i].z, rv[i].w};
            *(LAS u32x2*)(VL + row * ML_PITCH + (16 * grp + 4 * b3) * 2) = lo;
            *(LAS u32x2*)(VL + row * ML_PITCH + (16 * grp + 8 + 4 * b3) * 2) = hi;
        }
        if (tid < 256) { aL[tid] = av; nL[tid] = nv; }
    }
    __syncthreads();
    f32x16 hs0, hs1;
#pragma unroll
    for (int i = 0; i < 16; ++i) { hs0[i] = 0.f; hs1[i] = 0.f; }
#pragma unroll 1
    for (int dir = 0; dir < 2; ++dir) {
        const int js = dir ? nc - 1 - jt : jt;
        const float m = MJp[chain_base(sid, h, dir) + js];
        const f32x4 sc = *(const f32x4*)(SC + ((size_t)qrow * 8 + h * 2 + dir) * 4);
        const float mx = fmaxf(m, sc[2]);
        const float u_t = -mx, w_inter = expf(m - mx), flo = expf(-(sc[1] + mx));
        f32x16 a0, a1;
#pragma unroll
        for (int i = 0; i < 16; ++i) { a0[i] = 0.f; a1[i] = 0.f; }
        const LAS unsigned char* Cp = CL + dir * ML_ARR + (vh * 64 + l32) * ML_PITCH + 16 * half;
#pragma unroll
        for (int s = 0; s < 8; ++s) {
            const bf16x8 A0 = *(const LAS bf16x8*)(Cp + 32 * s);
            const bf16x8 A1 = *(const LAS bf16x8*)(Cp + 32 * ML_PITCH + 32 * s);
            a0 = MFMA32(A0, qf[s], a0); a1 = MFMA32(A1, qf[s], a1);
        }
#pragma unroll
        for (int i = 0; i < 16; ++i) { a0[i] *= w_inter; a1[i] *= w_inter; }
        float dq = 0.f;
#pragma unroll
        for (int s = 0; s < 8; ++s)
#pragma unroll
            for (int e = 0; e < 8; ++e) dq += bf2f((unsigned short)qf[s][e]) * nL[dir * 128 + 16 * s + 8 * half + e];
        dq += __shfl_xor(dq, 32);
        float rsum = 0.f;
        const int st_lo = dir ? wt : 0, st_hi = dir ? 3 : wt;
        for (int st = st_lo; st <= st_hi; ++st) {
            f32x16 S;
#pragma unroll
            for (int i = 0; i < 16; ++i) S[i] = 0.f;
            const LAS unsigned char* Kp = KL + (st * 32 + l32) * ML_PITCH + 16 * half;
#pragma unroll
            for (int s = 0; s < 8; ++s) { const bf16x8 A = *(const LAS bf16x8*)(Kp + 32 * s); S = MFMA32(A, qf[s], S); }
#pragma unroll
            for (int i = 0; i < 16; ++i) {
                const int sl = st * 32 + crow(i, half);
                const bool valid = dir ? (sl >= tl) : (sl <= tl);
                const float dcy = __expf(u_t + aL[dir * 128 + sl]);
                const float p = valid ? S[i] * dcy : 0.f;
                S[i] = p; rsum += p;
            }
            const bf16x8 pf0 = pack8(S[0], S[1], S[2], S[3], S[4], S[5], S[6], S[7]);
            const bf16x8 pf1 = pack8(S[8], S[9], S[10], S[11], S[12], S[13], S[14], S[15]);
            const LAS unsigned char* Vp = VL + (vh * 64 + l32) * ML_PITCH + (st * 32 + 8 * half) * 2;
            {
                const bf16x8 A0 = *(const LAS bf16x8*)(Vp), A1 = *(const LAS bf16x8*)(Vp + 32 * ML_PITCH);
                a0 = MFMA32(A0, pf0, a0); a1 = MFMA32(A1, pf0, a1);
                const bf16x8 B0 = *(const LAS bf16x8*)(Vp + 32), B1 = *(const LAS bf16x8*)(Vp + 32 * ML_PITCH + 32);
                a0 = MFMA32(B0, pf1, a0); a1 = MFMA32(B1, pf1, a1);
            }
        }
        rsum += __shfl_xor(rsum, 32);
        const float den = w_inter * dq + rsum;
        const float inv = 1.f / fmaxf(fabsf(den), flo);
#pragma unroll
        for (int i = 0; i < 16; ++i) { hs0[i] += a0[i] * inv; hs1[i] += a1[i] * inv; }
    }
    float ssq = 0.f;
#pragma unroll
    for (int i = 0; i < 16; ++i) ssq += hs0[i] * hs0[i] + hs1[i] * hs1[i];
    ssq += __shfl_xor(ssq, 32);
    if (half == 0) ssqL[w * 32 + l32] = ssq;
    __syncthreads();
    const float tot = ssq + ssqL[(w ^ 4) * 32 + l32];
    const float rn = rsqrtf(tot * (1.f / 128.f) + EPS);
    {
        LAS float* ht = (LAS float*)lds;
#pragma unroll
        for (int vt = 0; vt < 2; ++vt)
#pragma unroll
            for (int i = 0; i < 16; ++i) ht[tl * 129 + vh * 64 + vt * 32 + crow(i, half)] = (vt == 0 ? hs0[i] : hs1[i]) * rn;
        __syncthreads();
#pragma unroll
        for (int j = 0; j < 4; ++j) {
            const int idx = tid + 512 * j, row = idx >> 4, pc = idx & 15, col = h * 128 + pc * 8;
            const bf16_t* prow = P + (size_t)(R0 + row) * NP;
            const u32x4 oa = *(const u32x4*)(prow + C_OA + col), zz = *(const u32x4*)(prow + C_Z + col);
            const f32x4 g0 = *(const f32x4*)(ghn + col), g1 = *(const f32x4*)(ghn + col + 4);
            const LAS float* sp = ht + row * 129 + pc * 8;
            u32x4 ov;
            ov.x = cvtpk(sp[0] * g0[0] * sigmf(__uint_as_float(oa.x << 16)) * __uint_as_float(zz.x << 16), sp[1] * g0[1] * sigmf(__uint_as_float(oa.x & 0xffff0000u)) * __uint_as_float(zz.x & 0xffff0000u));
            ov.y = cvtpk(sp[2] * g0[2] * sigmf(__uint_as_float(oa.y << 16)) * __uint_as_float(zz.y << 16), sp[3] * g0[3] * sigmf(__uint_as_float(oa.y & 0xffff0000u)) * __uint_as_float(zz.y & 0xffff0000u));
            ov.z = cvtpk(sp[4] * g1[0] * sigmf(__uint_as_float(oa.z << 16)) * __uint_as_float(zz.z << 16), sp[5] * g1[1] * sigmf(__uint_as_float(oa.z & 0xffff0000u)) * __uint_as_float(zz.z & 0xffff0000u));
            ov.w = cvtpk(sp[6] * g1[2] * sigmf(__uint_as_float(oa.w << 16)) * __uint_as_float(zz.w << 16), sp[7] * g1[3] * sigmf(__uint_as_float(oa.w & 0xffff0000u)) * __uint_as_float(zz.w & 0xffff0000u));
            if (usewt) wt16(wtd, Yg + (size_t)(R0 + row) * DM + col, ov); else *(u32x4*)(Yg + (size_t)(R0 + row) * DM + col) = ov;
        }
    }
    if (pcnt) asm volatile("s_waitcnt vmcnt(0)" ::: "memory");
    __syncthreads();
    if (pcnt && tid == 0) __hip_atomic_fetch_add(pcnt + 16 * (R0 >> 8), 1u, __ATOMIC_RELAXED, __HIP_MEMORY_SCOPE_AGENT);
}

DI void transpose_item(const float* W, int K, int N, bf16_t* WT, LAS float* scr, int item, int lane) {
    const int nblk = (N + 31) / 32, kb = item / nblk, nb = item % nblk, k0 = 64 * kb, n0 = 32 * nb;
    const int nn = n0 + (lane & 31);
    float tv[32];
#pragma unroll
    for (int i = 0; i < 32; ++i) { const int kk = 2 * i + (lane >> 5); tv[i] = (nn < N) ? __builtin_nontemporal_load(W + (size_t)(k0 + kk) * N + nn) : 0.f; }
#pragma unroll
    for (int i = 0; i < 32; ++i) { const int kk = 2 * i + (lane >> 5); scr[kk * 33 + (lane & 31)] = tv[i]; }
    asm volatile("s_waitcnt lgkmcnt(0)" ::: "memory");
    const int c = lane & 7;
#pragma unroll
    for (int j = 0; j < 4; ++j) { const int n = (lane >> 3) + 8 * j; const LAS float* s = scr + (8 * c) * 33 + n;
        u32x4 o; o.x = cvtpk(s[0 * 33], s[1 * 33]); o.y = cvtpk(s[2 * 33], s[3 * 33]); o.z = cvtpk(s[4 * 33], s[5 * 33]); o.w = cvtpk(s[6 * 33], s[7 * 33]);
        *(u32x4*)(WT + (size_t)(n0 + n) * K + k0 + 8 * c) = o; }
    asm volatile("s_waitcnt lgkmcnt(0)" ::: "memory");
}

template <int NR>
DI void prenorm_rows(const float* const (&xrow)[NR], const float* gpre, const float* const (&md)[NR], bf16_t* const (&orow)[NR], int lane) {
    f32x4 v[NR][4];
#pragma unroll
    for (int r = 0; r < NR; ++r)
#pragma unroll
        for (int j = 0; j < 4; ++j) v[r][j] = *(const f32x4*)(xrow[r] + 4 * lane + 256 * j);
#pragma unroll
    for (int r = 0; r < NR; ++r) {
        float s = 0.f;
#pragma unroll
        for (int j = 0; j < 4; ++j) s += (v[r][j].x * v[r][j].x + v[r][j].y * v[r][j].y) + (v[r][j].z * v[r][j].z + v[r][j].w * v[r][j].w);
        const float rr = rsqrtf(wave_sum(s) * (1.f / DM) + EPS);
#pragma unroll
        for (int j = 0; j < 4; ++j) {
            const int c = 4 * lane + 256 * j;
            const f32x4 g = *(const f32x4*)(gpre + c), a = *(const f32x4*)(md[r] + 1024 + c), b = *(const f32x4*)(md[r] + c);
            f32x4 o;
#pragma unroll
            for (int e = 0; e < 4; ++e) o[e] = v[r][j][e] * rr * g[e] * (1.f + a[e]) + b[e];
            u32x2 w; w.x = cvtpk(o[0], o[1]); w.y = cvtpk(o[2], o[3]);
            *(u32x2*)(orow[r] + c) = w;
        }
    }
}
template <bool NEXT, int NR, bool XBF, bool X1BF>
DI void postnorm_rows(const float* const (&xrow)[NR], const bf16_t* const (&yrow)[NR], const float* gpost, const float* const (&md0)[NR], float* const (&x1row)[NR],
                      const float* gpre, const float* const (&md1)[NR], bf16_t* const (&hrow)[NR], int lane) {
    f32x4 y[NR][4], x[NR][4];
#pragma unroll
    for (int r = 0; r < NR; ++r)
#pragma unroll
        for (int j = 0; j < 4; ++j) {
            const u32x2 raw = *(const u32x2*)(yrow[r] + 4 * lane + 256 * j);
            y[r][j] = (f32x4){__uint_as_float(raw.x << 16), __uint_as_float(raw.x & 0xffff0000u), __uint_as_float(raw.y << 16), __uint_as_float(raw.y & 0xffff0000u)};
            if (XBF) {
                const u32x2 rx = *(const u32x2*)((const bf16_t*)xrow[r] + 4 * lane + 256 * j);
                x[r][j] = (f32x4){__uint_as_float(rx.x << 16), __uint_as_float(rx.x & 0xffff0000u), __uint_as_float(rx.y << 16), __uint_as_float(rx.y & 0xffff0000u)};
            } else x[r][j] = *(const f32x4*)(xrow[r] + 4 * lane + 256 * j);
        }
#pragma unroll
    for (int r = 0; r < NR; ++r) {
        float s = 0.f;
#pragma unroll
        for (int j = 0; j < 4; ++j) s += (y[r][j].x * y[r][j].x + y[r][j].y * y[r][j].y) + (y[r][j].z * y[r][j].z + y[r][j].w * y[r][j].w);
        const float rr = rsqrtf(wave_sum(s) * (1.f / DM) + EPS);
        float s1 = 0.f;
#pragma unroll
        for (int j = 0; j < 4; ++j) {
            const int c = 4 * lane + 256 * j;
            const f32x4 g = *(const f32x4*)(gpost + c), gt = *(const f32x4*)(md0[r] + 2048 + c);
#pragma unroll
            for (int e = 0; e < 4; ++e) x[r][j][e] = x[r][j][e] + gt[e] * (y[r][j][e] * rr * g[e]);
            if (X1BF) { u32x2 wx; wx.x = cvtpk(x[r][j][0], x[r][j][1]); wx.y = cvtpk(x[r][j][2], x[r][j][3]); *(u32x2*)((bf16_t*)x1row[r] + c) = wx; }
            else *(f32x4*)(x1row[r] + c) = x[r][j];
            s1 += (x[r][j].x * x[r][j].x + x[r][j].y * x[r][j].y) + (x[r][j].z * x[r][j].z + x[r][j].w * x[r][j].w);
        }
        if (NEXT) {
            const float r1 = rsqrtf(wave_sum(s1) * (1.f / DM) + EPS);
#pragma unroll
            for (int j = 0; j < 4; ++j) {
                const int c = 4 * lane + 256 * j;
                const f32x4 g = *(const f32x4*)(gpre + c), a = *(const f32x4*)(md1[r] + 1024 + c), b = *(const f32x4*)(md1[r] + c);
                f32x4 o;
#pragma unroll
                for (int e = 0; e < 4; ++e) o[e] = x[r][j][e] * r1 * g[e] * (1.f + a[e]) + b[e];
                u32x2 w; w.x = cvtpk(o[0], o[1]); w.y = cvtpk(o[2], o[3]);
                *(u32x2*)(hrow[r] + c) = w;
            }
        }
    }
}

#define XB_TMO      128
#define XB_XCNT(j)  (256  + 64 * (j))
#define XB_XSUB(j)  (1280 + 64 * (j))
#define XB_XGEN(j)  (2304 + 64 * (j))
#define XB_TOP      3328
#define XB_TOPGEN   3392
#define XCD_BAR_WORDS 3456
#define XB_SPIN_CAP (1u << 18)
DI unsigned xb_ld(unsigned* p)              { return __hip_atomic_load(p, __ATOMIC_RELAXED, __HIP_MEMORY_SCOPE_AGENT); }
DI unsigned xb_add(unsigned* p, unsigned v) { return __hip_atomic_fetch_add(p, v, __ATOMIC_RELAXED, __HIP_MEMORY_SCOPE_AGENT); }
DI unsigned xb_xcc_id() { return (unsigned)__builtin_amdgcn_s_getreg((3 << 11) | 20) & 0xFu; }
#define XB_SPIN(cond, bar) do { unsigned _sp = 0; while (cond) { __builtin_amdgcn_s_sleep(1); \
    if ((++_sp & 255u) == 0u) { if (xb_ld(&(bar)[XB_TMO])) break; if (_sp > XB_SPIN_CAP) { atomicAdd(&(bar)[XB_TMO], 1u); break; } } } } while (0)
struct XcdBarrier { unsigned* bar; unsigned x; volatile LAS unsigned* st; };
DI XcdBarrier xcd_barrier_post(unsigned* bar, volatile LAS unsigned* st) {
    XcdBarrier b; b.bar = bar; b.x = xb_xcc_id(); b.st = st;
    if (threadIdx.x == 0) (void)xb_add(&bar[XB_XCNT(b.x)], 1u);
    return b;
}
DI void xcd_barrier_complete(unsigned* bar, unsigned x, unsigned& nloc, unsigned& nx) {
    const unsigned G = gridDim.x * gridDim.y * gridDim.z;
    unsigned sum, cnt, mine, sp = 0u;
    for (;;) {
        sum = 0u; cnt = 0u; mine = 0u;
#pragma unroll
        for (unsigned j = 0; j < 16; ++j) { const unsigned c = xb_ld(&bar[XB_XCNT(j)]); sum += c; cnt += (c > 0u) ? 1u : 0u; mine = (j == x) ? c : mine; }
        if (sum == G) break;
        __builtin_amdgcn_s_sleep(1);
        if ((++sp & 255u) == 0u) { if (xb_ld(&bar[XB_TMO])) break; if (sp > XB_SPIN_CAP) { atomicAdd(&bar[XB_TMO], 1u); break; } }
    }
    nloc = mine > 0u ? mine : 1u; nx = cnt > 0u ? cnt : 1u;
}
DI void xcd_barrier(const XcdBarrier& b) {
    asm volatile("s_waitcnt vmcnt(0)" ::: "memory");
    __syncthreads();
    if (threadIdx.x == 0) {
        unsigned* bar = b.bar;
        __builtin_amdgcn_s_waitcnt(0);
        unsigned nloc = b.st[0], nx = b.st[1];
        if (nloc == 0u) { xcd_barrier_complete(bar, b.x, nloc, nx); b.st[0] = nloc; b.st[1] = nx; }
        const unsigned old = xb_add(&bar[XB_XSUB(b.x)], 1u);
        const unsigned gen = old / nloc;
        if (old + 1u == (gen + 1u) * nloc) {
            __builtin_amdgcn_fence(__ATOMIC_RELEASE, "agent");
            asm volatile("s_waitcnt vmcnt(0)" ::: "memory");
            const unsigned og = xb_add(&bar[XB_TOP], 1u);
            const unsigned tg = og / nx;
            if (og + 1u == (tg + 1u) * nx) xb_add(&bar[XB_TOPGEN], 1u);
            else XB_SPIN(xb_ld(&bar[XB_TOPGEN]) == tg, bar);
            __builtin_amdgcn_fence(__ATOMIC_ACQUIRE, "agent");
            xb_add(&bar[XB_XGEN(b.x)], 1u);
            asm volatile("s_waitcnt vmcnt(0)" ::: "memory");
        } else {
            XB_SPIN(xb_ld(&bar[XB_XGEN(b.x)]) == gen, bar);
            __builtin_amdgcn_fence(__ATOMIC_ACQUIRE, "agent");
            asm volatile("s_waitcnt vmcnt(0)" ::: "memory");
        }
    }
    __syncthreads();
}

__global__ void __launch_bounds__(512, 2) fwd_megakernel(Params p) {
    extern __shared__ __attribute__((aligned(16))) unsigned char lds_raw[];
    LAS unsigned char* lds = (LAS unsigned char*)lds_raw;
    cg::grid_group grid = cg::this_grid();
    const int tid = threadIdx.x;
    const int G = gridDim.x, blk = blockIdx.x;
#define lane ((int)(threadIdx.x & 63u))
#define wave (__builtin_amdgcn_readfirstlane((int)(threadIdx.x >> 6)))
#define gw (blk * 8 + wave)
    const int NGW = G * 8;
    unsigned char* ws = p.ws;
    float* out = p.out;
    const float* x_prompt = p.in[0]; const float* x_sample = p.in[1];
    const float* st_C = p.in[2]; const float* st_n = p.in[3]; const float* st_m = p.in[4];
    const float* gpre = p.in[13]; const float* gpost = p.in[14];
    float* MOD = (float*)(ws + WS_MOD); float* Gt = (float*)(ws + WS_G); float* SC = (float*)(ws + WS_SC); float* CH = (float*)(ws + WS_CH);
    float* UN = (float*)(ws + WS_UN); float* NST = (float*)(ws + WS_NST); float* MJ = (float*)(ws + WS_MJ);
    bf16_t* CK = (bf16_t*)(ws + WS_CK); bf16_t* CVT = (bf16_t*)(ws + WS_CVT); bf16_t* NK = (bf16_t*)(ws + WS_NK); bf16_t* NVT = (bf16_t*)(ws + WS_NVT);
    bf16_t* WINE = (bf16_t*)(ws + WS_WINE); bf16_t* WOUTE = (bf16_t*)(ws + WS_WOUTE); bf16_t* WINO = (bf16_t*)(ws + WS_WINO); bf16_t* WOUTO = (bf16_t*)(ws + WS_WOUTO);
    bf16_t* H = (bf16_t*)(ws + WS_H); bf16_t* KT = (bf16_t*)(ws + WS_KT); bf16_t* VT = (bf16_t*)(ws + WS_VT); bf16_t* Y2 = (bf16_t*)(ws + WS_Y2);
    bf16_t* P = (bf16_t*)(ws + WS_P); bf16_t* CST = (bf16_t*)(ws + WS_CST); bf16_t* QB = (bf16_t*)(ws + WS_QB); bf16_t* KB = (bf16_t*)(ws + WS_KB);
    bf16_t* VBT = (bf16_t*)(ws + WS_VBT); bf16_t* U = (bf16_t*)(ws + WS_U); bf16_t* VCT = (bf16_t*)(ws + WS_VCT);
    bf16_t* X1P = (bf16_t*)(ws + WS_X1P); bf16_t* X1S = (bf16_t*)(ws + WS_X1S);
#define X1ROW(r) ((r) < MP ? X1P + (size_t)(r) * DM : X1S + (size_t)((r) - MP) * DM)
    const int lo = p.ph_lo, hi = p.ph_hi;
    volatile LAS unsigned* bst = (volatile LAS unsigned*)(lds + LDS_BYTES - 64);
    if (tid == 0) { bst[0] = 0u; bst[1] = 0u; }
    __syncthreads();
    XcdBarrier xbar = xcd_barrier_post((unsigned*)(ws + WS_BAR), bst);
    if (p.coop == 2) grid.sync();
#define IN(k) (lo <= (k) && (k) < hi)
#define SEAM(k) do { if (p.coop && IN(k) && IN((k) + 1)) { for (int sr_ = 0; sr_ < SYNC_REP; ++sr_) xcd_barrier(xbar); } } while (0)
#define REPEAT(k) _Pragma("unroll 1") for (int rep_ = 0; rep_ < 1 + ((REP_MASK >> (k)) & 1); ++rep_)

    if (IN(0)) REPEAT(0) {
        for (int mb = blk; mb < 192; mb += G) {
            const int l = mb / 96, j0 = (mb % 96) * 32;
            LAS float* sL = (LAS float*)lds;
            LAS float* red = sL + 3072;
            for (int i = tid; i < 3072; i += 512) { const int v = i >> 10, k = i & 1023; const float cv = (v == 0) ? p.in[10][k] : p.in[9][(v - 1) * 1024 + k]; sL[i] = siluf(cv); }
            __syncthreads();
            const int col = tid & 31, kg = tid >> 5;
            float a0 = 0.f, a1 = 0.f, a2 = 0.f;
            const float* wp = p.in[11] + ((size_t)l * 1024 + kg * 64) * 3072 + j0 + col;
#pragma unroll
            for (int i0 = 0; i0 < 64; i0 += 32) {
                float wv[32];
#pragma unroll
                for (int i = 0; i < 32; ++i) wv[i] = __builtin_nontemporal_load(wp + (size_t)(i0 + i) * 3072);
#pragma unroll
                for (int i = 0; i < 32; ++i) { const int k = kg * 64 + i0 + i; a0 += sL[k] * wv[i]; a1 += sL[1024 + k] * wv[i]; a2 += sL[2048 + k] * wv[i]; }
            }
            red[(0 * 16 + kg) * 32 + col] = a0; red[(1 * 16 + kg) * 32 + col] = a1; red[(2 * 16 + kg) * 32 + col] = a2;
            __syncthreads();
            if (tid < 96) { const int v = tid >> 5, c = tid & 31; float s = p.in[12][l * 3072 + j0 + c];
                for (int k2 = 0; k2 < 16; ++k2) s += red[(v * 16 + k2) * 32 + c];
                __hip_atomic_store(MOD + (l * 3 + v) * 3072 + j0 + c, s, __ATOMIC_RELAXED, __HIP_MEMORY_SCOPE_AGENT); }
            asm volatile("s_waitcnt vmcnt(0)" ::: "memory");
            __syncthreads();
            if (tid == 0) __hip_atomic_fetch_add((unsigned*)(ws + 16384) + 16 * 160, 1u, __ATOMIC_RELAXED, __HIP_MEMORY_SCOPE_AGENT);
        }
        {
            LAS float* scr = (LAS float*)(lds + wave * 16384);
            const int I_E = 16 * 121, I_O = 16 * 32;
            for (int it = gw; it < I_E + I_O; it += NGW) {
                if (it < I_E) transpose_item(p.in[15], 1024, 3856, WINE, scr, it, lane);
                else transpose_item(p.in[20], 1024, 1024, WOUTE, scr, it - I_E, lane);
            }
        }
        {
            const int gt = blk * 512 + tid, NT = G * 512;
            for (int i = gt; i < 65536; i += NT) {
                CK[i] = f2bf(p.in[5][i]);
                const int d = i & 63, s = (i >> 6) & 255, bh = i >> 14;
                CVT[(bh * 64 + d) * 256 + s] = f2bf(p.in[6][i]);
            }
        }
        __syncthreads();
        if (tid == 0) {
            unsigned* c = (unsigned*)(ws + 16384) + 16 * 160; unsigned spins = 0;
            while (__hip_atomic_load(c, __ATOMIC_RELAXED, __HIP_MEMORY_SCOPE_AGENT) < 192u) { __builtin_amdgcn_s_sleep(1); if (++spins > (1u << 22)) break; }
            __builtin_amdgcn_fence(__ATOMIC_ACQUIRE, "agent");
            asm volatile("s_waitcnt vmcnt(0)" ::: "memory");
        }
        __syncthreads();
    }
    if (IN(1)) REPEAT(1) {
        for (int row0 = gw; row0 < MROWS; row0 += 2 * NGW) {
            const float* xr[2]; const float* md[2]; bf16_t* orow[2];
#pragma unroll
            for (int r = 0; r < 2; ++r) {
                const int row = min(row0 + r * NGW, MROWS - 1);
                const int v = row < MP ? 0 : 1 + ((row - MP) >> 12);
                xr[r] = row < MP ? x_prompt + (size_t)row * DM : x_sample + (size_t)(row - MP) * DM;
                md[r] = MOD + (0 * 3 + v) * 3072; orow[r] = H + (size_t)row * DM;
            }
            prenorm_rows<2>(xr, gpre, md, orow, lane);
        }
    }
    SEAM(1);
    if (IN(2)) REPEAT(2) {
        pg8::Gemm g{H, WINE, MROWS, 4096, 1024}; pg8::StaticOrder S; S.init(MROWS, 4096, G, blk);
        EpiEvenIn E{P, KT, VT, VBT, Gt, out};
        pg8::gemm_phase(lds, g, S, E);
    }
    SEAM(2);
    if (IN(3)) REPEAT(3) {
        for (int it = gw; it < 768; it += NGW) {
            int sid, h, dir, js;
            if (it < 256) { js = it & 1; dir = (it >> 1) & 1; h = (it >> 2) & 3; sid = it >> 4; }
            else { const int r = it - 256; js = r & 31; dir = (r >> 5) & 1; h = (r >> 6) & 3; sid = 16 + (r >> 8); }
            gate_scan_item(sid, h, dir, js, lane, Gt, p.in[16], SC, CH);
        }
        for (int row0 = gw; row0 < MROWS; row0 += 2 * NGW) {
            const int row1 = row0 + NGW; const bool two = row1 < MROWS;
            u32x4 ra[2], rb[2];
            ra[0] = *(const u32x4*)(P + (size_t)row0 * NP + C_QB + lane * 8); ra[1] = *(const u32x4*)(P + (size_t)row0 * NP + C_KB + lane * 8);
            if (two) { rb[0] = *(const u32x4*)(P + (size_t)row1 * NP + C_QB + lane * 8); rb[1] = *(const u32x4*)(P + (size_t)row1 * NP + C_KB + lane * 8); }
            qknorm_item(row0, lane, ra, p.in[18], p.in[19], QB, KB, out);
            if (two) qknorm_item(row1, lane, rb, p.in[18], p.in[19], QB, KB, out);
        }
    }
    SEAM(3);
    const bool gate67 = (G >= (MROWS / 256) * (DM / 256)) && p.coop && IN(4) && IN(5) && IN(6) && IN(7);
    unsigned* pcntA = (unsigned*)(ws + 65536);
    const bool gate45 = (G == 256) && p.coop && IN(4) && IN(5) && IN(6);
    unsigned* ucnt = (unsigned*)(ws + 49152);
    if (IN(4)) REPEAT(4) {
        const WT wtw4 = mk_wt(ws, (unsigned)WS_END);
        const int NIT = 256 + 768 + 128;
        for (int it = blk; it < NIT; it += G) {
            if (it < 256) {
                const int xcd = it & 7, jj = it >> 3, b = xcd >> 2, kv = (xcd >> 1) & 1, idx = (xcd & 1) * 32 + jj, qh = kv * 4 + (idx & 3), qblk = idx >> 2;
                const int rowq = MP + b * 4096 + qblk * 256;
                attn_item<0>(lds, tid, QB + (size_t)rowq * 512 + qh * 64, 512,
                             CK + (size_t)((b * 2 + kv) * 256) * 64, 64, CVT + (size_t)((b * 2 + kv) * 64) * 256, 256, 4,
                             KB + (size_t)(MP + b * 4096) * 128 + kv * 64, 128, VBT + (size_t)(kv * 64) * MROWS + MP + b * 4096, MROWS, 64,
                             0, 0, nullptr,
                             P + (size_t)rowq * NP + C_Z + 512 + qh * 64, NP, H + (size_t)rowq * DM + 512 + qh * 64, DM, wtw4, gate67, gate67 ? pcntA + 16 * (rowq >> 8) : nullptr);
            } else if (it < 256 + 768) {
                const int r0 = it - 256; int sid, h, dir, js;
                if (r0 < 256) { js = r0 & 1; dir = (r0 >> 1) & 1; h = (r0 >> 2) & 3; sid = r0 >> 4; }
                else { const int r = r0 - 256; js = r & 31; dir = (r >> 5) & 1; h = (r >> 6) & 3; sid = 16 + (r >> 8); }
                mlstm_u_item(lds, tid, sid, h, dir, js, SC, CH, st_m, KT, VT, U, UN, wtw4, gate45 ? ucnt : nullptr);
            } else {
                const int r = it - 1024, qh = r & 7, b = r >> 3, kv = qh >> 2;
                const int rowq = b * 256;
                attn_item<0>(lds, tid, QB + (size_t)rowq * 512 + qh * 64, 512,
                             KB, 128, VBT, MROWS, 0,
                             KB + (size_t)rowq * 128 + kv * 64, 128, VBT + (size_t)(kv * 64) * MROWS + rowq, MROWS, 4,
                             0, 0, nullptr,
                             P + (size_t)rowq * NP + C_Z + 512 + qh * 64, NP, H + (size_t)rowq * DM + 512 + qh * 64, DM, wtw4, gate67, gate67 ? pcntA + 16 * (rowq >> 8) : nullptr);
            }
        }
    }
    if (!gate45) SEAM(4);
    const bool gate56 = (G == 256) && p.coop && IN(5) && IN(6);
    unsigned* chcnt = (unsigned*)(ws + 32768);
    if (IN(5)) REPEAT(5) {
        const WT wtw = mk_wt(ws, (unsigned)WS_END);
        const int NT = G * 512;
        const int nS = 16 * 2048, nP = 128 * 2048;
        const int perS = (nS + G - 1) / G;
        const int nvb = gate56 ? 2 : 1;
        const int sblk = gate56 ? blk - 128 : blk;
        if (!gate56 || blk >= 128) {
            for (int ps = 0; ps < 2; ++ps) {
                const int pass = 1 - ps;
                if (gate45) {
                    if (tid == 0) {
                        unsigned spins = 0; bool ok = false;
                        while (!ok) {
                            ok = true;
                            for (int vbi = 0; vbi < 2; ++vbi) {
                                const int vb = sblk + 128 * vbi;
                                if (pass == 1) {
                                    ok = ok && __hip_atomic_load(ucnt + 16 * (vb >> 2), __ATOMIC_RELAXED, __HIP_MEMORY_SCOPE_AGENT) >= 2u
                                            && __hip_atomic_load(ucnt + 16 * ((vb >> 2) + 64), __ATOMIC_RELAXED, __HIP_MEMORY_SCOPE_AGENT) >= 2u;
                                    if (vb < 36) for (int q = 0; q < 4; ++q) { const int c = vb * 4 + q; ok = ok && __hip_atomic_load(ucnt + 16 * c, __ATOMIC_RELAXED, __HIP_MEMORY_SCOPE_AGENT) >= (c < 128 ? 2u : 32u); }
                                } else ok = ok && __hip_atomic_load(ucnt + 16 * (128 + (vb >> 4)), __ATOMIC_RELAXED, __HIP_MEMORY_SCOPE_AGENT) >= 32u;
                            }
                            if (!ok) { __builtin_amdgcn_s_sleep(1); if (++spins > (1u << 22)) break; }
                        }
                        __builtin_amdgcn_fence(__ATOMIC_ACQUIRE, "agent");
                        asm volatile("s_waitcnt vmcnt(0)" ::: "memory");
                    }
                    __syncthreads();
                }
                for (int vbi = 0; vbi < nvb; ++vbi) {
                    const int vb = sblk + 128 * vbi;
                    int i0, i1, st;
                    if (pass == 1) { i0 = vb * 512 + tid; i1 = nP; st = NT; }
                    else if (gate56) { const bool on = (vbi == 0) && (tid < 256); i0 = on ? (sblk + 128 * (tid >> 7)) * 128 + (tid & 127) : 0; i1 = on ? i0 + 1 : 0; st = 1; }
                    else { i0 = vb * perS + tid; i1 = min((vb + 1) * perS, nS); st = 512; }
                    for (int idx0 = i0; idx0 < i1; idx0 += st) {
            const int idx = pass == 0 ? nP + idx0 : idx0;
            const int chain = idx >> 11, e8 = (idx & 2047) * 8;
            int sid, h, dir;
            if (chain < 128) { dir = chain & 1; h = (chain >> 1) & 3; sid = chain >> 3; } else { const int r = chain - 128; dir = r & 1; h = (r >> 1) & 3; sid = 16 + (r >> 3); }
            const int nc = sid < 16 ? 2 : 32, base = chain_base(sid, h, dir);
            float cur[8];
            if (sid < 16) {
#pragma unroll
                for (int e = 0; e < 8; ++e) cur[e] = 0.f;
            } else {
                const float* c0 = st_C + ((size_t)(((sid - 16) * 2 + dir) * 4 + h)) * 16384 + e8;
                const f32x4 a = *(const f32x4*)c0, b = *(const f32x4*)(c0 + 4);
                cur[0] = a[0]; cur[1] = a[1]; cur[2] = a[2]; cur[3] = a[3]; cur[4] = b[0]; cur[5] = b[1]; cur[6] = b[2]; cur[7] = b[3];
            }
            float m = chain_m0(st_m, sid, h, dir);
            const bf16_t* __restrict__ Ub = U + (size_t)base * 16384 + e8;
            bf16_t* __restrict__ Cb = CST + (size_t)base * 16384 + e8;
            for (int js0 = 0; js0 < nc; js0 += 8) {
                u32x4 raw[8];
#pragma unroll
                for (int j = 0; j < 8; ++j) if (js0 + j < nc) raw[j] = *(const u32x4*)(Ub + (size_t)(js0 + j) * 16384);
#pragma unroll
                for (int j = 0; j < 8; ++j) if (js0 + j < nc) {
                    const int js = js0 + j;
                    const float bL = CH[(base + js) * 2], rmL = CH[(base + js) * 2 + 1];
                    const float Mx = fmaxf(m, rmL), a = expf(m - Mx), f = expf(rmL - Mx);
                    if (e8 == 0) __hip_atomic_store(MJ + base + js, m, __ATOMIC_RELAXED, __HIP_MEMORY_SCOPE_AGENT);
                    u32x4 wv; wv.x = cvtpk(cur[0], cur[1]); wv.y = cvtpk(cur[2], cur[3]); wv.z = cvtpk(cur[4], cur[5]); wv.w = cvtpk(cur[6], cur[7]);
                    wt16(wtw, Cb + (size_t)js * 16384, wv);
                    cur[0] = a * cur[0] + f * __uint_as_float(raw[j].x << 16); cur[1] = a * cur[1] + f * __uint_as_float(raw[j].x & 0xffff0000u);
                    cur[2] = a * cur[2] + f * __uint_as_float(raw[j].y << 16); cur[3] = a * cur[3] + f * __uint_as_float(raw[j].y & 0xffff0000u);
                    cur[4] = a * cur[4] + f * __uint_as_float(raw[j].z << 16); cur[5] = a * cur[5] + f * __uint_as_float(raw[j].z & 0xffff0000u);
                    cur[6] = a * cur[6] + f * __uint_as_float(raw[j].w << 16); cur[7] = a * cur[7] + f * __uint_as_float(raw[j].w & 0xffff0000u);
                    m = bL + Mx;
                }
            }
            if (sid < 16) {
                float* o = out + O_C + ((size_t)((sid * 2 + dir) * 4 + h)) * 16384 + e8;
                *(f32x4*)o = (f32x4){cur[0], cur[1], cur[2], cur[3]}; *(f32x4*)(o + 4) = (f32x4){cur[4], cur[5], cur[6], cur[7]};
            }
                            }
                }
                if (pass == 1) {
                    for (int vbi = 0; vbi < nvb; ++vbi)
                    for (int idx = (sblk + 128 * vbi) * 512 + tid; idx < 144 * 128; idx += NT) {
            const int chain = idx >> 7, k = idx & 127;
            int sid, h, dir;
            if (chain < 128) { dir = chain & 1; h = (chain >> 1) & 3; sid = chain >> 3; } else { const int r = chain - 128; dir = r & 1; h = (r >> 1) & 3; sid = 16 + (r >> 3); }
            const int nc = sid < 16 ? 2 : 32, base = chain_base(sid, h, dir);
            float cur = sid < 16 ? 0.f : st_n[(((sid - 16) * 2 + dir) * 4 + h) * 128 + k];
            float m = chain_m0(st_m, sid, h, dir);
            for (int js0 = 0; js0 < nc; js0 += 8) {
                float un[8];
#pragma unroll
                for (int j = 0; j < 8; ++j) if (js0 + j < nc) un[j] = UN[(size_t)(base + js0 + j) * 128 + k];
#pragma unroll
                for (int j = 0; j < 8; ++j) if (js0 + j < nc) {
                    const int js = js0 + j;
                    const float bL = CH[(base + js) * 2], rmL = CH[(base + js) * 2 + 1];
                    const float Mx = fmaxf(m, rmL), a = expf(m - Mx), f = expf(rmL - Mx);
                    __hip_atomic_store(NST + (size_t)(base + js) * 128 + k, cur, __ATOMIC_RELAXED, __HIP_MEMORY_SCOPE_AGENT);
                    cur = a * cur + f * un[j];
                    m = bL + Mx;
                }
            }
            if (sid < 16) {
                out[O_N + ((size_t)((sid * 2 + dir) * 4 + h)) * 128 + k] = cur;
                if (k == 0) out[O_M + (sid * 2 + dir) * 4 + h] = m;
            }
                            }
                }
                if (gate56) {
                    asm volatile("s_waitcnt vmcnt(0)" ::: "memory");
                    __syncthreads();
                    if (tid == 0) {
                        for (int vbi = 0; vbi < 2; ++vbi) {
                            const int vb = sblk + 128 * vbi;
                            if (pass == 1) {
                                __hip_atomic_fetch_add(chcnt + 16 * (vb >> 2), 1u, __ATOMIC_RELAXED, __HIP_MEMORY_SCOPE_AGENT);
                                __hip_atomic_fetch_add(chcnt + 16 * ((vb >> 2) + 64), 1u, __ATOMIC_RELAXED, __HIP_MEMORY_SCOPE_AGENT);
                                if (vb < 36) for (int q = 0; q < 4; ++q) __hip_atomic_fetch_add(chcnt + 16 * (vb * 4 + q), 1u, __ATOMIC_RELAXED, __HIP_MEMORY_SCOPE_AGENT);
                            } else {
                                __hip_atomic_fetch_add(chcnt + 16 * (128 + (vb >> 4)), 1u, __ATOMIC_RELAXED, __HIP_MEMORY_SCOPE_AGENT);
                            }
                        }
                    }
                }
            }
        } else {
            const int r = blk, jt = r & 1, h = (r >> 1) & 3, sid = r >> 3;
            if (tid == 0) {
                const int c0 = (sid * 4 + h) * 2; unsigned spins = 0;
                while (__hip_atomic_load(chcnt + 16 * c0, __ATOMIC_RELAXED, __HIP_MEMORY_SCOPE_AGENT) < 5u ||
                       __hip_atomic_load(chcnt + 16 * (c0 + 1), __ATOMIC_RELAXED, __HIP_MEMORY_SCOPE_AGENT) < 5u) { __builtin_amdgcn_s_sleep(1); if (++spins > (1u << 22)) break; }
                __builtin_amdgcn_fence(__ATOMIC_ACQUIRE, "agent");
                asm volatile("s_waitcnt vmcnt(0)" ::: "memory");
            }
            __syncthreads();
            mlstm_out_item(lds, tid, sid, h, jt, SC, MJ, NST, CST, P, VT, p.in[17], H, wtw, gate67, gate67 ? pcntA : nullptr);
        }
    }
    if (!gate56) SEAM(5);
    if (IN(6)) REPEAT(6) {
        const WT wtw = mk_wt(ws, (unsigned)WS_END);
        for (int it = blk; it < (gate56 ? 256 : 384); it += G) {
            int sid, h, jt;
            if (it < 256) { jt = it & 31; h = (it >> 5) & 3; sid = 16 + (it >> 7); }
            else { const int r = it - 256; jt = r & 1; h = (r >> 1) & 3; sid = r >> 3; }
            if (gate56) {
                if (tid == 0) {
                    const int c0 = 128 + ((sid - 16) * 4 + h) * 2; unsigned spins = 0;
                    while (__hip_atomic_load(chcnt + 16 * c0, __ATOMIC_RELAXED, __HIP_MEMORY_SCOPE_AGENT) < 17u ||
                           __hip_atomic_load(chcnt + 16 * (c0 + 1), __ATOMIC_RELAXED, __HIP_MEMORY_SCOPE_AGENT) < 17u) { __builtin_amdgcn_s_sleep(1); if (++spins > (1u << 22)) break; }
                    __builtin_amdgcn_fence(__ATOMIC_ACQUIRE, "agent");
                    asm volatile("s_waitcnt vmcnt(0)" ::: "memory");
                }
                __syncthreads();
            }
            mlstm_out_item(lds, tid, sid, h, jt, SC, MJ, NST, CST, P, VT, p.in[17], H, wtw, gate67, gate67 ? pcntA : nullptr);
        }
    }
    if (!gate67) SEAM(6);
    const bool fuse_mid = (G >= (MROWS / 256) * (DM / 256));
    if (IN(7)) REPEAT(7) {
        pg8::Gemm g{H, WOUTE, MROWS, 1024, 1024}; pg8::StaticOrder S; S.init(MROWS, 1024, G, blk);
        if (fuse_mid) {
            if (gate67) {
                pg8::Unit u0;
                if (S.next(0, u0)) {
                    if (tid == 0) {
                        unsigned spins = 0;
                        while (__hip_atomic_load(pcntA + 16 * u0.pm, __ATOMIC_RELAXED, __HIP_MEMORY_SCOPE_AGENT) < 16u) { __builtin_amdgcn_s_sleep(1); if (++spins > (1u << 22)) break; }
                        __builtin_amdgcn_fence(__ATOMIC_ACQUIRE, "agent");
                        asm volatile("s_waitcnt vmcnt(0)" ::: "memory");
                    }
                }
                __syncthreads();
            }
            EpiMid E{x_prompt, x_sample, MOD, gpost, gpre + DM, X1P, X1S, H, (float*)(ws + WS_G), (unsigned*)(ws + 16384)};
            pg8::gemm_phase(lds, g, S, E);
        } else {
            EpiPlain E{Y2, DM};
            pg8::gemm_phase(lds, g, S, E);
        }
        {
            const int nunits = (MROWS / 256) * (DM / 256);
            const bool some_idle = G > nunits;
            if (!some_idle || blk >= nunits) {
                const int nw = some_idle ? G - nunits : G, ib = some_idle ? blk - nunits : blk;
                LAS float* scr = (LAS float*)(lds + wave * 16384);
                const int I_C = 16 * 128, I_O = 16 * 32;
                for (int it = ib * 8 + wave; it < I_C + I_O; it += nw * 8) {
                    if (it < I_C) transpose_item(p.in[21], 1024, 4096, WINO, scr, it, lane);
                    else transpose_item(p.in[23], 1024, 1024, WOUTO, scr, it - I_C, lane);
                }
                const int NT = nw * 512;
                for (int i0 = ib * 512 + tid; i0 < 524288; i0 += 4 * NT) {
                    float ka[4], va[4];
#pragma unroll
                    for (int k = 0; k < 4; ++k) { const int i = i0 + k * NT; if (i < 524288) { ka[k] = p.in[7][i]; va[k] = p.in[8][i]; } }
#pragma unroll
                    for (int k = 0; k < 4; ++k) { const int i = i0 + k * NT; if (i < 524288) {
                        NK[i] = f2bf(ka[k]);
                        const int d = i & 63, s2 = (i >> 6) & 255, bh = i >> 14;
                        NVT[(bh * 64 + d) * 256 + s2] = f2bf(va[k]); } }
                }
            }
        }
    }
    SEAM(7);
    if (!fuse_mid) {
    if (IN(8)) REPEAT(8) {
        for (int row0 = gw; row0 < MROWS; row0 += 2 * NGW) {
            const float* xr[2]; const bf16_t* yr[2]; const float* md0[2]; const float* md1[2]; float* x1r[2]; bf16_t* hr[2];
#pragma unroll
            for (int r = 0; r < 2; ++r) {
                const int row = min(row0 + r * NGW, MROWS - 1);
                const int v = row < MP ? 0 : 1 + ((row - MP) >> 12);
                xr[r] = row < MP ? x_prompt + (size_t)row * DM : x_sample + (size_t)(row - MP) * DM;
                yr[r] = Y2 + (size_t)row * DM; md0[r] = MOD + (0 * 3 + v) * 3072; md1[r] = MOD + (1 * 3 + v) * 3072;
                x1r[r] = (float*)X1ROW(row); hr[r] = H + (size_t)row * DM;
            }
            postnorm_rows<true, 2, false, true>(xr, yr, gpost, md0, x1r, gpre + DM, md1, hr, lane);
        }
    }
    SEAM(8);
    }
    if (IN(9)) REPEAT(9) {
        pg8::Gemm g{H, WINO, MROWS, 4096, 1024}; pg8::StaticOrder S; S.init(MROWS, 4096, G, blk);
        EpiOddIn E{P, VCT, out};
        pg8::gemm_phase(lds, g, S, E);
    }
    SEAM(9);
    const bool gate1011 = (G >= (MROWS / 256) * (DM / 256)) && p.coop && IN(10) && IN(11);
    unsigned* pcntB = (unsigned*)(ws + 62464);
    if (IN(10)) REPEAT(10) {
        const WT wtw10 = mk_wt(ws, (unsigned)WS_END);
        LAS float* rpbL = (LAS float*)(lds + 8 * AT_TILE);
        for (int it = blk; it < 512 + 256; it += G) {
            if (it < 512) {
                const int xcd = it & 7, jj = (it >> 3) & 31, b = it >> 8, h = 2 * xcd + (jj >> 4), rblk = jj & 15;
                for (int i = tid; i < 640; i += 512) { const int j = i - 64; rpbL[i] = (j >= 0 && j < 465) ? p.in[22][h * 465 + j] * LOG2E : 0.f; }
                const int r0 = rblk * 4;
                const int rs_lo = min(max(r0 - 4, 0), 56), rs_hi = min(max(r0 + 3 - 4, 0), 56) + 7;
                const int rowq = MP + b * 4096 + r0 * 64, rowk = MP + b * 4096 + rs_lo * 64;
                attn_item<1>(lds, tid, P + (size_t)rowq * NP + h * 64, NP,
                             NK + (size_t)((b * 16 + h) * 256) * 64, 64, NVT + (size_t)((b * 16 + h) * 64) * 256, 256, 4,
                             P + (size_t)rowk * NP + 1024 + h * 64, NP, VCT + (size_t)(h * 64) * MROWS + rowk, MROWS, rs_hi - rs_lo + 1,
                             r0, rs_lo, rpbL,
                             P + (size_t)rowq * NP + 3072 + h * 64, NP, H + (size_t)rowq * DM + h * 64, DM, wtw10, gate1011, gate1011 ? pcntB + 16 * (rowq >> 8) : nullptr);
            } else {
                const int r = it - 512, h = r & 15, b = r >> 4;
                const int rowq = b * 256;
                attn_item<0>(lds, tid, P + (size_t)rowq * NP + h * 64, NP,
                             P, NP, VCT, MROWS, 0,
                             P + (size_t)rowq * NP + 1024 + h * 64, NP, VCT + (size_t)(h * 64) * MROWS + rowq, MROWS, 4,
                             0, 0, nullptr,
                             P + (size_t)rowq * NP + 3072 + h * 64, NP, H + (size_t)rowq * DM + h * 64, DM, wtw10, gate1011, gate1011 ? pcntB + 16 * (rowq >> 8) : nullptr);
            }
        }
    }
    if (!gate1011) SEAM(10);
    const bool fuse_last = (G >= (MROWS / 256) * (DM / 256));
    if (IN(11)) REPEAT(11) {
        pg8::Gemm g{H, WOUTO, MROWS, 1024, 1024}; pg8::StaticOrder S; S.init(MROWS, 1024, G, blk);
        if (fuse_last) {
            if (gate1011) {
                pg8::Unit u0;
                if (S.next(0, u0)) {
                    if (tid == 0) {
                        unsigned spins = 0;
                        while (__hip_atomic_load(pcntB + 16 * u0.pm, __ATOMIC_RELAXED, __HIP_MEMORY_SCOPE_AGENT) < 16u) { __builtin_amdgcn_s_sleep(1); if (++spins > (1u << 22)) break; }
                        __builtin_amdgcn_fence(__ATOMIC_ACQUIRE, "agent");
                        asm volatile("s_waitcnt vmcnt(0)" ::: "memory");
                    }
                }
                __syncthreads();
            }
            EpiFinal E{X1P, X1S, MOD, gpost + DM, out, (float*)(ws + WS_G), (unsigned*)(ws + 16384)};
            pg8::gemm_phase(lds, g, S, E);
        } else {
            EpiPlain E{Y2, DM};
            pg8::gemm_phase(lds, g, S, E);
        }
    }
    if (!fuse_last) {
    SEAM(11);
    if (IN(12)) {
        for (int row0 = gw; row0 < MROWS; row0 += 2 * NGW) {
            const float* xr[2]; const bf16_t* yr[2]; const float* md1[2]; float* x1r[2]; bf16_t* hr[2];
#pragma unroll
            for (int r = 0; r < 2; ++r) {
                const int row = min(row0 + r * NGW, MROWS - 1);
                const int v = row < MP ? 0 : 1 + ((row - MP) >> 12);
                xr[r] = (const float*)X1ROW(row); yr[r] = Y2 + (size_t)row * DM; md1[r] = MOD + (1 * 3 + v) * 3072; x1r[r] = out + (size_t)row * DM; hr[r] = nullptr;
            }
            postnorm_rows<false, 2, true, false>(xr, yr, gpost + DM, md1, x1r, nullptr, md1, hr, lane);
        }
    }
    }
#undef IN
#undef SEAM
#undef REPEAT
#undef lane
#undef wave
#undef gw
#undef X1ROW
}

#ifndef MK_COOP
#define MK_COOP 1
#endif
extern "C" void kernel_launch(void* const* d_in, const int* in_sizes, int n_in, void* d_out, int out_size, void* d_ws, size_t ws_size, hipStream_t stream) {
    static int grid = 0;
    if (grid == 0) {
        int dev = 0, cus = 0, per_cu = 0;
        (void)hipGetDevice(&dev);
        (void)hipDeviceGetAttribute(&cus, hipDeviceAttributeMultiprocessorCount, dev);
        (void)hipFuncSetAttribute((const void*)fwd_megakernel, hipFuncAttributeMaxDynamicSharedMemorySize, LDS_BYTES);
        (void)hipOccupancyMaxActiveBlocksPerMultiprocessor(&per_cu, (const void*)fwd_megakernel, 512, LDS_BYTES);
        if (per_cu < 1) { fprintf(stderr, "kernel_launch: occupancy query returned %d\n", per_cu); per_cu = 1; }
        grid = cus * per_cu;
        if (ws_size < WS_END) fprintf(stderr, "kernel_launch: workspace too small (%zu < %zu)\n", ws_size, (size_t)WS_END);
    }
    Params p{};
    for (int i = 0; i < 24; ++i) p.in[i] = (const float*)d_in[i];
    p.out = (float*)d_out; p.ws = (unsigned char*)d_ws;
#if MK_COOP
    p.ph_lo = 0; p.ph_hi = 13; p.coop = 1; p.pad = 0;
    void* args[] = {&p};
    (void)hipMemsetAsync((char*)d_ws + WS_BAR, 0, 131072, stream);
    hipError_t e = hipLaunchCooperativeKernel((const void*)fwd_megakernel, dim3(grid), dim3(512), args, LDS_BYTES, stream);
    if (e != hipSuccess) fprintf(stderr, "cooperative launch failed: %s (grid %d)\n", hipGetErrorString(e), grid);
#else
    for (int ph = 0; ph < 13; ++ph) {
        p.ph_lo = ph; p.ph_hi = ph + 1; p.coop = 0; p.pad = 0;
        hipLaunchKernelGGL(fwd_megakernel, dim3(grid), dim3(512), LDS_BYTES, stream, p);
    }
#endif
}
```
